# Optimizing an MI355X kernel written in HIP

```python
import math
import jax, jax.numpy as jnp
from jax import lax
import numpy as np

D_MODEL = 1024
BATCH = 4
SEQ = 4096
DEPTH = 2
DEC_BATCH = 128
DEC_SEQ = 4
PAST_LEN = 2048
PAGE_SIZE = 128

N_EVEN = (DEPTH + 1) // 2
N_ODD = DEPTH // 2
SB_HEADS = 8
SB_HEAD_DIM = D_MODEL // 16
SB_WIDTH = SB_HEADS * SB_HEAD_DIM
SB_BIAS_INIT = -8.0
Q_BLOCK = 128
LRU_WIDTH = D_MODEL // 2
LRU_BLOCKS = 8
LRU_BLOCK_DIM = LRU_WIDTH // LRU_BLOCKS
LRU_C = 8.0
CONV_WIDTH = 4
DN_HEADS = 8
DN_HEAD_DIM = D_MODEL // 8
DN_WIDTH = DN_HEADS * DN_HEAD_DIM
DN_CHUNK = 64
D_FF = 2 * D_MODEL
EVEN_IN = 3 * SB_WIDTH + 2 * LRU_WIDTH
ODD_IN = 4 * DN_WIDTH + 2 * DN_HEADS
EPS = 1e-6

kernel_name = 'stickbreak_rglru_gdn_macaron_step'


def rms_norm(x, g):
    xf = x.astype(jnp.float32)
    y = xf * lax.rsqrt(jnp.mean(xf * xf, axis=-1, keepdims=True) + EPS)
    return (y * g.astype(jnp.float32)).astype(x.dtype)


def l2_normalize(x):
    xf = x.astype(jnp.float32)
    return xf * lax.rsqrt(jnp.sum(xf * xf, axis=-1, keepdims=True) + EPS)


def swiglu(x, w_in, w_out):
    g, u = jnp.split(x @ w_in, 2, axis=-1)
    return (jax.nn.silu(g) * u) @ w_out


def causal_conv(buf, u, w, b=None):
    xp = jnp.concatenate([buf.astype(u.dtype), u], axis=1)
    T = u.shape[1]
    y = w[0] * xp[:, 0:T]
    for i in range(1, CONV_WIDTH):
        y = y + w[i] * xp[:, i:i + T]
    if b is not None:
        y = y + b
    return y, xp[:, -(CONV_WIDTH - 1):]


def sb_block(q, q_pos, k, v, k_pos, bias):
    z = jnp.einsum('bqhd,bshd->bhqs', q, k, preferred_element_type=jnp.float32) * (SB_HEAD_DIM ** -0.5)
    z = z + bias.astype(jnp.float32)[None, :, None, None]
    mask = k_pos[None, :] < q_pos[:, None]
    log_keep = jnp.where(mask, jax.nn.log_sigmoid(-z), 0.0)
    later = lax.cumsum(log_keep, axis=3, reverse=True) - log_keep
    w = jnp.where(mask, jnp.exp(jax.nn.log_sigmoid(z) + later), 0.0)
    return jnp.einsum('bhqs,bshd->bqhd', w.astype(v.dtype), v)


def sb_attention(q, k, v, q_pos, k_pos, bias):
    B, T, H, Dh = q.shape
    blk = Q_BLOCK if T % Q_BLOCK == 0 else T
    nb = T // blk
    qb = q.reshape(B, nb, blk, H, Dh).transpose(1, 0, 2, 3, 4)
    pb = q_pos.reshape(nb, blk)
    ob = lax.map(lambda a: sb_block(a[0], a[1], k, v, k_pos, bias), (qb, pb))
    return ob.transpose(1, 0, 2, 3, 4).reshape(B, T, H, Dh)


def rg_lru(xc, h0, w_a, b_a, w_i, b_i, lam):
    B, T, W = xc.shape
    xb = xc.reshape(B, T, LRU_BLOCKS, LRU_BLOCK_DIM)
    r = jax.nn.sigmoid((jnp.einsum('btnc,ncd->btnd', xb, w_a).reshape(B, T, W) + b_a).astype(jnp.float32))
    i = jax.nn.sigmoid((jnp.einsum('btnc,ncd->btnd', xb, w_i).reshape(B, T, W) + b_i).astype(jnp.float32))
    log_a = -LRU_C * r * jax.nn.softplus(-lam.astype(jnp.float32))
    a = jnp.exp(log_a)
    b = jnp.sqrt(-jnp.expm1(2.0 * log_a)) * (i * xc.astype(jnp.float32))
    b = b.at[:, 0].add(a[:, 0] * h0.astype(jnp.float32))

    def combine(left, right):
        a1, b1 = left
        a2, b2 = right
        return a1 * a2, a2 * b1 + b2

    _, h = lax.associative_scan(combine, (a, b), axis=1)
    return h, h[:, -1]


def sb_lru_mixer(u, past_k, past_v, conv_buf, h0, w_in, q_gain, k_gain, sb_bias, conv_w, conv_b,
                 w_a, b_a, w_i, b_i, lam, w_out):
    B, T, _ = u.shape
    proj = u @ w_in
    q, k, v, xr, xg = jnp.split(proj, [SB_WIDTH, 2 * SB_WIDTH, 3 * SB_WIDTH, 3 * SB_WIDTH + LRU_WIDTH], axis=-1)
    q = rms_norm(q.reshape(B, T, SB_HEADS, SB_HEAD_DIM), q_gain)
    k = rms_norm(k.reshape(B, T, SB_HEADS, SB_HEAD_DIM), k_gain)
    v = v.reshape(B, T, SB_HEADS, SB_HEAD_DIM)
    past_len = past_k.shape[1]
    k_all = jnp.concatenate([past_k.astype(k.dtype), k], axis=1)
    v_all = jnp.concatenate([past_v.astype(v.dtype), v], axis=1)
    q_pos = past_len + jnp.arange(T)
    k_pos = jnp.arange(past_len + T)
    attn = sb_attention(q, k_all, v_all, q_pos, k_pos, sb_bias).reshape(B, T, SB_WIDTH)
    xc, new_buf = causal_conv(conv_buf, xr, conv_w, conv_b)
    h, h_last = rg_lru(xc, h0, w_a, b_a, w_i, b_i, lam)
    rec = h.astype(u.dtype) * jax.nn.gelu(xg)
    out = jnp.concatenate([attn.astype(u.dtype), rec], axis=-1) @ w_out
    return out, (k, v, new_buf, h_last)


def gated_delta_chunked(q, k, v, beta, g, S0):
    B, T, H, DK = q.shape
    DV = v.shape[-1]
    C = min(DN_CHUNK, T)
    pad = (-T) % C
    f32 = jnp.float32

    def prep(a):
        a = a.astype(f32)
        a = jnp.pad(a, [(0, 0), (0, pad)] + [(0, 0)] * (a.ndim - 2))
        n = a.shape[1] // C
        a = a.reshape((B, n, C) + a.shape[2:])
        return jnp.swapaxes(a, 2, 3)

    qc, kc, vc, bc, gc = prep(q), prep(k), prep(v), prep(beta), prep(g)
    G = jnp.cumsum(gc, axis=-1)
    incl = jnp.tril(jnp.ones((C, C), bool))
    strict = jnp.tril(jnp.ones((C, C), bool), -1)
    decay = jnp.exp(jnp.where(incl, G[..., :, None] - G[..., None, :], -jnp.inf))
    A = jnp.where(strict, jnp.einsum('bnhcd,bnhsd->bnhcs', kc, kc) * decay, 0.0) * bc[..., None]
    rhs = jnp.concatenate([vc * bc[..., None], kc * (bc * jnp.exp(G))[..., None]], axis=-1)
    sol = lax.linalg.triangular_solve(A, rhs, left_side=True, lower=True, unit_diagonal=True)
    Uv, Wk = sol[..., :DV], sol[..., DV:]
    P = jnp.einsum('bnhcd,bnhsd->bnhcs', qc, kc) * decay
    qg = qc * jnp.exp(G)[..., None]
    kg = kc * jnp.exp(G[..., -1:] - G)[..., None]
    gl = jnp.exp(G[..., -1])

    def step(S, xs):
        uv, wk, p, qq, kk, gg = xs
        U = uv - jnp.einsum('bhcd,bhde->bhce', wk, S)
        O = jnp.einsum('bhcd,bhde->bhce', qq, S) + jnp.einsum('bhcs,bhse->bhce', p, U)
        S = gg[..., None, None] * S + jnp.einsum('bhcd,bhce->bhde', kk, U)
        return S, O

    xs = tuple(jnp.moveaxis(a, 1, 0) for a in (Uv, Wk, P, qg, kg, gl))
    S, O = lax.scan(step, S0.astype(f32), xs)
    O = jnp.transpose(O, (1, 0, 3, 2, 4)).reshape(B, -1, H, DV)[:, :T]
    return O, S


def deltanet_mixer(u, conv_buf, S0, w_in, conv_w, A_log, dt_bias, o_gain, w_out):
    B, T, _ = u.shape
    proj = u @ w_in
    qkv, z, b_logit, a_logit = jnp.split(proj, [3 * DN_WIDTH, 4 * DN_WIDTH, 4 * DN_WIDTH + DN_HEADS], axis=-1)
    qkv, new_buf = causal_conv(conv_buf, qkv, conv_w)
    q, k, v = jnp.split(jax.nn.silu(qkv), 3, axis=-1)
    q = l2_normalize(q.reshape(B, T, DN_HEADS, DN_HEAD_DIM)) * (DN_HEAD_DIM ** -0.5)
    k = l2_normalize(k.reshape(B, T, DN_HEADS, DN_HEAD_DIM))
    v = v.reshape(B, T, DN_HEADS, DN_HEAD_DIM)
    beta = jax.nn.sigmoid(b_logit.astype(jnp.float32))
    g = -jnp.exp(A_log.astype(jnp.float32)) * jax.nn.softplus(a_logit.astype(jnp.float32) + dt_bias.astype(jnp.float32))
    o, S = gated_delta_chunked(q, k, v, beta, g, S0)
    o = rms_norm(o, o_gain) * jax.nn.silu(z.reshape(B, T, DN_HEADS, DN_HEAD_DIM).astype(jnp.float32))
    return o.reshape(B, T, DN_WIDTH).astype(u.dtype) @ w_out, (new_buf, S)


def macaron_layer(x, mixer, n1, w1i, w1o, nm, n2, w2i, w2o):
    x = x + 0.5 * swiglu(rms_norm(x, n1), w1i, w1o)
    m, new_state = mixer(rms_norm(x, nm))
    x = x + m
    x = x + 0.5 * swiglu(rms_norm(x, n2), w2i, w2o)
    return x, new_state


def setup_inputs(seed: int = 0) -> dict:
    key = jax.random.key(seed)
    keys = iter(jax.random.split(key, 48))
    f32 = jnp.float32

    def nrm(shape, scale):
        return jax.random.normal(next(keys), shape, f32) * scale

    def gain(shape):
        return 1.0 + nrm(shape, 0.02)

    n_pages = PAST_LEN // PAGE_SIZE
    n_used = DEC_BATCH * n_pages
    n_pool = n_used + max(1, n_used // 4)
    bd = LRU_BLOCK_DIM
    x_prompt = nrm((BATCH, SEQ, D_MODEL), 1.0)
    x_sample = nrm((DEC_BATCH, DEC_SEQ, D_MODEL), 1.0)
    cache_k = nrm((N_EVEN, n_pool, PAGE_SIZE, SB_HEADS, SB_HEAD_DIM), 1.0)
    cache_v = nrm((N_EVEN, n_pool, PAGE_SIZE, SB_HEADS, SB_HEAD_DIM), 1.0)
    state_lru_conv = nrm((N_EVEN, DEC_BATCH, CONV_WIDTH - 1, LRU_WIDTH), 1.0)
    state_lru_h = nrm((N_EVEN, DEC_BATCH, LRU_WIDTH), 0.5)
    state_dn_conv = nrm((N_ODD, DEC_BATCH, CONV_WIDTH - 1, 3 * DN_WIDTH), 1.0)
    state_dn_S = nrm((N_ODD, DEC_BATCH, DN_HEADS, DN_HEAD_DIM, DN_HEAD_DIM), DN_HEAD_DIM ** -0.5)
    page_table = jax.random.permutation(next(keys), n_pool)[:n_used].reshape(DEC_BATCH, n_pages).astype(jnp.int32)
    a_c = jax.random.uniform(next(keys), (N_EVEN, LRU_WIDTH), f32, 0.9, 0.999)
    a_base = a_c ** (1.0 / LRU_C)
    lru_lambda = jnp.log(a_base) - jnp.log1p(-a_base)
    dn_A_log = jnp.log(jax.random.uniform(next(keys), (N_ODD, DN_HEADS), f32, 1.0, 16.0))
    dt0 = jnp.exp(jax.random.uniform(next(keys), (N_ODD, DN_HEADS), f32, math.log(1e-3), math.log(1e-1)))
    dn_dt_bias = dt0 + jnp.log(-jnp.expm1(-dt0))
    return {
        'x_prompt': x_prompt, 'x_sample': x_sample,
        'cache_k': cache_k, 'cache_v': cache_v,
        'state_lru_conv': state_lru_conv, 'state_lru_h': state_lru_h,
        'state_dn_conv': state_dn_conv, 'state_dn_S': state_dn_S,
        'page_table': page_table,
        'norm_ffn1': gain((DEPTH, D_MODEL)),
        'w_ffn1_in': nrm((DEPTH, D_MODEL, 2 * D_FF), D_MODEL ** -0.5),
        'w_ffn1_out': nrm((DEPTH, D_FF, D_MODEL), D_FF ** -0.5),
        'norm_mix': gain((DEPTH, D_MODEL)),
        'norm_ffn2': gain((DEPTH, D_MODEL)),
        'w_ffn2_in': nrm((DEPTH, D_MODEL, 2 * D_FF), D_MODEL ** -0.5),
        'w_ffn2_out': nrm((DEPTH, D_FF, D_MODEL), D_FF ** -0.5),
        'w_in_even': nrm((N_EVEN, D_MODEL, EVEN_IN), D_MODEL ** -0.5),
        'sb_q_gain': gain((N_EVEN, SB_HEAD_DIM)),
        'sb_k_gain': gain((N_EVEN, SB_HEAD_DIM)),
        'sb_bias': SB_BIAS_INIT + nrm((N_EVEN, SB_HEADS), 0.1),
        'lru_conv_w': nrm((N_EVEN, CONV_WIDTH, LRU_WIDTH), CONV_WIDTH ** -0.5),
        'lru_conv_b': nrm((N_EVEN, LRU_WIDTH), 0.01),
        'lru_w_a': nrm((N_EVEN, LRU_BLOCKS, bd, bd), bd ** -0.5),
        'lru_b_a': nrm((N_EVEN, LRU_WIDTH), 0.01),
        'lru_w_i': nrm((N_EVEN, LRU_BLOCKS, bd, bd), bd ** -0.5),
        'lru_b_i': nrm((N_EVEN, LRU_WIDTH), 0.01),
        'lru_lambda': lru_lambda,
        'w_out_even': nrm((N_EVEN, SB_WIDTH + LRU_WIDTH, D_MODEL), (SB_WIDTH + LRU_WIDTH) ** -0.5),
        'w_in_odd': nrm((N_ODD, D_MODEL, ODD_IN), D_MODEL ** -0.5),
        'dn_conv_w': nrm((N_ODD, CONV_WIDTH, 3 * DN_WIDTH), CONV_WIDTH ** -0.5),
        'dn_A_log': dn_A_log,
        'dn_dt_bias': dn_dt_bias,
        'dn_o_gain': gain((N_ODD, DN_HEAD_DIM)),
        'w_out_odd': nrm((N_ODD, DN_WIDTH, D_MODEL), DN_WIDTH ** -0.5),
    }


def reference(x_prompt, x_sample, cache_k, cache_v, state_lru_conv, state_lru_h, state_dn_conv, state_dn_S,
              page_table, norm_ffn1, w_ffn1_in, w_ffn1_out, norm_mix, norm_ffn2, w_ffn2_in, w_ffn2_out,
              w_in_even, sb_q_gain, sb_k_gain, sb_bias, lru_conv_w, lru_conv_b, lru_w_a, lru_b_a, lru_w_i, lru_b_i,
              lru_lambda, w_out_even, w_in_odd, dn_conv_w, dn_A_log, dn_dt_bias, dn_o_gain, w_out_odd):
    dt = x_prompt.dtype
    nb_p = x_prompt.shape[0]
    nb_s = x_sample.shape[0]
    n_pages = page_table.shape[1]
    empty_kv = jnp.zeros((nb_p, 0, SB_HEADS, SB_HEAD_DIM), dt)
    zero_lru_conv = jnp.zeros((nb_p, CONV_WIDTH - 1, LRU_WIDTH), dt)
    zero_lru_h = jnp.zeros((nb_p, LRU_WIDTH), jnp.float32)
    zero_dn_conv = jnp.zeros((nb_p, CONV_WIDTH - 1, 3 * DN_WIDTH), dt)
    zero_dn_S = jnp.zeros((nb_p, DN_HEADS, DN_HEAD_DIM, DN_HEAD_DIM), jnp.float32)
    yp, ys = x_prompt, x_sample
    kp, vp, lcp, lhp, dcp, dsp = [], [], [], [], [], []
    ks, vs, lcs, lhs, dcs, dss = [], [], [], [], [], []
    for l in range(DEPTH):
        ffn = (norm_ffn1[l], w_ffn1_in[l], w_ffn1_out[l], norm_mix[l], norm_ffn2[l], w_ffn2_in[l], w_ffn2_out[l])
        if l % 2 == 0:
            e = l // 2
            wts = (w_in_even[e], sb_q_gain[e], sb_k_gain[e], sb_bias[e], lru_conv_w[e], lru_conv_b[e], lru_w_a[e],
                   lru_b_a[e], lru_w_i[e], lru_b_i[e], lru_lambda[e], w_out_even[e])
            past_k = cache_k[e][page_table].reshape(nb_s, n_pages * PAGE_SIZE, SB_HEADS, SB_HEAD_DIM)
            past_v = cache_v[e][page_table].reshape(nb_s, n_pages * PAGE_SIZE, SB_HEADS, SB_HEAD_DIM)
            yp, (k1, v1, c1, h1) = macaron_layer(
                yp, lambda u: sb_lru_mixer(u, empty_kv, empty_kv, zero_lru_conv, zero_lru_h, *wts), *ffn)
            ys, (k2, v2, c2, h2) = macaron_layer(
                ys, lambda u: sb_lru_mixer(u, past_k, past_v, state_lru_conv[e], state_lru_h[e], *wts), *ffn)
            kp.append(k1); vp.append(v1); lcp.append(c1); lhp.append(h1)
            ks.append(k2); vs.append(v2); lcs.append(c2); lhs.append(h2)
        else:
            o = l // 2
            wts = (w_in_odd[o], dn_conv_w[o], dn_A_log[o], dn_dt_bias[o], dn_o_gain[o], w_out_odd[o])
            yp, (c1, S1) = macaron_layer(yp, lambda u: deltanet_mixer(u, zero_dn_conv, zero_dn_S, *wts), *ffn)
            ys, (c2, S2) = macaron_layer(
                ys, lambda u: deltanet_mixer(u, state_dn_conv[o], state_dn_S[o], *wts), *ffn)
            dcp.append(c1); dsp.append(S1)
            dcs.append(c2); dss.append(S2)
    return (yp, ys,
            jnp.stack(kp), jnp.stack(vp), jnp.stack(lcp), jnp.stack(lhp), jnp.stack(dcp), jnp.stack(dsp),
            jnp.stack(ks), jnp.stack(vs), jnp.stack(lcs), jnp.stack(lhs), jnp.stack(dcs), jnp.stack(dss))
```

```cpp
#include <hip/hip_runtime.h>
#include <cstdio>
#include <cstdint>

#define GAS __attribute__((address_space(1)))
#define LAS __attribute__((address_space(3)))
typedef unsigned short bf16;
typedef short bf16x8 __attribute__((ext_vector_type(8)));
typedef short bf16x4 __attribute__((ext_vector_type(4)));
typedef float f32x2 __attribute__((ext_vector_type(2)));
typedef float f32x4 __attribute__((ext_vector_type(4)));
typedef float f32x16 __attribute__((ext_vector_type(16)));
typedef unsigned u32x2 __attribute__((ext_vector_type(2)));
typedef unsigned u32x4 __attribute__((ext_vector_type(4)));
typedef __bf16 bf16v2 __attribute__((ext_vector_type(2)));
#define DI __device__ __forceinline__
DI unsigned pk2(float lo, float hi) { f32x2 v = {lo, hi}; return __builtin_bit_cast(unsigned, __builtin_convertvector(v, bf16v2)); }
DI bf16 f2bf(float f) { return (bf16)(pk2(f, 0.f) & 0xffffu); }
DI float bf2f(bf16 b) { return __builtin_bit_cast(float, ((unsigned)b) << 16); }
DI float bflo(unsigned w) { return __builtin_bit_cast(float, w << 16); }
DI float bfhi(unsigned w) { return __builtin_bit_cast(float, w & 0xffff0000u); }
DI float fexp2(float x) { return __builtin_amdgcn_exp2f(x); }
DI float flog2(float x) { return __builtin_amdgcn_logf(x); }
DI float frcp(float x) { return __builtin_amdgcn_rcpf(x); }
DI float frsq(float x) { return __builtin_amdgcn_rsqf(x); }
#define LOG2E 1.4426950408889634f
#define LN2 0.6931471805599453f
DI float fsigmoid(float x) { return frcp(1.0f + fexp2(-x * LOG2E)); }
DI float fsilu(float x) { return x * fsigmoid(x); }
DI float fsoftplus(float x) { return x > 20.f ? x : LN2 * flog2(1.0f + fexp2(x * LOG2E)); }
DI float fgelu_tanh(float x) { const float u = 0.7978845608028654f * (x + 0.044715f * x * x * x); return x * fsigmoid(2.0f * u); }
DI float fnegexpm1(float x) { const float pl = -x * (1.f + x * (0.5f + x * (0.16666667f + x * (0.041666668f + x * (0.0083333338f + x * 0.0013888889f))))); return x > -0.25f ? pl : 1.0f - fexp2(x * LOG2E); }
#define MFMA32(a, b, c) __builtin_amdgcn_mfma_f32_32x32x16_bf16((a), (b), (c), 0, 0, 0)
#define LDS_WAIT() asm volatile("s_waitcnt lgkmcnt(0)" ::: "memory")
#define VM_WAIT() asm volatile("s_waitcnt vmcnt(0)" ::: "memory")
DI float wave_sum(float v) {
#pragma unroll
    for (int o = 1; o < 64; o <<= 1) v += __shfl_xor(v, o);
    return v;
}

constexpr int DM = 1024, NB_P = 4, T_P = 4096, MP = NB_P * T_P  , NB_S = 128, T_S = 4, MS = NB_S * T_S  , MT = MP + MS  ;
constexpr int PAST = 2048, PAGE = 128, NPAGES = 16, NPOOL = 2560;
constexpr int SBH = 8, SBD = 64, SBW = 512, LRW = 512, DNH = 8, DND = 128, DNW = 1024, DFF = 2048;
constexpr int EVEN_IN = 2560, ODD_IN = 4112, ODD_PAD = 4352;
constexpr float EPS = 1e-6f;
namespace pg8 {
#define PG8_LAS __attribute__((address_space(3)))
typedef unsigned short bf16_t;
constexpr int BM = 256, BK = 64, HALF = 128, HTB = HALF * BK * 2  , STAGE_BYTES = 8 * HTB, NXCD = 8, WGM = 8;

__host__ __device__ __forceinline__ int lds_byte(int r, int c) { const int st = (r >> 4) * 2 + (c >> 5), rr = r & 15, cc = c & 31, ob = rr * 64 + cc * 2; return st * 1024 + (ob ^ (((ob >> 9) & 1) << 5)); }
__host__ __device__ __forceinline__ void stage_rc(int b, int& R, int& C) { const int st = b / 1024, sb = b % 1024, swz = sb ^ (((sb >> 9) & 1) << 5); R = (st >> 1) * 16 + swz / 64; C = (st & 1) * 32 + (swz % 64) / 2; }
__host__ __device__ __forceinline__ int perm32(int rho) { const int n = rho >> 4, i = rho & 15; return 8 * (i >> 2) + 4 * n + (i & 3); }

struct Unit { int pm, pn; };
struct Gemm { const bf16_t* A; const bf16_t* Bt; int M, N, K; };

struct StaticOrder {
    int nM, nN, nwg, G, c;
    __host__ __device__ void init(int M, int N, int G_, int c_) { nM = M / BM; nN = N / BM; nwg = nM * nN; G = G_; c = c_; }
    __host__ __device__ bool next(int i, Unit& u) const {
        const long L = (long)i * G + c; if (L >= nwg) return false;
        int wgid = (int)L; { const int q = nwg / NXCD, r = nwg % NXCD, xcd = wgid % NXCD, off = wgid / NXCD; wgid = (xcd < r ? xcd * (q + 1) : r * (q + 1) + (xcd - r) * q) + off; }
        const int nig = WGM * nN, gid = wgid / nig, fm = gid * WGM, gsz = (nM - fm) < WGM ? (nM - fm) : WGM;
        u.pm = fm + ((wgid % nig) % gsz); u.pn = (wgid % nig) / gsz; return true;
    }
    __device__ __forceinline__ void a_ready(const Unit&) const {}
    __device__ __forceinline__ void done(const Unit&) const {}
};


DI float row_rstd(const float* ssq, int row) { return frsq((float)((const unsigned*)ssq)[row] * (1.f / 1024.f) * (1.f / DM) + EPS); }
DI void ssq_add(float* ssq, int row, float s) { atomicAdd((unsigned*)ssq + row, (unsigned)(s * 1024.f + 0.5f)); }
struct PreNone {};
struct PreRs { unsigned raw[2][4]; DI float rs(int ai, int m) const { return frsq((float)raw[ai][m] * (1.f / 1024.f) * (1.f / DM) + EPS); } };
DI PreRs pre_rstd(const float* ssq, const Unit& u, int wr, int fr) { PreRs p;
#pragma unroll
    for (int ai = 0; ai < 2; ++ai)
#pragma unroll
        for (int m = 0; m < 4; ++m) p.raw[ai][m] = ((const unsigned*)ssq)[u.pm * BM + wr * 64 + fr + ai * HALF + m * 16];
    return p; }
struct EpiSwiglu {
    static constexpr bool PERM = true, AFTER_DRAIN = false;
    bf16_t* H; int ldc; const float* ssq;
    typedef PreRs Pre; DI Pre pre(const Unit& u, int wr, int fr) const { return pre_rstd(ssq, u, wr, fr); }
    __device__ __forceinline__ void operator()(const f32x4 (&acc)[2][2][4][2], const Unit& u, int wr, int wc, int fr, int fq, const Pre& P) const {
        const int row0 = u.pm * BM + wr * 64 + fr, col0 = u.pn * HALF + wc * 32 + 8 * fq;
#pragma unroll
        for (int ai = 0; ai < 2; ++ai)
#pragma unroll
            for (int m = 0; m < 4; ++m) {
                const int row = row0 + ai * HALF + m * 16; const float rs = P.rs(ai, m);
                bf16_t* rowp = H + (size_t)row * ldc + col0;
                const f32x4 g0 = acc[ai][0][m][0] * rs, g1 = acc[ai][0][m][1] * rs, u0 = acc[ai][1][m][0] * rs, u1 = acc[ai][1][m][1] * rs;
                u32x4 w;
                w.x = pk2(fsilu(g0[0]) * u0[0], fsilu(g0[1]) * u0[1]); w.y = pk2(fsilu(g0[2]) * u0[2], fsilu(g0[3]) * u0[3]);
                w.z = pk2(fsilu(g1[0]) * u1[0], fsilu(g1[1]) * u1[1]); w.w = pk2(fsilu(g1[2]) * u1[2], fsilu(g1[3]) * u1[3]);
                *(u32x4*)rowp = w;
            }
    }
};
template <bool BASE_F32, bool OUT_F32> struct EpiResT {
    static constexpr bool PERM = true, AFTER_DRAIN = false;
    const void* base; void* out; float* ssq; float alpha;
    typedef PreNone Pre; DI Pre pre(const Unit&, int, int) const { return Pre{}; }
    __device__ __forceinline__ void operator()(const f32x4 (&acc)[2][2][4][2], const Unit& u, int wr, int wc, int fr, int fq, const Pre&) const {
        const int row0 = u.pm * BM + wr * 64 + fr, col0 = u.pn * BM + wc * 32 + 8 * fq;
#pragma unroll
        for (int ai = 0; ai < 2; ++ai)
#pragma unroll
            for (int m = 0; m < 4; ++m) {
                const int row = row0 + ai * HALF + m * 16; const size_t off = (size_t)row * DM + col0; float s = 0.f;
#pragma unroll
                for (int bj = 0; bj < 2; ++bj) {
                    f32x4 b0, b1;
                    if (BASE_F32) { const float* bp = (const float*)base + off + bj * HALF; b0 = *(const f32x4*)bp; b1 = *(const f32x4*)(bp + 4); }
                    else { const u32x4 w = *(const u32x4*)((const bf16_t*)base + off + bj * HALF); b0 = (f32x4){bflo(w.x), bfhi(w.x), bflo(w.y), bfhi(w.y)}; b1 = (f32x4){bflo(w.z), bfhi(w.z), bflo(w.w), bfhi(w.w)}; }
                    const f32x4 o0 = b0 + acc[ai][bj][m][0] * alpha, o1 = b1 + acc[ai][bj][m][1] * alpha;
                    if (OUT_F32) { float* op = (float*)out + off + bj * HALF; *(f32x4*)op = o0; *(f32x4*)(op + 4) = o1; }
                    else { u32x4 w; w.x = pk2(o0[0], o0[1]); w.y = pk2(o0[2], o0[3]); w.z = pk2(o1[0], o1[1]); w.w = pk2(o1[2], o1[3]); *(u32x4*)((bf16_t*)out + off + bj * HALF) = w; }
                    s += ((o0[0] * o0[0] + o0[1] * o0[1]) + (o0[2] * o0[2] + o0[3] * o0[3])) + ((o1[0] * o1[0] + o1[1] * o1[1]) + (o1[2] * o1[2] + o1[3] * o1[3]));
                }
                if (ssq) { s += __shfl_xor(s, 16); s += __shfl_xor(s, 32); if (fq == 0) ssq_add(ssq, row, s); }
            }
    }
};
struct EpiProj {
    static constexpr bool PERM = true, AFTER_DRAIN = false;
    bf16_t* O; int ldc; const float* ssq;
    typedef PreRs Pre; DI Pre pre(const Unit& u, int wr, int fr) const { return pre_rstd(ssq, u, wr, fr); }
    __device__ __forceinline__ void operator()(const f32x4 (&acc)[2][2][4][2], const Unit& u, int wr, int wc, int fr, int fq, const Pre& P) const {
        const int row0 = u.pm * BM + wr * 64 + fr, col0 = u.pn * BM + wc * 32 + 8 * fq;
#pragma unroll
        for (int ai = 0; ai < 2; ++ai)
#pragma unroll
            for (int m = 0; m < 4; ++m) {
                const int row = row0 + ai * HALF + m * 16; const float rs = P.rs(ai, m);
                bf16_t* rowp = O + (size_t)row * ldc + col0;
#pragma unroll
                for (int bj = 0; bj < 2; ++bj) { const f32x4 v0 = acc[ai][bj][m][0] * rs, v1 = acc[ai][bj][m][1] * rs;
                    u32x4 w; w.x = pk2(v0[0], v0[1]); w.y = pk2(v0[2], v0[3]); w.z = pk2(v1[0], v1[1]); w.w = pk2(v1[2], v1[3]);
                    *(u32x4*)(rowp + bj * HALF) = w; }
            }
    }
};

template <class Epi, class Sched, bool ALIGN_EPI = false, bool SP2 = false>
__device__ __forceinline__ void gemm_phase(PG8_LAS unsigned char* lds, const Gemm g, const Sched& S, const Epi& E) {
    const int tid = threadIdx.x, wid = __builtin_amdgcn_readfirstlane(tid >> 6), lane = tid & 63, wr = wid >> 2, wc = wid & 3, fr = lane & 15, fq = lane >> 4;
    const int K = g.K, nt = K / BK;
    unsigned voffA[2], voffB[2];
#pragma unroll
    for (int i = 0; i < 2; ++i) { int R, C; stage_rc(tid * 16 + i * 8192, R, C); const int Rb = Epi::PERM ? ((R & ~31) + perm32(R & 31)) : R;
        voffA[i] = (unsigned)(R * K + C) * 2u; voffB[i] = (unsigned)(Rb * K + C) * 2u; }
    const size_t kstep = (size_t)(BK * 2);
    const size_t hstep = (size_t)HALF * K * 2;
    const size_t tstep = 2 * hstep;
    const unsigned ldsw = (unsigned)wid * 1024u;
    const int aoff = lds_byte(wr * 64 + fr, fq * 8), boff = lds_byte(wc * 32 + fr, fq * 8);
#define PG8_SA(b, h) (((b) * 2 + (h)) * HTB)
#define PG8_SB(b, h) ((4 + (b) * 2 + (h)) * HTB)
#define PG8_STAGE(bufoff, gbase, voff) do { _Pragma("unroll") for (int _i = 0; _i < 2; ++_i) \
        __builtin_amdgcn_global_load_lds((const unsigned*)((const char*)(gbase) + (voff)[_i]), (PG8_LAS unsigned*)(lds + (bufoff) + ldsw + _i * 8192), 16, 0, 0); } while (0)
#define PG8_LDA(dst, b, h) do { _Pragma("unroll") for (int m = 0; m < 4; ++m) _Pragma("unroll") for (int k = 0; k < 2; ++k) dst[m][k] = *(const PG8_LAS bf16x8*)(lds + PG8_SA(b, h) + aoff + m * 2048 + k * 1024); } while (0)
#define PG8_LDB(dst, b, h) do { _Pragma("unroll") for (int n = 0; n < 2; ++n) _Pragma("unroll") for (int k = 0; k < 2; ++k) dst[n][k] = *(const PG8_LAS bf16x8*)(lds + PG8_SB(b, h) + boff + n * 2048 + k * 1024); } while (0)
#define PG8_MMA(ai, bj, At, Bt) do { __builtin_amdgcn_s_setprio(1); _Pragma("unroll") for (int m = 0; m < 4; ++m) _Pragma("unroll") for (int n = 0; n < 2; ++n) _Pragma("unroll") for (int k = 0; k < 2; ++k) \
        acc[ai][bj][m][n] = __builtin_amdgcn_mfma_f32_16x16x32_bf16(Bt[n][k], At[m][k], acc[ai][bj][m][n], 0, 0, 0); __builtin_amdgcn_s_setprio(0); } while (0)
#define PG8_WAIT_V(n) asm volatile("s_waitcnt vmcnt(" #n ")" ::: "memory")
#define PG8_WAIT_L(n) asm volatile("s_waitcnt lgkmcnt(" #n ")" ::: "memory")
#define PG8_BAR __builtin_amdgcn_s_barrier()
#define PG8_SCHED __builtin_amdgcn_sched_barrier(0)
    Unit cur, nxt; int ui = 0;
    if (!S.next(0, cur)) return;
    f32x4 acc[2][2][4][2];
#pragma unroll
    for (int a = 0; a < 2; ++a)
#pragma unroll
        for (int b = 0; b < 2; ++b)
#pragma unroll
            for (int m = 0; m < 4; ++m)
#pragma unroll
                for (int n = 0; n < 2; ++n) acc[a][b][m][n] = (f32x4){0.f, 0.f, 0.f, 0.f};
    bf16x8 At[4][2], B0[2][2], B1[2][2];
    const char* cA = (const char*)g.A + (size_t)cur.pm * tstep; const char* cB = (const char*)g.Bt + (size_t)cur.pn * tstep;
    S.a_ready(cur);
    if constexpr (SP2) {
        PG8_STAGE(PG8_SB(0, 0), cB, voffB); PG8_STAGE(PG8_SB(0, 1), cB + hstep, voffB); PG8_STAGE(PG8_SA(0, 0), cA, voffA); PG8_STAGE(PG8_SA(0, 1), cA + hstep, voffA);
        if (wr == 1) PG8_BAR;
        PG8_WAIT_V(2); PG8_BAR;
        PG8_STAGE(PG8_SB(1, 0), cB + kstep, voffB); PG8_STAGE(PG8_SA(1, 0), cA + kstep, voffA); PG8_STAGE(PG8_SB(1, 1), cB + hstep + kstep, voffB);
        PG8_WAIT_V(6); PG8_BAR;
    } else {
        PG8_STAGE(PG8_SB(0, 0), cB, voffB); PG8_STAGE(PG8_SA(0, 0), cA, voffA); PG8_STAGE(PG8_SB(0, 1), cB + hstep, voffB); PG8_STAGE(PG8_SA(0, 1), cA + hstep, voffA);
        if (wr == 1) PG8_BAR;
        PG8_WAIT_V(4); PG8_BAR;
        PG8_STAGE(PG8_SB(1, 0), cB + kstep, voffB); PG8_STAGE(PG8_SA(1, 0), cA + kstep, voffA); PG8_STAGE(PG8_SB(1, 1), cB + hstep + kstep, voffB);
        PG8_WAIT_V(6); PG8_BAR;
    }
    for (;;) {
        const bool has_next = S.next(ui + 1, nxt);
        const char* nA = has_next ? (const char*)g.A + (size_t)nxt.pm * tstep : cA; const char* nB = has_next ? (const char*)g.Bt + (size_t)nxt.pn * tstep : cB;
        const typename Epi::Pre pre = E.pre(cur, wr, fr);
        for (int t = 0; t < nt; t += 2) {
            const bool last = (t == nt - 2);
            const char* a1 = cA + (size_t)(t + 1) * kstep;
            const char* a2 = last ? nA : cA + (size_t)(t + 2) * kstep; const char* b2 = last ? nB : cB + (size_t)(t + 2) * kstep;
            const char* a3 = a2 + kstep; const char* b3 = b2 + kstep;
            if (last && has_next) S.a_ready(nxt);
            if constexpr (SP2) {
            PG8_LDB(B0, 0, 0); PG8_LDB(B1, 0, 1); PG8_SCHED; PG8_LDA(At, 0, 0); PG8_STAGE(PG8_SA(1, 1), a1 + hstep, voffA);
            PG8_WAIT_V(8); PG8_WAIT_L(0); PG8_BAR; PG8_MMA(0, 0, At, B0); PG8_MMA(0, 1, At, B1); PG8_BAR; PG8_SCHED;
            PG8_LDA(At, 0, 1); PG8_STAGE(PG8_SB(0, 0), b2, voffB); PG8_STAGE(PG8_SB(0, 1), b2 + hstep, voffB); PG8_STAGE(PG8_SA(0, 0), a2, voffA);
            PG8_WAIT_V(8); PG8_WAIT_L(0); PG8_BAR; PG8_MMA(1, 0, At, B0); PG8_MMA(1, 1, At, B1); PG8_BAR; PG8_SCHED;
            PG8_LDB(B0, 1, 0); PG8_LDB(B1, 1, 1); PG8_SCHED; PG8_LDA(At, 1, 0); PG8_STAGE(PG8_SA(0, 1), a2 + hstep, voffA);
            PG8_WAIT_V(8); PG8_WAIT_L(0); PG8_BAR; PG8_MMA(0, 0, At, B0); PG8_MMA(0, 1, At, B1); PG8_BAR; PG8_SCHED;
            PG8_LDA(At, 1, 1); PG8_STAGE(PG8_SB(1, 0), b3, voffB); PG8_STAGE(PG8_SB(1, 1), b3 + hstep, voffB); PG8_STAGE(PG8_SA(1, 0), a3, voffA);
            PG8_WAIT_V(8); PG8_WAIT_L(0); PG8_BAR; PG8_MMA(1, 0, At, B0); PG8_MMA(1, 1, At, B1); PG8_BAR; PG8_SCHED;
            } else {
            PG8_LDB(B0, 0, 0); PG8_SCHED; PG8_LDA(At, 0, 0); PG8_STAGE(PG8_SA(1, 1), a1 + hstep, voffA);
            PG8_WAIT_L(8); PG8_BAR; PG8_WAIT_L(0); PG8_MMA(0, 0, At, B0); PG8_BAR; PG8_SCHED;
            PG8_LDB(B1, 0, 1); PG8_STAGE(PG8_SB(0, 0), b2, voffB);
            PG8_BAR; PG8_WAIT_L(0); PG8_MMA(0, 1, At, B1); PG8_BAR;
            PG8_LDA(At, 0, 1); PG8_STAGE(PG8_SA(0, 0), a2, voffA);
            PG8_BAR; PG8_WAIT_L(0); PG8_MMA(1, 0, At, B0); PG8_BAR; PG8_SCHED;
            PG8_STAGE(PG8_SB(0, 1), b2 + hstep, voffB);
            PG8_WAIT_V(6); PG8_BAR; PG8_MMA(1, 1, At, B1); PG8_BAR;
            PG8_LDB(B0, 1, 0); PG8_SCHED; PG8_LDA(At, 1, 0); PG8_STAGE(PG8_SA(0, 1), a2 + hstep, voffA);
            PG8_WAIT_L(8); PG8_BAR; PG8_WAIT_L(0); PG8_MMA(0, 0, At, B0); PG8_BAR; PG8_SCHED;
            PG8_LDB(B1, 1, 1); PG8_STAGE(PG8_SB(1, 0), b3, voffB);
            PG8_BAR; PG8_WAIT_L(0); PG8_MMA(0, 1, At, B1); PG8_BAR;
            PG8_LDA(At, 1, 1); PG8_STAGE(PG8_SA(1, 0), a3, voffA);
            PG8_BAR; PG8_WAIT_L(0); PG8_MMA(1, 0, At, B0); PG8_BAR; PG8_SCHED;
            PG8_STAGE(PG8_SB(1, 1), b3 + hstep, voffB);
            PG8_WAIT_V(6); PG8_BAR; PG8_MMA(1, 1, At, B1); PG8_BAR;
            }
        }
        if constexpr (ALIGN_EPI) { if (wr == 0) PG8_BAR; }
        if constexpr (!Epi::AFTER_DRAIN) { E(acc, cur, wr, wc, fr, fq, pre); S.done(cur); }
        if (!has_next) break;
#pragma unroll
        for (int a = 0; a < 2; ++a)
#pragma unroll
            for (int b = 0; b < 2; ++b)
#pragma unroll
                for (int m = 0; m < 4; ++m)
#pragma unroll
                    for (int n = 0; n < 2; ++n) acc[a][b][m][n] = (f32x4){0.f, 0.f, 0.f, 0.f};
        cur = nxt; cA = nA; cB = nB; ++ui;
        if constexpr (ALIGN_EPI) { if (wr == 1) PG8_BAR; }
    }
    PG8_WAIT_V(0);
    if constexpr (!ALIGN_EPI) { if (wr == 0) PG8_BAR; }
    PG8_BAR;
    if constexpr (Epi::AFTER_DRAIN) { E.fused(acc, cur, wr, wc, fr, fq, lds, wid, lane); S.done(cur); }
#undef PG8_SA
#undef PG8_SB
#undef PG8_STAGE
#undef PG8_LDA
#undef PG8_LDB
#undef PG8_MMA
#undef PG8_WAIT_V
#undef PG8_WAIT_L
#undef PG8_BAR
#undef PG8_SCHED
}
}
#define PG8_SP2 true
#define PG8_ALIGN true
#define XB_TMO      128
#define XB_XCNT(j)  (256  + 64 * (j))
#define XB_XSUB(j)  (1280 + 64 * (j))
#define XB_XGEN(j)  (2304 + 64 * (j))
#define XB_TOP      3328
#define XB_TOPGEN   3392
#define XCD_BAR_WORDS 3456
#define XB_SPIN_CAP (1u << 18)


__device__ __forceinline__ unsigned xb_ld(unsigned* p)              { return __hip_atomic_load(p, __ATOMIC_RELAXED, __HIP_MEMORY_SCOPE_AGENT); }
__device__ __forceinline__ unsigned xb_add(unsigned* p, unsigned v) { return __hip_atomic_fetch_add(p, v, __ATOMIC_RELAXED, __HIP_MEMORY_SCOPE_AGENT); }
__device__ __forceinline__ unsigned xb_xcc_id() { return (unsigned)__builtin_amdgcn_s_getreg((3 << 11) | 20) & 0xFu; }
#define XB_SPIN(cond, bar) do { unsigned _sp = 0; while (cond) { __builtin_amdgcn_s_sleep(1); \
    if ((++_sp & 255u) == 0u) { if (xb_ld(&(bar)[XB_TMO])) break; if (_sp > XB_SPIN_CAP) { atomicAdd(&(bar)[XB_TMO], 1u); break; } } } } while (0)

struct XcdBarrier {
    unsigned* bar; unsigned x;
    volatile LAS unsigned* st;
};

__device__ __forceinline__ XcdBarrier xcd_barrier_post(unsigned* bar, volatile LAS unsigned* st) {
    XcdBarrier b; b.bar = bar; b.x = xb_xcc_id(); b.st = st;
    if (threadIdx.x == 0) (void)xb_add(&bar[XB_XCNT(b.x)], 1u);
    return b;
}
__device__ __forceinline__ void xcd_barrier_complete(unsigned* bar, unsigned x, unsigned& nloc, unsigned& nx) {
    const unsigned G = gridDim.x * gridDim.y * gridDim.z;
    unsigned sum, cnt, mine, sp = 0u;
    for (;;) {
        sum = 0u; cnt = 0u; mine = 0u;
#pragma unroll
        for (unsigned j = 0; j < 16; ++j) { const unsigned c = xb_ld(&bar[XB_XCNT(j)]); sum += c; cnt += (c > 0u) ? 1u : 0u; mine = (j == x) ? c : mine; }
        if (sum == G) break;
        __builtin_amdgcn_s_sleep(1);
        if ((++sp & 255u) == 0u) { if (xb_ld(&bar[XB_TMO])) break; if (sp > XB_SPIN_CAP) { atomicAdd(&bar[XB_TMO], 1u); break; } }
    }
    nloc = mine > 0u ? mine : 1u; nx = cnt > 0u ? cnt : 1u;
}

__device__ __forceinline__ void xcd_barrier(const XcdBarrier& b) {
    asm volatile("s_waitcnt vmcnt(0)" ::: "memory");
    __syncthreads();
    if (threadIdx.x == 0) {
        unsigned* bar = b.bar;
        __builtin_amdgcn_s_waitcnt(0);
        unsigned nloc = b.st[0], nx = b.st[1];
        if (nloc == 0u) { xcd_barrier_complete(bar, b.x, nloc, nx); b.st[0] = nloc; b.st[1] = nx; }
        const unsigned old = xb_add(&bar[XB_XSUB(b.x)], 1u);
        const unsigned gen = old / nloc;
        if (old + 1u == (gen + 1u) * nloc) {
            __builtin_amdgcn_fence(__ATOMIC_RELEASE, "agent");
            asm volatile("s_waitcnt vmcnt(0)" ::: "memory");
            const unsigned og = xb_add(&bar[XB_TOP], 1u);
            const unsigned tg = og / nx;
            if (og + 1u == (tg + 1u) * nx) xb_add(&bar[XB_TOPGEN], 1u);
            else XB_SPIN(xb_ld(&bar[XB_TOPGEN]) == tg, bar);
            __builtin_amdgcn_fence(__ATOMIC_ACQUIRE, "agent");
            xb_add(&bar[XB_XGEN(b.x)], 1u);
            asm volatile("s_waitcnt vmcnt(0)" ::: "memory");
        } else {
            XB_SPIN(xb_ld(&bar[XB_XGEN(b.x)]) == gen, bar);
            __builtin_amdgcn_fence(__ATOMIC_ACQUIRE, "agent");
            asm volatile("s_waitcnt vmcnt(0)" ::: "memory");
        }
    }
    __syncthreads();
}

constexpr size_t MiB = 1u << 20;
constexpr size_t WS_CTL = 0, CTL_ZERO_BYTES = 1 * MiB;
constexpr size_t WS_WFIN = 1 * MiB;
constexpr size_t WS_WFOUT = 33 * MiB;
constexpr size_t WS_WINE = 49 * MiB;
constexpr size_t WS_WOUTE = 54 * MiB;
constexpr size_t WS_WINO = 56 * MiB;
constexpr size_t WS_WOUTO = 65 * MiB;
constexpr size_t WS_X = 68 * MiB;
constexpr size_t WS_XN = 134 * MiB;
constexpr size_t WS_H = 167 * MiB;
constexpr size_t WS_PROJ = 233 * MiB;
constexpr size_t WS_QB = 374 * MiB;
constexpr size_t WS_KB = 391 * MiB;
constexpr size_t WS_VT = 408 * MiB;
constexpr size_t WS_VS = 424 * MiB;
constexpr size_t WS_AO = 425 * MiB;
constexpr size_t WS_HL = 458 * MiB;
constexpr size_t WS_PP = 474 * MiB;
constexpr size_t WS_AGG = 490 * MiB;
constexpr size_t WS_UV = 491 * MiB, WS_WK = 523 * MiB, WS_QG = 555 * MiB, WS_KGT = 587 * MiB;
constexpr size_t WS_PM = 619 * MiB;
constexpr size_t WS_GL = 635 * MiB;
constexpr size_t WS_OR = 636 * MiB;
constexpr size_t WS_SPART = 668 * MiB;
constexpr size_t WS_END = 672 * MiB;
constexpr int CW_BAR = 4096;
constexpr int CW_SSQ = 65536;
constexpr int CW_SMPCNT = 32768;
constexpr int CW_QUEUE = 16384;

constexpr size_t O_YP = 0, O_YS = 16777216, O_KP = 17301504, O_VP = 25690112, O_LCP = 34078720, O_LHP = 34084864, O_DCP = 34086912, O_DSP = 34123776,
                 O_KS = 34648064, O_VS = 34910208, O_LCS = 35172352, O_LHS = 35368960, O_DCS = 35434496, O_DSS = 36614144, O_END = 53391360;

constexpr int RING_BYTES = 131072;
constexpr int LDSCTL_OFF = RING_BYTES;
constexpr int LDS_BYTES = 147456;

enum InIdx { I_XP = 0, I_XS, I_CK, I_CV, I_SLC, I_SLH, I_SDC, I_SDS, I_PT, I_NF1, I_WF1I, I_WF1O, I_NM, I_NF2, I_WF2I, I_WF2O,
             I_WINE, I_QG, I_KG, I_SBB, I_LCW, I_LCB, I_LWA, I_LBA, I_LWI, I_LBI, I_LAM, I_WOUTE, I_WINO, I_DCW, I_DAL, I_DDT, I_DOG, I_WOUTO, N_IN };
struct Params { const void* in[N_IN]; float* out; unsigned char* ws; int ph_lo, ph_hi, mode, pad; };
static_assert(sizeof(Params) == (N_IN + 2) * 8 + 16, "Params has no padding");

constexpr int NWAVES = 8, NTHR = 512;
constexpr int PH_PRO = 0, PH_L0 = 1, PH_PER_LAYER = 9, NPH = 1 + 2 * PH_PER_LAYER;
enum LayerPhase { LP_FIN1 = 0, LP_FOUT1, LP_PROJ, LP_MIXA, LP_MIXB, LP_MIXC, LP_OUT, LP_FIN2, LP_FOUT2 };

struct RowId { DI int operator()(int n) const { return n; } };
struct RowSwiglu { DI int operator()(int n) const { return n < DFF ? ((n >> 7) << 8) + (n & 127) : (((n - DFF) >> 7) << 8) + 128 + ((n - DFF) & 127); } };
template <class RM> DI void transpose_item(const float* W, int K, int N, bf16* WT, RM rm, LAS float* scrf, int item, int lane, const float* gain = nullptr) {
    LAS bf16* scr = (LAS bf16*)scrf;
    const int nblk = (N + 63) / 64, kb = item / nblk, nb = item % nblk, k0 = 64 * kb, n0 = 64 * nb;
    { const int kk = lane >> 4, n4 = 4 * (lane & 15); const bool ok = n0 + n4 < N;
      f32x4 v[16];
#pragma unroll
      for (int i = 0; i < 16; ++i) v[i] = ok ? *(const f32x4*)(W + (size_t)(k0 + 4 * i + kk) * N + n0 + n4) : (f32x4){0.f, 0.f, 0.f, 0.f};
      if (gain) {
#pragma unroll
          for (int i = 0; i < 16; ++i) v[i] = v[i] * gain[k0 + 4 * i + kk]; }
#pragma unroll
      for (int i = 0; i < 16; ++i) { u32x2 w; w.x = pk2(v[i][0], v[i][1]); w.y = pk2(v[i][2], v[i][3]); *(LAS u32x2*)(scr + (4 * i + kk) * 68 + n4) = w; } }
    LDS_WAIT(); asm volatile("" ::: "memory");
    const int c = lane & 7;
#pragma unroll
    for (int j = 0; j < 8; ++j) { const int nn = (lane >> 3) + 8 * j, n = n0 + nn; const LAS bf16* s = scr + (8 * c) * 68 + nn;
        u32x4 o;
#pragma unroll
        for (int q = 0; q < 4; ++q) o[q] = (unsigned)s[(2 * q) * 68] | ((unsigned)s[(2 * q + 1) * 68] << 16);
        if (n < N) *(u32x4*)(WT + (size_t)rm(n) * K + k0 + 8 * c) = o; }
    LDS_WAIT(); asm volatile("" ::: "memory");
}
constexpr int I_FIN = (DM / 64) * (2 * DFF / 64), I_FOUT = (DFF / 64) * (DM / 64), I_INE = (DM / 64) * (EVEN_IN / 64), I_SQ = (DM / 64) * (DM / 64), I_INO = (DM / 64) * ((ODD_IN + 63) / 64);
constexpr int IT_FIN = 0, IT_FOUT = 4 * I_FIN, IT_INE = IT_FOUT + 4 * I_FOUT, IT_OUTE = IT_INE + I_INE, IT_OUTO = IT_OUTE + I_SQ, IT_INO = IT_OUTO + I_SQ;
DI void convert_item(const Params& p, LAS float* scr, int it, int lane) {
    unsigned char* ws = p.ws;
    int r = it;
    if (r < 4 * I_FIN) { const int w = r / I_FIN, l = w >> 1, which = w & 1;
        transpose_item((const float*)p.in[which ? I_WF2I : I_WF1I] + (size_t)l * DM * 2 * DFF, DM, 2 * DFF, (bf16*)(ws + WS_WFIN) + (size_t)w * 2 * DFF * DM, RowSwiglu(), scr, r % I_FIN, lane, (const float*)p.in[which ? I_NF2 : I_NF1] + l * DM); return; }
    r -= 4 * I_FIN;
    if (r < 4 * I_FOUT) { const int w = r / I_FOUT, l = w >> 1, which = w & 1;
        transpose_item((const float*)p.in[which ? I_WF2O : I_WF1O] + (size_t)l * DFF * DM, DFF, DM, (bf16*)(ws + WS_WFOUT) + (size_t)w * DM * DFF, RowId(), scr, r % I_FOUT, lane); return; }
    r -= 4 * I_FOUT;
    if (r < I_INE) { transpose_item((const float*)p.in[I_WINE], DM, EVEN_IN, (bf16*)(ws + WS_WINE), RowId(), scr, r, lane, (const float*)p.in[I_NM]); return; }
    r -= I_INE;
    if (r < I_SQ) { transpose_item((const float*)p.in[I_WOUTE], DM, DM, (bf16*)(ws + WS_WOUTE), RowId(), scr, r, lane); return; }
    r -= I_SQ;
    if (r < I_SQ) { transpose_item((const float*)p.in[I_WOUTO], DM, DM, (bf16*)(ws + WS_WOUTO), RowId(), scr, r, lane); return; }
    r -= I_SQ;
    transpose_item((const float*)p.in[I_WINO], DM, ODD_IN, (bf16*)(ws + WS_WINO), RowId(), scr, r, lane, (const float*)p.in[I_NM] + DM);
}
constexpr int DEF_N = I_FIN + I_FOUT + I_SQ;
DI int defer_item(int v) { return v < I_FIN ? IT_FIN + 3 * I_FIN + v : v < I_FIN + I_FOUT ? IT_FOUT + 3 * I_FOUT + (v - I_FIN) : IT_OUTO + (v - I_FIN - I_FOUT); }
DI bool is_deferred(int it) { return (it >= IT_FIN + 2 * I_FIN && it < IT_FIN + 4 * I_FIN) || (it >= IT_FOUT + 2 * I_FOUT && it < IT_FOUT + 4 * I_FOUT) || (it >= IT_OUTO); }
constexpr int DEF2_N = I_FIN + I_FOUT + I_INO;
DI int defer2_item(int v) { return v < I_FIN ? IT_FIN + 2 * I_FIN + v : v < I_FIN + I_FOUT ? IT_FOUT + 2 * I_FOUT + (v - I_FIN) : IT_INO + (v - I_FIN - I_FOUT); }
DI void phase_prologue(const Params& p, LAS unsigned char* lds, int gw, int NGW, int wave, int lane) {
    LAS float* scr = (LAS float*)(lds + wave * 16384);
    constexpr int NITEMS = IT_INO + I_INO;
    for (int it = gw; it < NITEMS; it += NGW) if (!is_deferred(it)) convert_item(p, scr, it, lane);
    { u32x4* z = (u32x4*)((bf16*)(p.ws + WS_WINO) + (size_t)ODD_IN * DM); const int n16 = (ODD_PAD - ODD_IN) * DM * 2 / 16;
      for (int i = gw * 64 + lane; i < n16; i += NGW * 64) z[i] = (u32x4){0u, 0u, 0u, 0u}; }
}
DI void phase_input_rows(const float* src_p, const float* src_s, bf16* xb, float* ssq, int gw, int NGW, int lane) {
    for (int m = gw; m < MT; m += 2 * NGW) {
        const int m1 = m + NGW < MT ? m + NGW : m;
        const float* r0 = m < MP ? src_p + (size_t)m * DM : src_s + (size_t)(m - MP) * DM;
        const float* r1 = m1 < MP ? src_p + (size_t)m1 * DM : src_s + (size_t)(m1 - MP) * DM;
        const f32x4* x0 = (const f32x4*)r0 + lane; const f32x4* x1 = (const f32x4*)r1 + lane; f32x4 v[4], w[4]; float s = 0.f, t = 0.f;
#pragma unroll
        for (int j = 0; j < 4; ++j) { v[j] = x0[64 * j]; w[j] = x1[64 * j]; }
#pragma unroll
        for (int j = 0; j < 4; ++j) { s += (v[j].x * v[j].x + v[j].y * v[j].y) + (v[j].z * v[j].z + v[j].w * v[j].w); t += (w[j].x * w[j].x + w[j].y * w[j].y) + (w[j].z * w[j].z + w[j].w * w[j].w); }
        s = wave_sum(s); t = wave_sum(t);
        u32x2* o0 = (u32x2*)(xb + (size_t)m * DM) + lane; u32x2* o1 = (u32x2*)(xb + (size_t)m1 * DM) + lane;
#pragma unroll
        for (int j = 0; j < 4; ++j) { u32x2 a; a.x = pk2(v[j].x, v[j].y); a.y = pk2(v[j].z, v[j].w); o0[64 * j] = a; }
        if (m1 != m) {
#pragma unroll
            for (int j = 0; j < 4; ++j) { u32x2 a; a.x = pk2(w[j].x, w[j].y); a.y = pk2(w[j].z, w[j].w); o1[64 * j] = a; } }
        if (lane == 0) { ((unsigned*)ssq)[m] = (unsigned)(s * 1024.f + 0.5f); if (m1 != m) ((unsigned*)ssq)[m1] = (unsigned)(t * 1024.f + 0.5f); }
    }
}
constexpr int GS_LD = 72;
template <int ROWS> struct GsRegs { u32x4 a[ROWS / 64], b; };
template <int ROWS> DI void gs_load(GsRegs<ROWS>& R, const bf16* ap, const bf16* bp, int K, int kt) {
#pragma unroll
    for (int rep = 0; rep < ROWS / 64; ++rep) R.a[rep] = *(const u32x4*)(ap + (size_t)(64 * rep) * K + kt * 64);
    R.b = *(const u32x4*)(bp + kt * 64);
}
template <int ROWS> DI void gs_store(const GsRegs<ROWS>& R, LAS unsigned char* buf, int soff) {
#pragma unroll
    for (int rep = 0; rep < ROWS / 64; ++rep) *(LAS u32x4*)(buf + soff + rep * (64 * GS_LD * 2)) = R.a[rep];
    *(LAS u32x4*)(buf + ROWS * GS_LD * 2 + soff) = R.b;
}
template <int ROWS> DI void gs_compute(f32x16& acc0, f32x16& acc1, const LAS unsigned char* ab, int wave, int r, int h2) {
    const LAS unsigned char* bb = ab + ROWS * GS_LD * 2;
#pragma unroll
    for (int s = 0; s < 4; ++s) {
        const bf16x8 a = *(const LAS bf16x8*)(ab + ((32 * wave + r) * GS_LD + 16 * s + 8 * h2) * 2);
        const bf16x8 b0 = *(const LAS bf16x8*)(bb + (r * GS_LD + 16 * s + 8 * h2) * 2), b1 = *(const LAS bf16x8*)(bb + ((32 + r) * GS_LD + 16 * s + 8 * h2) * 2);
        acc0 = MFMA32(a, b0, acc0); acc1 = MFMA32(a, b1, acc1);
    }
}
template <int ROWS, class Epi> DI void gemm_small_unit(LAS unsigned char* lds, const bf16* A, const bf16* Bt, int K, int m0, int n0, int n1, const Epi& E, int tid_, int wave) {
    constexpr int BUF = (ROWS + 64) * GS_LD * 2;
    int tid = tid_; asm volatile("" : "+v"(tid));
    const int lane = tid & 63, r = lane & 31, h2 = lane >> 5;
    const int arow = tid >> 3, ck = tid & 7;
    const bf16* ap = A + (size_t)(m0 + arow) * K + ck * 8;
    const bf16* bp = Bt + (size_t)(arow < 32 ? n0 + arow : n1 + arow - 32) * K + ck * 8;
    const int soff = (arow * GS_LD + ck * 8) * 2;
    f32x16 acc0, acc1;
#pragma unroll
    for (int i = 0; i < 16; ++i) { acc0[i] = 0.f; acc1[i] = 0.f; }
    GsRegs<ROWS> R0, R1, R2, R3;
    gs_load<ROWS>(R0, ap, bp, K, 0); gs_load<ROWS>(R1, ap, bp, K, 1); gs_load<ROWS>(R2, ap, bp, K, 2); gs_load<ROWS>(R3, ap, bp, K, 3);
    gs_store<ROWS>(R0, lds, soff);
    __syncthreads();
    const int nkt = K >> 6;
#define GS_STEP(RF, RN, t) do { gs_load<ROWS>(RF, ap, bp, K, ((t) + 4 < nkt) ? (t) + 4 : nkt - 1); \
        if (wave < ROWS / 32) gs_compute<ROWS>(acc0, acc1, lds + ((t) & 1) * BUF, wave, r, h2); \
        gs_store<ROWS>(RN, lds + (((t) + 1) & 1) * BUF, soff); \
        __syncthreads(); } while (0)
#pragma unroll 1
    for (int kt = 0; kt < nkt; kt += 4) { GS_STEP(R0, R1, kt); GS_STEP(R1, R2, kt + 1); GS_STEP(R2, R3, kt + 2); GS_STEP(R3, R0, kt + 3); }
#undef GS_STEP
    if (wave < ROWS / 32) E(acc0, acc1, m0 + 32 * wave, n0, n1, r, h2);
}
struct SEpiSwiglu { bf16* H; int colbase; const float* ssq;
    DI void operator()(const f32x16& a0, const f32x16& a1, int row0, int, int, int r, int h2) const {
#pragma unroll
        for (int i = 0; i < 16; ++i) { const int row = row0 + (i & 3) + 8 * (i >> 2) + 4 * h2; const float rs = pg8::row_rstd(ssq, row); H[(size_t)row * DFF + colbase + r] = f2bf(fsilu(a0[i] * rs) * (a1[i] * rs)); } } };
template <bool BASE_F32, bool OUT_F32> struct SEpiResT { const void* base; void* out; float* ssq; float alpha;
    DI void operator()(const f32x16& a0, const f32x16& a1, int row0, int n0, int n1, int r, int h2) const {
#pragma unroll
        for (int i = 0; i < 16; ++i) { const int row = row0 + (i & 3) + 8 * (i >> 2) + 4 * h2; const size_t ol = (size_t)(row - MP) * DM, og = (size_t)row * DM;
            const float b0 = BASE_F32 ? ((const float*)base)[ol + n0 + r] : bf2f(((const bf16*)base)[og + n0 + r]), b1 = BASE_F32 ? ((const float*)base)[ol + n1 + r] : bf2f(((const bf16*)base)[og + n1 + r]);
            const float v0 = b0 + alpha * a0[i], v1 = b1 + alpha * a1[i];
            if (OUT_F32) { ((float*)out)[ol + n0 + r] = v0; ((float*)out)[ol + n1 + r] = v1; } else { ((bf16*)out)[og + n0 + r] = f2bf(v0); ((bf16*)out)[og + n1 + r] = f2bf(v1); }
            if (ssq) { float s = v0 * v0 + v1 * v1;
#pragma unroll
                for (int of = 1; of < 32; of <<= 1) s += __shfl_xor(s, of);
                if (r == 0) pg8::ssq_add(ssq, row, s); } } } };
struct SEpiProj { bf16* O; int ldc; const float* ssq;
    DI void operator()(const f32x16& a0, const f32x16& a1, int row0, int n0, int n1, int r, int h2) const {
#pragma unroll
        for (int i = 0; i < 16; ++i) { const int row = row0 + (i & 3) + 8 * (i >> 2) + 4 * h2; const float rs = pg8::row_rstd(ssq, row); const size_t o = (size_t)row * ldc; O[o + n0 + r] = f2bf(a0[i] * rs); O[o + n1 + r] = f2bf(a1[i] * rs); } } };
DI void qkv_row(const Params& p, const bf16* PROJ, int m, int lane, float* kout, float* vout, u32x4& vraw) {
    bf16* QB = (bf16*)(p.ws + WS_QB); bf16* KB = (bf16*)(p.ws + WS_KB);
    const bf16* pr = PROJ + (size_t)m * EVEN_IN;
    const u32x4 q8 = *(const u32x4*)(pr + 8 * lane), k8 = *(const u32x4*)(pr + SBW + 8 * lane), v8 = *(const u32x4*)(pr + 2 * SBW + 8 * lane);
    float q[8], k[8], v[8];
#pragma unroll
    for (int j = 0; j < 4; ++j) { q[2 * j] = bflo(q8[j]); q[2 * j + 1] = bfhi(q8[j]); k[2 * j] = bflo(k8[j]); k[2 * j + 1] = bfhi(k8[j]); v[2 * j] = bflo(v8[j]); v[2 * j + 1] = bfhi(v8[j]); }
    float sq = 0.f, sk = 0.f;
#pragma unroll
    for (int j = 0; j < 8; ++j) { sq += q[j] * q[j]; sk += k[j] * k[j]; }
#pragma unroll
    for (int o = 1; o < 8; o <<= 1) { sq += __shfl_xor(sq, o); sk += __shfl_xor(sk, o); }
    const float rq = frsq(sq * (1.f / SBD) + EPS) * (0.125f * LOG2E), rk = frsq(sk * (1.f / SBD) + EPS);
    const float* qg = (const float*)p.in[I_QG] + 8 * (lane & 7); const float* kg = (const float*)p.in[I_KG] + 8 * (lane & 7);
    const f32x4 qg0 = *(const f32x4*)qg, qg1 = *(const f32x4*)(qg + 4), kg0 = *(const f32x4*)kg, kg1 = *(const f32x4*)(kg + 4);
    float qn[8], kn[8];
#pragma unroll
    for (int j = 0; j < 4; ++j) { qn[j] = q[j] * rq * qg0[j]; qn[4 + j] = q[4 + j] * rq * qg1[j]; kn[j] = k[j] * rk * kg0[j]; kn[4 + j] = k[4 + j] * rk * kg1[j]; }
    u32x4 qo, ko;
#pragma unroll
    for (int j = 0; j < 4; ++j) { qo[j] = pk2(qn[2 * j], qn[2 * j + 1]); ko[j] = pk2(kn[2 * j], kn[2 * j + 1]); }
    *(u32x4*)(QB + (size_t)m * SBW + 8 * lane) = qo; *(u32x4*)(KB + (size_t)m * SBW + 8 * lane) = ko;
    *(f32x4*)(kout + 8 * lane) = (f32x4){kn[0], kn[1], kn[2], kn[3]}; *(f32x4*)(kout + 8 * lane + 4) = (f32x4){kn[4], kn[5], kn[6], kn[7]};
    *(f32x4*)(vout + 8 * lane) = (f32x4){v[0], v[1], v[2], v[3]}; *(f32x4*)(vout + 8 * lane + 4) = (f32x4){v[4], v[5], v[6], v[7]};
    vraw = v8;
}
DI void lru_ab(float r_pre, float i_pre, float xc, float sp_lam8, float& a, float& b) {
    const float rr = fsigmoid(r_pre), ii = fsigmoid(i_pre);
    const float log_a = -sp_lam8 * rr;
    a = fexp2(log_a * LOG2E);
    b = __builtin_amdgcn_sqrtf(fnegexpm1(2.0f * log_a)) * (ii * xc);
}
DI void phase_even_a(const Params& p, LAS unsigned char* lds, int tid, int lane_, int wave, int G) {
    unsigned char* ws = p.ws;
    const bf16* PROJ = (const bf16*)(ws + WS_PROJ);
    bf16* VT = (bf16*)(ws + WS_VT); bf16* VS = (bf16*)(ws + WS_VS); bf16* AO = (bf16*)(ws + WS_AO);
    bf16* HL = (bf16*)(ws + WS_HL); bf16* PP = (bf16*)(ws + WS_PP); float* AGG = (float*)(ws + WS_AGG);
    constexpr int VLD = SBW + 8;
    LAS bf16* vt = (LAS bf16*)lds;
    LAS float* xc = (LAS float*)lds;
    const int ch0 = tid, lane0 = lane_;
    const float* cw = (const float*)p.in[I_LCW];
    const float cw0 = cw[ch0], cw1 = cw[LRW + ch0], cw2 = cw[2 * LRW + ch0], cw3 = cw[3 * LRW + ch0], cb = ((const float*)p.in[I_LCB])[ch0];
    const float b_a = ((const float*)p.in[I_LBA])[ch0], b_i = ((const float*)p.in[I_LBI])[ch0];
    const float sp_lam8 = 8.0f * fsoftplus(-((const float*)p.in[I_LAM])[ch0]);
    f32x2 wa[32], wi[32];
    { const float* pa = (const float*)p.in[I_LWA] + (size_t)wave * 4096 + lane0; const float* pi = (const float*)p.in[I_LWI] + (size_t)wave * 4096 + lane0;
#pragma unroll
      for (int c = 0; c < 32; ++c) { wa[c].x = pa[(2 * c) * 64]; wa[c].y = pa[(2 * c + 1) * 64]; wi[c].x = pi[(2 * c) * 64]; wi[c].y = pi[(2 * c + 1) * 64]; } }
    for (int unit = blockIdx.x; unit < NB_P * 64 + NB_S; unit += G) {
        const bool smp = unit >= NB_P * 64;
        if (!smp) {
            const int b = unit >> 6, c = unit & 63, t0 = c * 64, m0 = b * T_P + t0;
            int tidv = tid; asm volatile("" : "+v"(tidv)); const int lane = tidv & 63, ch = tidv;
#pragma unroll 2
            for (int i = 0; i < 8; ++i) { const int tl = wave * 8 + i, m = m0 + tl; u32x4 vraw;
                qkv_row(p, PROJ, m, lane, p.out + O_KP + (size_t)m * SBW, p.out + O_VP + (size_t)m * SBW, vraw);
                *(LAS u32x4*)(vt + tl * VLD + 8 * lane) = vraw; }
            __syncthreads();
            { const int col = tidv; bf16* dst = VT + ((size_t)(b * SBH) * SBD + col) * T_P + t0;
#pragma unroll
              for (int j = 0; j < 8; ++j) { unsigned w[4];
#pragma unroll
                  for (int i = 0; i < 4; ++i) w[i] = (unsigned)vt[(8 * j + 2 * i) * VLD + col] | ((unsigned)vt[(8 * j + 2 * i + 1) * VLD + col] << 16);
                  *(u32x4*)(dst + 8 * j) = (u32x4){w[0], w[1], w[2], w[3]}; } }
            __syncthreads();
            float x0 = 0.f, x1 = 0.f, x2 = 0.f;
            if (c > 0) { x0 = bf2f(PROJ[(size_t)(m0 - 3) * EVEN_IN + 3 * SBW + ch]); x1 = bf2f(PROJ[(size_t)(m0 - 2) * EVEN_IN + 3 * SBW + ch]); x2 = bf2f(PROJ[(size_t)(m0 - 1) * EVEN_IN + 3 * SBW + ch]); }
#pragma unroll 1
            for (int tb = 0; tb < 64; tb += 16) {
                bf16 xr[16];
#pragma unroll
                for (int t = 0; t < 16; ++t) xr[t] = PROJ[(size_t)(m0 + tb + t) * EVEN_IN + 3 * SBW + ch];
#pragma unroll
                for (int t = 0; t < 16; ++t) { const float x3 = bf2f(xr[t]); xc[(tb + t) * LRW + ch] = cb + cw0 * x0 + cw1 * x1 + cw2 * x2 + cw3 * x3; x0 = x1; x1 = x2; x2 = x3; } }
            if (c == 63) { float* o = p.out + O_LCP + (size_t)b * 3 * LRW + ch; o[0] = x0; o[LRW] = x1; o[2 * LRW] = x2; }
            __syncthreads();
            float h = 0.f, P = 1.f;
#pragma unroll 1
            for (int t = 0; t < 64; ++t) {
                const LAS f32x4* xr4 = (const LAS f32x4*)(xc + t * LRW + wave * 64);
                f32x2 ra = {b_a, 0.f}, rb = {0.f, 0.f}, ia = {b_i, 0.f}, ib = {0.f, 0.f};
#pragma unroll
                for (int c4 = 0; c4 < 16; ++c4) { const f32x4 x = xr4[c4];
                    const f32x2 xl = {x[0], x[1]}, xh = {x[2], x[3]};
                    ra = __builtin_elementwise_fma(xl, wa[2 * c4], ra); rb = __builtin_elementwise_fma(xh, wa[2 * c4 + 1], rb);
                    ia = __builtin_elementwise_fma(xl, wi[2 * c4], ia); ib = __builtin_elementwise_fma(xh, wi[2 * c4 + 1], ib);
                    if ((c4 & 3) == 3) asm volatile("" ::: "memory"); }
                float a, bb; lru_ab((ra.x + ra.y) + (rb.x + rb.y), (ia.x + ia.y) + (ib.x + ib.y), xc[t * LRW + ch], sp_lam8, a, bb);
                h = a * h + bb; P *= a;
                HL[(size_t)(m0 + t) * LRW + ch] = f2bf(h); PP[(size_t)(m0 + t) * LRW + ch] = f2bf(P);
            }
            AGG[((size_t)(b * 64 + c) * 2 + 0) * LRW + ch] = P; AGG[((size_t)(b * 64 + c) * 2 + 1) * LRW + ch] = h;
            __syncthreads();
        } else {
            const int s = unit - NB_P * 64, m0 = MP + 4 * s;
            int chs = tid; asm volatile("" : "+v"(chs)); const int lane = chs & 63;
            if (wave < 4) { const int m = m0 + wave; u32x4 vraw;
                qkv_row(p, PROJ, m, lane, p.out + O_KS + (size_t)(4 * s + wave) * SBW, p.out + O_VS + (size_t)(4 * s + wave) * SBW, vraw);
                *(u32x4*)(VS + (size_t)(4 * s + wave) * SBW + 8 * lane) = vraw; }
            const float* st = (const float*)p.in[I_SLC] + (size_t)s * 3 * LRW + chs;
            float xp[7]; xp[0] = st[0]; xp[1] = st[LRW]; xp[2] = st[2 * LRW];
#pragma unroll
            for (int t = 0; t < 4; ++t) xp[3 + t] = bf2f(PROJ[(size_t)(m0 + t) * EVEN_IN + 3 * SBW + chs]);
#pragma unroll
            for (int t = 0; t < 4; ++t) xc[t * LRW + chs] = cb + cw0 * xp[t] + cw1 * xp[t + 1] + cw2 * xp[t + 2] + cw3 * xp[t + 3];
            { float* o = p.out + O_LCS + (size_t)s * 3 * LRW + chs; o[0] = xp[4]; o[LRW] = xp[5]; o[2 * LRW] = xp[6]; }
            __syncthreads();
            float h = ((const float*)p.in[I_SLH])[(size_t)s * LRW + chs];
#pragma unroll 1
            for (int t = 0; t < 4; ++t) {
                const LAS f32x4* xr4 = (const LAS f32x4*)(xc + t * LRW + wave * 64);
                f32x2 ra = {b_a, 0.f}, rb = {0.f, 0.f}, ia = {b_i, 0.f}, ib = {0.f, 0.f};
#pragma unroll
                for (int c4 = 0; c4 < 16; ++c4) { const f32x4 x = xr4[c4];
                    const f32x2 xl = {x[0], x[1]}, xh = {x[2], x[3]};
                    ra = __builtin_elementwise_fma(xl, wa[2 * c4], ra); rb = __builtin_elementwise_fma(xh, wa[2 * c4 + 1], rb);
                    ia = __builtin_elementwise_fma(xl, wi[2 * c4], ia); ib = __builtin_elementwise_fma(xh, wi[2 * c4 + 1], ib);
                    if ((c4 & 3) == 3) asm volatile("" ::: "memory"); }
                float a, bb; lru_ab((ra.x + ra.y) + (rb.x + rb.y), (ia.x + ia.y) + (ib.x + ib.y), xc[t * LRW + chs], sp_lam8, a, bb);
                h = a * h + bb;
                const float xg = bf2f(PROJ[(size_t)(m0 + t) * EVEN_IN + 4 * SBW + chs]);
                AO[(size_t)(m0 + t) * DM + SBW + chs] = f2bf(h * fgelu_tanh(xg));
            }
            (p.out + O_LHS)[(size_t)s * LRW + chs] = h;
            __syncthreads();
        }
    }
}
DI unsigned queue_next(unsigned* head, volatile LAS unsigned* slot, int tid) {
    if (tid == 0) *slot = __hip_atomic_fetch_add(head, 1u, __ATOMIC_RELAXED, __HIP_MEMORY_SCOPE_AGENT);
    __syncthreads();
    const unsigned u = __builtin_amdgcn_readfirstlane(*slot);
    __syncthreads();
    return u;
}
template <int CTRL> DI float dppf(float x) { return __builtin_bit_cast(float, __builtin_amdgcn_mov_dpp(__builtin_bit_cast(int, x), CTRL, 0xf, 0xf, true)); }
struct SmpAcc { float carry; f32x4 acc[4]; };
struct SmpKV { f32x4 k[4], v[4]; };
DI void smp_key(SmpAcc& A, const f32x4 (&q)[4], const f32x4 K4, const f32x4 V4, float bias2, int c, bool masked) {
    const f32x2 Kl = __builtin_shufflevector(K4, K4, 0, 1), Kh = __builtin_shufflevector(K4, K4, 2, 3);
    f32x2 t0 = Kl * __builtin_shufflevector(q[0], q[0], 0, 1), t1 = Kl * __builtin_shufflevector(q[1], q[1], 0, 1), t2 = Kl * __builtin_shufflevector(q[2], q[2], 0, 1), t3 = Kl * __builtin_shufflevector(q[3], q[3], 0, 1);
    t0 = __builtin_elementwise_fma(Kh, __builtin_shufflevector(q[0], q[0], 2, 3), t0); t1 = __builtin_elementwise_fma(Kh, __builtin_shufflevector(q[1], q[1], 2, 3), t1);
    t2 = __builtin_elementwise_fma(Kh, __builtin_shufflevector(q[2], q[2], 2, 3), t2); t3 = __builtin_elementwise_fma(Kh, __builtin_shufflevector(q[3], q[3], 2, 3), t3);
    const float z0 = t0.x + t0.y, z1 = t1.x + t1.y, z2 = t2.x + t2.y, z3 = t3.x + t3.y;
    const bool b0 = c & 1, b1 = c & 2;
    const float y0 = (b0 ? z2 : z0) + dppf<0xB1>(b0 ? z0 : z2), y1 = (b0 ? z3 : z1) + dppf<0xB1>(b0 ? z1 : z3);
    float x = (b1 ? y1 : y0) + dppf<0x4E>(b1 ? y0 : y1);
    x += dppf<0x124>(x); x += dppf<0x128>(x);
    const float zz = fminf(x + bias2, 80.f), e = fexp2(zz); float kp = frcp(1.0f + e), sg = e * kp;
    if (masked) { kp = 1.f; sg = 0.f; }
    const float w = sg * A.carry;
    A.carry *= kp;
    const float w0 = dppf<0x00>(w), w1 = dppf<0xAA>(w), w2 = dppf<0x55>(w), w3 = dppf<0xFF>(w);
    A.acc[0] += V4 * w0; A.acc[1] += V4 * w1; A.acc[2] += V4 * w2; A.acc[3] += V4 * w3;
}
DI void smp_load(SmpKV& R, const float* ck, const float* cv, int phys, int pos0, int hg, int lane) {
    const size_t base = ((size_t)phys * PAGE + pos0) * SBW + hg * 256 + lane * 4;
#pragma unroll
    for (int u = 0; u < 4; ++u) { R.k[u] = __builtin_nontemporal_load((const f32x4*)(ck + base + (size_t)u * SBW)); R.v[u] = __builtin_nontemporal_load((const f32x4*)(cv + base + (size_t)u * SBW)); }
}
DI void attn_sample_unit(const Params& p, LAS unsigned char* lds, int lane_, int wave, int s, int half) {
    unsigned char* ws = p.ws;
    const bf16* QB = (const bf16*)(ws + WS_QB); const bf16* KB = (const bf16*)(ws + WS_KB); const bf16* VS = (const bf16*)(ws + WS_VS); bf16* AO = (bf16*)(ws + WS_AO);
    int lane = lane_; asm volatile("" : "+v"(lane));
    const int hg = wave & 1, seg = wave >> 1, hh = lane >> 4, c = lane & 15, h = 4 * hg + hh, qme = 2 * (c & 1) + ((c >> 1) & 1);
    const float bias2 = ((const float*)p.in[I_SBB])[h] * LOG2E;
    f32x4 q[4];
#pragma unroll
    for (int i = 0; i < 4; ++i) { const u32x2 w = *(const u32x2*)(QB + (size_t)(MP + 4 * s + i) * SBW + h * SBD + 4 * c); q[i] = (f32x4){bflo(w.x), bfhi(w.x), bflo(w.y), bfhi(w.y)}; }
    SmpAcc A; A.carry = 1.f;
#pragma unroll
    for (int i = 0; i < 4; ++i) A.acc[i] = (f32x4){0.f, 0.f, 0.f, 0.f};
    if (half && seg == 0) {
#pragma unroll
        for (int n = 3; n >= 0; --n) { const u32x2 kw = *(const u32x2*)(KB + (size_t)(MP + 4 * s + n) * SBW + h * SBD + 4 * c), vw = *(const u32x2*)(VS + (size_t)(4 * s + n) * SBW + h * SBD + 4 * c);
            smp_key(A, q, (f32x4){bflo(kw.x), bfhi(kw.x), bflo(kw.y), bfhi(kw.y)}, (f32x4){bflo(vw.x), bfhi(vw.x), bflo(vw.y), bfhi(vw.y)}, bias2, c, n >= qme); } }
    const float* ck = (const float*)p.in[I_CK]; const float* cv = (const float*)p.in[I_CV];
    typedef const __attribute__((address_space(4))) int* cint_p;
    cint_p pt = (cint_p)(unsigned long long)p.in[I_PT] + s * NPAGES + half * 8 + 6 - 2 * seg;
    SmpKV R0, R1, R2, R3;
#define SMP_LOAD(R, sidx) do { const int sn_ = (sidx) < 64 ? (sidx) : 63; const int ph_ = __builtin_amdgcn_readfirstlane(pt[1 - (sn_ >> 5)]); smp_load(R, ck, cv, ph_, 124 - 4 * (sn_ & 31), hg, lane); __builtin_amdgcn_sched_barrier(0); } while (0)
#define SMP_COMP(R) do { _Pragma("unroll") for (int u = 3; u >= 0; --u) smp_key(A, q, R.k[u], R.v[u], bias2, c, false); } while (0)
    SMP_LOAD(R0, 0); SMP_LOAD(R1, 1); SMP_LOAD(R2, 2);
#pragma unroll 1
    for (int st = 0; st < 64; st += 4) {
        SMP_LOAD(R3, st + 3); SMP_COMP(R0);
        SMP_LOAD(R0, st + 4); SMP_COMP(R1);
        SMP_LOAD(R1, st + 5); SMP_COMP(R2);
        SMP_LOAD(R2, st + 6); SMP_COMP(R3);
    }
#undef SMP_LOAD
#undef SMP_COMP
    const float P[4] = {dppf<0x00>(A.carry), dppf<0xAA>(A.carry), dppf<0x55>(A.carry), dppf<0xFF>(A.carry)};
    LAS float* xo = (LAS float*)lds;
    LAS float* xp = (LAS float*)(lds + 32768);
#pragma unroll
    for (int i = 0; i < 4; ++i) *(LAS f32x4*)(xo + ((wave * 4 + i) * 64 + lane) * 4) = A.acc[i];
    *(LAS f32x4*)(xp + (wave * 64 + lane) * 4) = (f32x4){P[0], P[1], P[2], P[3]};
    __syncthreads();
    if (seg == 0) {
        f32x4 o[4]; f32x4 pt_ = {1.f, 1.f, 1.f, 1.f};
#pragma unroll
        for (int i = 0; i < 4; ++i) o[i] = (f32x4){0.f, 0.f, 0.f, 0.f};
#pragma unroll
        for (int sg_ = 3; sg_ >= 0; --sg_) { const int wv = 2 * sg_ + hg; const f32x4 ps = *(const LAS f32x4*)(xp + (wv * 64 + lane) * 4);
#pragma unroll
            for (int i = 0; i < 4; ++i) o[i] = *(const LAS f32x4*)(xo + ((wv * 4 + i) * 64 + lane) * 4) + o[i] * ps[i];
            pt_ = pt_ * ps; }
        float* rec = (float*)(ws + WS_SPART) + (size_t)((s * 2 + hg) * 2 + half) * 1280;
#pragma unroll
        for (int i = 0; i < 4; ++i) *(f32x4*)(rec + (i * 64 + lane) * 4) = o[i];
        *(f32x4*)(rec + 1024 + lane * 4) = pt_;
        asm volatile("s_waitcnt vmcnt(0)" ::: "memory");
        __threadfence();
        asm volatile("s_waitcnt vmcnt(0)" ::: "memory");
        unsigned old = 0;
        if (lane == 0) old = __hip_atomic_fetch_add((unsigned*)(ws + WS_CTL) + CW_SMPCNT + s * 2 + hg, 1u, __ATOMIC_RELAXED, __HIP_MEMORY_SCOPE_AGENT);
        old = __builtin_amdgcn_readfirstlane(old);
        if (old == 1u) {
            __threadfence();
            asm volatile("s_waitcnt vmcnt(0)" ::: "memory");
            const float* orec = (const float*)(ws + WS_SPART) + (size_t)((s * 2 + hg) * 2 + (half ^ 1)) * 1280;
            const f32x4 Po = *(const f32x4*)(orec + 1024 + lane * 4);
#pragma unroll
            for (int i = 0; i < 4; ++i) { const f32x4 oo = *(const f32x4*)(orec + (i * 64 + lane) * 4);
                const f32x4 r = half ? o[i] + oo * pt_[i] : oo + o[i] * Po[i];
                u32x2 w; w.x = pk2(r[0], r[1]); w.y = pk2(r[2], r[3]); *(u32x2*)(AO + (size_t)(MP + 4 * s + i) * DM + h * SBD + 4 * c) = w; }
        }
    }
    __syncthreads();
}
DI void lru_fix_unit(const Params& p, int tid, int b, int c) {
    unsigned char* ws = p.ws;
    const bf16* PROJ = (const bf16*)(ws + WS_PROJ); const bf16* HL = (const bf16*)(ws + WS_HL); const bf16* PP = (const bf16*)(ws + WS_PP); const float* AGG = (const float*)(ws + WS_AGG); bf16* AO = (bf16*)(ws + WS_AO);
    int ch = tid; asm volatile("" : "+v"(ch));
    float carry = 0.f;
#pragma unroll 1
    for (int c0 = 0; c0 < c; c0 += 16) { float P[16], hh[16];
#pragma unroll
        for (int j = 0; j < 16; ++j) { const int cc = c0 + j < c ? c0 + j : c - 1; P[j] = AGG[((size_t)(b * 64 + cc) * 2 + 0) * LRW + ch]; hh[j] = AGG[((size_t)(b * 64 + cc) * 2 + 1) * LRW + ch]; }
#pragma unroll
        for (int j = 0; j < 16; ++j) if (c0 + j < c) carry = P[j] * carry + hh[j]; }
    const int m0 = b * T_P + c * 64; float hlast = 0.f;
#pragma unroll 1
    for (int t0 = 0; t0 < 64; t0 += 16) { bf16 hl[16], pp[16], xg[16];
#pragma unroll
        for (int j = 0; j < 16; ++j) { const size_t m = m0 + t0 + j; hl[j] = HL[m * LRW + ch]; pp[j] = PP[m * LRW + ch]; xg[j] = PROJ[m * EVEN_IN + 4 * SBW + ch]; }
#pragma unroll
        for (int j = 0; j < 16; ++j) { const size_t m = m0 + t0 + j; const float hv = bf2f(hl[j]) + bf2f(pp[j]) * carry; hlast = hv; AO[m * DM + SBW + ch] = f2bf(hv * fgelu_tanh(bf2f(xg[j]))); } }
    if (c == 63) (p.out + O_LHP)[(size_t)b * LRW + ch] = hlast;
}
DI void prompt_tile(const LAS unsigned char* kc, const LAS unsigned char* vc, const bf16x8 (&qf)[4], f32x16 (&accO)[2], float& carry, float bias2, int key0, int Q0, int r, int h2) {
    constexpr int KLD = 72, VLD = 68;
    if (key0 < Q0 + 31) {
        f32x16 sk[2];
#pragma unroll
        for (int kb = 0; kb < 2; ++kb) {
#pragma unroll
            for (int i = 0; i < 16; ++i) sk[kb][i] = bias2;
#pragma unroll
            for (int s = 0; s < 4; ++s) { const bf16x8 a = *(const LAS bf16x8*)(kc + (32 * kb + r) * (KLD * 2) + (16 * s + 8 * h2) * 2); sk[kb] = MFMA32(a, qf[s], sk[kb]); }
        }
        const bool need_mask = key0 + 63 >= Q0;
        f32x2 kp[2][8];
#pragma unroll
        for (int kb = 0; kb < 2; ++kb)
#pragma unroll
            for (int pq = 0; pq < 8; ++pq) {
                f32x2 e2; e2.x = fexp2(sk[kb][2 * pq]); e2.y = fexp2(sk[kb][2 * pq + 1]);
                const f32x2 d2 = e2 + 1.0f;
                f32x2 k2; k2.x = frcp(d2.x); k2.y = frcp(d2.y);
                kp[kb][pq] = k2;
            }
        if (need_mask) {
            asm volatile("" ::: "memory");
            const int lim = Q0 + r - key0 - 4 * h2;
#pragma unroll
            for (int kb = 0; kb < 2; ++kb)
#pragma unroll
                for (int pq = 0; pq < 8; ++pq) { const int ko = 32 * kb + ((2 * pq) & 3) + 8 * ((2 * pq) >> 2); if (ko >= lim) kp[kb][pq].x = 1.f; if (ko + 1 >= lim) kp[kb][pq].y = 1.f; }
        }
        float R[2][4], Rp[2][4];
#pragma unroll
        for (int kb = 0; kb < 2; ++kb)
#pragma unroll
            for (int q = 0; q < 4; ++q) { const f32x2 pr = kp[kb][2 * q] * kp[kb][2 * q + 1]; R[kb][q] = pr.x * pr.y; Rp[kb][q] = __shfl_xor(R[kb][q], 32); }
        float c = carry;
#pragma unroll
        for (int kb = 1; kb >= 0; --kb)
#pragma unroll
            for (int q = 3; q >= 0; --q) {
                const float E3 = c * (h2 ? 1.0f : Rp[kb][q]);
                c *= R[kb][q] * Rp[kb][q];
                const f32x2 ka = kp[kb][2 * q], kc = kp[kb][2 * q + 1];
                const float E2 = E3 * kc.y, E1 = E2 * kc.x, E0 = E1 * ka.y;
                const f32x2 w01 = (1.0f - ka) * (f32x2){E0, E1}, w23 = (1.0f - kc) * (f32x2){E2, E3};
                sk[kb][4 * q] = w01.x; sk[kb][4 * q + 1] = w01.y; sk[kb][4 * q + 2] = w23.x; sk[kb][4 * q + 3] = w23.y;
            }
        carry = c;
#pragma unroll
        for (int kb = 0; kb < 2; ++kb)
#pragma unroll
            for (int s = 0; s < 2; ++s) {
                u32x4 wp;
#pragma unroll
                for (int j = 0; j < 4; ++j) wp[j] = pk2(sk[kb][8 * s + 2 * j], sk[kb][8 * s + 2 * j + 1]);
                const bf16x8 wf = __builtin_bit_cast(bf16x8, wp);
#pragma unroll
                for (int db = 0; db < 2; ++db) {
                    const LAS unsigned char* va = vc + (32 * db + r) * (VLD * 2) + (32 * kb + 16 * s + 4 * h2) * 2;
                    const u32x2 lo = *(const LAS u32x2*)va, hi = *(const LAS u32x2*)(va + 16);
                    const bf16x8 vf = __builtin_bit_cast(bf16x8, (u32x4){lo.x, lo.y, hi.x, hi.y});
                    accO[db] = MFMA32(vf, wf, accO[db]);
                }
            }
    }
}
DI void sample_finish(const Params& p, LAS float* xo, LAS float* xp, const SmpAcc& A, int s, int half, int wave, int hg, int seg, int lane, int h, int c) {
    unsigned char* ws = p.ws; bf16* AO = (bf16*)(ws + WS_AO);
    const float P[4] = {dppf<0x00>(A.carry), dppf<0xAA>(A.carry), dppf<0x55>(A.carry), dppf<0xFF>(A.carry)};
#pragma unroll
    for (int i = 0; i < 4; ++i) *(LAS f32x4*)(xo + ((wave * 4 + i) * 64 + lane) * 4) = A.acc[i];
    *(LAS f32x4*)(xp + (wave * 64 + lane) * 4) = (f32x4){P[0], P[1], P[2], P[3]};
    __syncthreads();
    if (seg == 0) {
        f32x4 o[4]; f32x4 pt_ = {1.f, 1.f, 1.f, 1.f};
#pragma unroll
        for (int i = 0; i < 4; ++i) o[i] = (f32x4){0.f, 0.f, 0.f, 0.f};
#pragma unroll
        for (int sg_ = 3; sg_ >= 0; --sg_) { const int wv = 2 * sg_ + hg; const f32x4 ps = *(const LAS f32x4*)(xp + (wv * 64 + lane) * 4);
#pragma unroll
            for (int i = 0; i < 4; ++i) o[i] = *(const LAS f32x4*)(xo + ((wv * 4 + i) * 64 + lane) * 4) + o[i] * ps[i];
            pt_ = pt_ * ps; }
        float* rec = (float*)(ws + WS_SPART) + (size_t)((s * 2 + hg) * 2 + half) * 1280;
#pragma unroll
        for (int i = 0; i < 4; ++i) *(f32x4*)(rec + (i * 64 + lane) * 4) = o[i];
        *(f32x4*)(rec + 1024 + lane * 4) = pt_;
        asm volatile("s_waitcnt vmcnt(0)" ::: "memory");
        __threadfence();
        asm volatile("s_waitcnt vmcnt(0)" ::: "memory");
        unsigned old = 0;
        if (lane == 0) old = __hip_atomic_fetch_add((unsigned*)(ws + WS_CTL) + CW_SMPCNT + s * 2 + hg, 1u, __ATOMIC_RELAXED, __HIP_MEMORY_SCOPE_AGENT);
        old = __builtin_amdgcn_readfirstlane(old);
        if (old == 1u) {
            __threadfence();
            asm volatile("s_waitcnt vmcnt(0)" ::: "memory");
            const float* orec = (const float*)(ws + WS_SPART) + (size_t)((s * 2 + hg) * 2 + (half ^ 1)) * 1280;
            const f32x4 Po = *(const f32x4*)(orec + 1024 + lane * 4);
#pragma unroll
            for (int i = 0; i < 4; ++i) { const f32x4 oo = *(const f32x4*)(orec + (i * 64 + lane) * 4);
                const f32x4 rr = half ? o[i] + oo * pt_[i] : oo + o[i] * Po[i];
                u32x2 w; w.x = pk2(rr[0], rr[1]); w.y = pk2(rr[2], rr[3]); *(u32x2*)(AO + (size_t)(MP + 4 * s + i) * DM + h * SBD + 4 * c) = w; }
        }
    }
}
DI void phase_even_b(const Params& p, LAS unsigned char* lds, int tid_, int lane_, int wave, int G, int qsel = 0) {
    unsigned char* ws = p.ws;
    unsigned* headP = (unsigned*)(ws + WS_CTL) + CW_QUEUE + 64 * qsel; unsigned* headS = headP + 32;
    volatile LAS unsigned* slot = (volatile LAS unsigned*)(lds + LDSCTL_OFF + 128);
    const bf16* QB = (const bf16*)(ws + WS_QB); const bf16* KB = (const bf16*)(ws + WS_KB); const bf16* VT = (const bf16*)(ws + WS_VT); const bf16* VS = (const bf16*)(ws + WS_VS); bf16* AO = (bf16*)(ws + WS_AO);
    const float* ck = (const float*)p.in[I_CK]; const float* cv = (const float*)p.in[I_CV];
    typedef const __attribute__((address_space(4))) int* cint_p;
    constexpr unsigned N_ATT = NB_P * SBH * 16, N_FIX = NB_P * 64, N_PQ = N_ATT + N_FIX, N_SQ = 2 * NB_S;
    constexpr int KLD = 72, VLD = 68, KBUF = 64 * KLD * 2, VBUF = 64 * VLD * 2;
    LAS unsigned char* kl = lds; LAS unsigned char* vl = lds + 2 * KBUF;
    LAS float* xo = (LAS float*)(lds + 36864); LAS float* xp = (LAS float*)(lds + 36864 + 32768);
    int tid = tid_; asm volatile("" : "+v"(tid));
    const int lane = tid & 63, r = lane & 31, h2 = lane >> 5;
    bool pAct = false, pEmpty = (p.mode == 1); int pb = 0, ph = 0, Q0 = 0, kt = 0, cur = 0;
    bf16x8 qf[4]; f32x16 accO[2]; float pcarry = 1.f, pbias2 = 0.f; u32x4 kr0, vr0, kr1, vr1;
    const int srow = tid >> 3, sch = tid & 7, kdst = srow * (KLD * 2) + sch * 16, vdst = srow * (VLD * 2) + sch * 16;
    const bf16* ksrc = KB; const bf16* vsrc = VT;
    bool sAct = false, sEmpty = (p.mode == 2); int ss = 0, shalf = 0, st = 0;
    const int hg = wave & 1, seg = wave >> 1, hh = lane >> 4, c = lane & 15, sh = 4 * hg + hh, qme = 2 * (c & 1) + ((c >> 1) & 1);
    const float sbias2 = ((const float*)p.in[I_SBB])[sh] * LOG2E;
    LAS f32x4* sq = (LAS f32x4*)(lds + 36864 + 40960) + wave * 256 + lane;
    SmpAcc A; SmpKV R0, R1; cint_p spt = (cint_p)(unsigned long long)p.in[I_PT];
#pragma unroll
    for (int i = 0; i < 4; ++i) { qf[i] = (bf16x8){0, 0, 0, 0, 0, 0, 0, 0}; A.acc[i] = (f32x4){0.f, 0.f, 0.f, 0.f}; }
    A.carry = 1.f;
#pragma unroll
    for (int i = 0; i < 16; ++i) { accO[0][i] = 0.f; accO[1][i] = 0.f; }
    kr0 = (u32x4){0u, 0u, 0u, 0u}; vr0 = kr0; kr1 = kr0; vr1 = kr0;
#pragma unroll
    for (int u = 0; u < 4; ++u) { R0.k[u] = (f32x4){0.f, 0.f, 0.f, 0.f}; R0.v[u] = R0.k[u]; R1.k[u] = R0.k[u]; R1.v[u] = R0.k[u]; }
#define SMP_LOAD(R, sidx) do { const int sn_ = (sidx) < 64 ? (sidx) : 63; const int ph_ = __builtin_amdgcn_readfirstlane(spt[1 - (sn_ >> 5)]); smp_load(R, ck, cv, ph_, 124 - 4 * (sn_ & 31), hg, lane); __builtin_amdgcn_sched_barrier(0); } while (0)
#define EB_ITER(SA, SB, PKA, PVA, PKB, PVB) { \
    bool fresh = false; \
    if (!pAct && !pEmpty) { \
        for (;;) { const unsigned u = queue_next(headP, slot, tid); \
            if (u >= N_PQ) { pEmpty = true; break; } \
            if (u >= N_ATT) { lru_fix_unit(p, tid, (int)((u - N_ATT) >> 6), (int)((u - N_ATT) & 63)); continue; } \
            const int qb = 15 - (int)(u >> 5), bh = (int)(u & 31); pb = bh >> 3; ph = bh & 7; Q0 = qb * 256 + wave * 32; kt = 4 * qb + 3; cur = 0; pcarry = 1.f; \
            pbias2 = ((const float*)p.in[I_SBB])[ph] * LOG2E; \
            { const bf16* qp = QB + (size_t)(pb * T_P + Q0 + r) * SBW + ph * SBD + 8 * h2; _Pragma("unroll") for (int s_ = 0; s_ < 4; ++s_) qf[s_] = *(const bf16x8*)(qp + 16 * s_); } \
            _Pragma("unroll") for (int i = 0; i < 16; ++i) { accO[0][i] = 0.f; accO[1][i] = 0.f; } \
            ksrc = KB + (size_t)(pb * T_P + srow) * SBW + ph * SBD + sch * 8; vsrc = VT + ((size_t)(pb * SBH + ph) * SBD + srow) * T_P + sch * 8; \
            PKA = *(const u32x4*)(ksrc + (size_t)(64 * kt) * SBW); PVA = *(const u32x4*)(vsrc + 64 * kt); \
            { const int k1 = kt > 0 ? kt - 1 : 0; PKB = *(const u32x4*)(ksrc + (size_t)(64 * k1) * SBW); PVB = *(const u32x4*)(vsrc + 64 * k1); } \
            *(LAS u32x4*)(kl + kdst) = PKA; *(LAS u32x2*)(vl + vdst) = (u32x2){PVA.x, PVA.y}; *(LAS u32x2*)(vl + vdst + 8) = (u32x2){PVA.z, PVA.w}; \
            pAct = true; fresh = true; break; } } \
    if (!sAct && !sEmpty) { const unsigned u = queue_next(headS, slot, tid); \
        if (u >= N_SQ) sEmpty = true; \
        else { ss = (int)(u >> 1); shalf = (int)(u & 1); st = 0; sAct = true; A.carry = 1.f; \
            f32x4 q[4]; \
            _Pragma("unroll") for (int i = 0; i < 4; ++i) { A.acc[i] = (f32x4){0.f, 0.f, 0.f, 0.f}; const u32x2 w = *(const u32x2*)(QB + (size_t)(MP + 4 * ss + i) * SBW + sh * SBD + 4 * c); q[i] = (f32x4){bflo(w.x), bfhi(w.x), bflo(w.y), bfhi(w.y)}; sq[64 * i] = q[i]; } \
            spt = (cint_p)(unsigned long long)p.in[I_PT] + ss * NPAGES + shalf * 8 + 6 - 2 * seg; \
            SMP_LOAD(SA, 0); SMP_LOAD(SB, 1); \
            if (shalf && seg == 0) { _Pragma("unroll") for (int n = 3; n >= 0; --n) { const u32x2 kw = *(const u32x2*)(KB + (size_t)(MP + 4 * ss + n) * SBW + sh * SBD + 4 * c), vw = *(const u32x2*)(VS + (size_t)(4 * ss + n) * SBW + sh * SBD + 4 * c); \
                smp_key(A, q, (f32x4){bflo(kw.x), bfhi(kw.x), bflo(kw.y), bfhi(kw.y)}, (f32x4){bflo(vw.x), bfhi(vw.x), bflo(vw.y), bfhi(vw.y)}, sbias2, c, n >= qme); } } } } \
    if (!pAct && !sAct) break; \
    if (fresh) __syncthreads(); \
      \
    { const int k2 = kt > 1 ? kt - 2 : 0; PKA = *(const u32x4*)(ksrc + (size_t)(64 * k2) * SBW); PVA = *(const u32x4*)(vsrc + 64 * k2); __builtin_amdgcn_sched_barrier(0); } \
    if (pAct) { \
        prompt_tile(kl + cur * KBUF, vl + cur * VBUF, qf, accO, pcarry, pbias2, 64 * kt, Q0, r, h2); \
        if (kt > 0) { LAS unsigned char* kn = kl + (cur ^ 1) * KBUF; LAS unsigned char* vn = vl + (cur ^ 1) * VBUF; \
            *(LAS u32x4*)(kn + kdst) = PKB; *(LAS u32x2*)(vn + vdst) = (u32x2){PVB.x, PVB.y}; *(LAS u32x2*)(vn + vdst + 8) = (u32x2){PVB.z, PVB.w}; } } \
    if (sAct) { f32x4 q[4]; _Pragma("unroll") for (int i = 0; i < 4; ++i) q[i] = sq[64 * i]; \
        _Pragma("unroll") for (int u = 3; u >= 0; --u) smp_key(A, q, SA.k[u], SA.v[u], sbias2, c, false); } \
    SMP_LOAD(SA, st + 2); \
    __syncthreads(); \
    if (pAct) { cur ^= 1; if (--kt < 0) { pAct = false; \
            bf16* orow = AO + (size_t)(pb * T_P + Q0 + r) * DM + ph * SBD; \
            _Pragma("unroll") for (int db = 0; db < 2; ++db) _Pragma("unroll") for (int g = 0; g < 4; ++g) { u32x2 w; w.x = pk2(accO[db][4 * g], accO[db][4 * g + 1]); w.y = pk2(accO[db][4 * g + 2], accO[db][4 * g + 3]); \
                *(u32x2*)(orow + 32 * db + 8 * g + 4 * h2) = w; } } } \
    if (sAct && ++st == 64) { sAct = false; sample_finish(p, xo, xp, A, ss, shalf, wave, hg, seg, lane, sh, c); } }
    for (;;) { EB_ITER(R0, R1, kr0, vr0, kr1, vr1) EB_ITER(R1, R0, kr1, vr1, kr0, vr0) }
#undef EB_ITER
#undef SMP_LOAD
}
constexpr int OA_QL = 0, OA_KL = 17408, OA_VL = 34816, OA_KBT = 52224, OA_VBT = 70656, OA_AL = 89088, OA_TL = 106496, OA_G = 115712, OA_BETA = 115968, OA_GRAW = 116224;
constexpr int QLD = 136, TLD = 72, ALD = 68;
constexpr int OA_RAW = OA_KBT, RAWLD = 384, OA_CW = 116480;
DI void oa_dma(const bf16* PROJ, const bf16* zeros, LAS unsigned char* rawb, int unit, int tid, int wave) {
    const int h = unit & 7, c = (unit >> 3) & 63, b = unit >> 9, m0 = b * T_P + c * 64;
#pragma unroll
    for (int rep = 0; rep < 7; ++rep) { const int id = tid + 512 * rep, row = id / 48, sg = id - row * 48, tn = sg >> 4, ck = sg & 15;
        const bool valid = id < 67 * 48 && !(c == 0 && row < 3);
        const bf16* src = valid ? PROJ + (size_t)(m0 - 3 + row) * ODD_PAD + tn * DNW + h * DND + ck * 8 : zeros + (tid & 63) * 8;
        __builtin_amdgcn_global_load_lds((const unsigned*)src, (LAS unsigned*)(rawb + (512 * rep + 64 * wave) * 16), 16, 0, 0); }
}
DI void oa_conv8(const LAS bf16* raw, const LAS float* cwl, int tl, int tn, int ch0, float (&y)[8]) {
    float acc[8];
#pragma unroll
    for (int j = 0; j < 8; ++j) acc[j] = 0.f;
#pragma unroll
    for (int i = 0; i < 4; ++i) {
        const u32x4 x = *(const LAS u32x4*)(raw + (tl + i) * RAWLD + tn * DND + ch0);
        const f32x4 w0 = *(const LAS f32x4*)(cwl + (tn * 4 + i) * DND + ch0), w1 = *(const LAS f32x4*)(cwl + (tn * 4 + i) * DND + ch0 + 4);
        acc[0] += w0[0] * bflo(x.x); acc[1] += w0[1] * bfhi(x.x); acc[2] += w0[2] * bflo(x.y); acc[3] += w0[3] * bfhi(x.y);
        acc[4] += w1[0] * bflo(x.z); acc[5] += w1[1] * bfhi(x.z); acc[6] += w1[2] * bflo(x.w); acc[7] += w1[3] * bfhi(x.w);
    }
#pragma unroll
    for (int j = 0; j < 8; ++j) y[j] = fsilu(acc[j]);
}
DI int perm16c(int k) { return (k & ~12) | ((k & 4) << 1) | ((k & 8) >> 1); }
DI void dn_conv8(const bf16* PROJ, const float* cw, int m, int t_in_seq, int chan, float (&y)[8]) {
    float acc[8];
#pragma unroll
    for (int j = 0; j < 8; ++j) acc[j] = 0.f;
#pragma unroll
    for (int i = 0; i < 4; ++i) {
        if (t_in_seq - 3 + i >= 0) {
            const u32x4 x = *(const u32x4*)(PROJ + (size_t)(m - 3 + i) * ODD_PAD + chan);
            const f32x4 w0 = *(const f32x4*)(cw + i * 3 * DNW + chan), w1 = *(const f32x4*)(cw + i * 3 * DNW + chan + 4);
            acc[0] += w0[0] * bflo(x.x); acc[1] += w0[1] * bfhi(x.x); acc[2] += w0[2] * bflo(x.y); acc[3] += w0[3] * bfhi(x.y);
            acc[4] += w1[0] * bflo(x.z); acc[5] += w1[1] * bfhi(x.z); acc[6] += w1[2] * bflo(x.w); acc[7] += w1[3] * bfhi(x.w);
        }
    }
#pragma unroll
    for (int j = 0; j < 8; ++j) y[j] = fsilu(acc[j]);
}
constexpr int OB2_QL = 0, OB2_KL = 17408, OB2_AL = 34816, OB2_KGT = 52224, OB2_KBT = 70656, OB2_VBT = 89088, OB2_TL = 107520  , OB2_CW = 124928, OB2_GB = 132096  , OB2_LOG = 140288;
DI void phase_odd_a(const Params& p, LAS unsigned char* lds, int tid, int lane_, int wave, int G) {
    unsigned char* ws = p.ws;
    const bf16* PROJ = (const bf16*)(ws + WS_PROJ);
    bf16* UV = (bf16*)(ws + WS_UV); bf16* WK = (bf16*)(ws + WS_WK); bf16* QG = (bf16*)(ws + WS_QG); bf16* KGT = (bf16*)(ws + WS_KGT); bf16* PM = (bf16*)(ws + WS_PM); float* GL = (float*)(ws + WS_GL);
    const float* cw = (const float*)p.in[I_DCW];
    LAS bf16* Ql = (LAS bf16*)(lds + OB2_QL); LAS bf16* Kl = (LAS bf16*)(lds + OB2_KL); LAS float* Al = (LAS float*)(lds + OB2_AL);
    LAS bf16* KgTl = (LAS bf16*)(lds + OB2_KGT); LAS bf16* KbT = (LAS bf16*)(lds + OB2_KBT); LAS bf16* VbT = (LAS bf16*)(lds + OB2_VBT); LAS bf16* Tl = (LAS bf16*)(lds + OB2_TL);
    LAS float* Gw = (LAS float*)(lds + OB2_GB) + wave * 256;
    LAS bf16* Vl = (LAS bf16*)(lds + OB2_TL);
    LAS float* cwl = (LAS float*)(lds + OB2_CW); LAS unsigned* lograw = (LAS unsigned*)(lds + OB2_LOG);
    LAS bf16* raw = (LAS bf16*)(lds + OB2_QL);
    LAS bf16* TT = (LAS bf16*)(lds + OB2_LOG + 512);
    int curh = -1;
    const bf16* zeros = (const bf16*)(ws + WS_WINO) + (size_t)ODD_IN * DM;
    const float negA_all = 0.f; (void)negA_all;
    for (int unit = (int)blockIdx.x - G; unit < NB_P * 64 * DNH; unit += G) {
        int tidv = tid; asm volatile("" : "+v"(tidv));
        const int lane = tidv & 63, r = lane & 31, h2 = lane >> 5, tl = tidv >> 3, part = tidv & 7;
        const bool real = unit >= 0, more = unit + G < NB_P * 64 * DNH;
        const int h = unit & 7, c = (unit >> 3) & 63, b = unit >> 9;
        if (real) {
            const int t0 = c * 64, m0 = b * T_P + t0, m = m0 + tl;
            if (h != curh) { curh = h;
#pragma unroll
                for (int rep = 0; rep < 3; ++rep) { const int id = tidv + 512 * rep, tn = id >> 9, i = (id >> 7) & 3, d = id & 127; cwl[id] = cw[i * 3 * DNW + tn * DNW + h * DND + d]; }
                __syncthreads(); }
            { const float bl = bf2f((bf16)lograw[2 * lane]), al = bf2f((bf16)lograw[2 * lane + 1]);
              float x = -__expf(((const float*)p.in[I_DAL])[h]) * fsoftplus(al + ((const float*)p.in[I_DDT])[h]);
#pragma unroll
              for (int o = 1; o < 64; o <<= 1) { const float y = __shfl_up(x, o); if (lane >= o) x += y; }
              const float be = fsigmoid(bl), glast = __shfl(x, 63);
              Gw[lane] = x; Gw[64 + lane] = be; Gw[128 + lane] = be * __expf(x); Gw[192 + lane] = __expf(glast - x); }
            float qv[16], kv[16], vv[16];
            { float y[8];
              oa_conv8(raw, cwl, tl, 0, part * 16, y);
#pragma unroll
              for (int j = 0; j < 8; ++j) qv[j] = y[j];
              oa_conv8(raw, cwl, tl, 0, part * 16 + 8, y);
#pragma unroll
              for (int j = 0; j < 8; ++j) qv[8 + j] = y[j];
              oa_conv8(raw, cwl, tl, 1, part * 16, y);
#pragma unroll
              for (int j = 0; j < 8; ++j) kv[j] = y[j];
              oa_conv8(raw, cwl, tl, 1, part * 16 + 8, y);
#pragma unroll
              for (int j = 0; j < 8; ++j) kv[8 + j] = y[j];
              oa_conv8(raw, cwl, tl, 2, part * 16, y);
#pragma unroll
              for (int j = 0; j < 8; ++j) vv[j] = y[j];
              oa_conv8(raw, cwl, tl, 2, part * 16 + 8, y);
#pragma unroll
              for (int j = 0; j < 8; ++j) vv[8 + j] = y[j]; }
            float sq = 0.f, sk = 0.f;
#pragma unroll
            for (int j = 0; j < 16; ++j) { sq += qv[j] * qv[j]; sk += kv[j] * kv[j]; }
#pragma unroll
            for (int o = 1; o < 8; o <<= 1) { sq += __shfl_xor(sq, o); sk += __shfl_xor(sk, o); }
            const float rq = frsq(sq + EPS) * 0.08838834764831845f, rk = frsq(sk + EPS);
#pragma unroll
            for (int j = 0; j < 16; ++j) { qv[j] *= rq; kv[j] *= rk; }
            if (c == 63 && tl >= 61) {
                float* o = p.out + O_DCP + (size_t)(b * 3 + (tl - 61)) * 3 * DNW;
#pragma unroll
                for (int tn = 0; tn < 3; ++tn)
#pragma unroll
                    for (int j = 0; j < 16; ++j) { const int chan = tn * DNW + h * DND + part * 16 + j; o[chan] = bf2f(PROJ[(size_t)m * ODD_PAD + chan]); }
            }
            const float Gt = Gw[tl], Glast = Gw[63], bt = Gw[64 + tl];
            __syncthreads();
            { u32x4 w0, w1;
#pragma unroll
              for (int j = 0; j < 4; ++j) { w0[j] = pk2(qv[2 * j], qv[2 * j + 1]); w1[j] = pk2(qv[8 + 2 * j], qv[8 + 2 * j + 1]); }
              *(LAS u32x4*)(Ql + tl * QLD + part * 16) = w0; *(LAS u32x4*)(Ql + tl * QLD + part * 16 + 8) = w1;
#pragma unroll
              for (int j = 0; j < 4; ++j) { w0[j] = pk2(kv[2 * j], kv[2 * j + 1]); w1[j] = pk2(kv[8 + 2 * j], kv[8 + 2 * j + 1]); }
              *(LAS u32x4*)(Kl + tl * QLD + part * 16) = w0; *(LAS u32x4*)(Kl + tl * QLD + part * 16 + 8) = w1;
#pragma unroll
              for (int j = 0; j < 4; ++j) { w0[j] = pk2(vv[2 * j], vv[2 * j + 1]); w1[j] = pk2(vv[8 + 2 * j], vv[8 + 2 * j + 1]); }
              *(LAS u32x4*)(Vl + tl * QLD + part * 16) = w0; *(LAS u32x4*)(Vl + tl * QLD + part * 16 + 8) = w1; }
            { const float eg = __expf(Gt);
              u32x4 w0, w1;
              w0[0] = pk2(qv[0] * eg, qv[1] * eg); w0[1] = pk2(qv[2] * eg, qv[3] * eg); w0[2] = pk2(qv[8] * eg, qv[9] * eg); w0[3] = pk2(qv[10] * eg, qv[11] * eg);
              w1[0] = pk2(qv[4] * eg, qv[5] * eg); w1[1] = pk2(qv[6] * eg, qv[7] * eg); w1[2] = pk2(qv[12] * eg, qv[13] * eg); w1[3] = pk2(qv[14] * eg, qv[15] * eg);
              bf16* qg = QG + (size_t)unit * 8192 + tl * DND + part * 16; *(u32x4*)qg = w0; *(u32x4*)(qg + 8) = w1; }
            if (tidv == 0) GL[unit] = __expf(Glast);
            __syncthreads();
            { const int d = tidv & 127, q16 = tidv >> 7;
              float kq[16], vq[16];
#pragma unroll
              for (int i = 0; i < 16; ++i) { kq[i] = bf2f(Kl[(16 * q16 + i) * QLD + d]); vq[i] = bf2f(Vl[(16 * q16 + i) * QLD + d]); }
              float skk[16], sbt[16], sek[16];
#pragma unroll
              for (int i4 = 0; i4 < 4; ++i4) { const f32x4 a = *(const LAS f32x4*)(Gw + 128 + 16 * q16 + 4 * i4), bq = *(const LAS f32x4*)(Gw + 64 + 16 * q16 + 4 * i4), e4 = *(const LAS f32x4*)(Gw + 192 + 16 * q16 + 4 * i4);
#pragma unroll
                  for (int j = 0; j < 4; ++j) { skk[4 * i4 + j] = a[j]; sbt[4 * i4 + j] = bq[j]; sek[4 * i4 + j] = e4[j]; } }
              u32x4 w0, w1;
#pragma unroll
              for (int j = 0; j < 4; ++j) { w0[j] = pk2(kq[2 * j] * skk[2 * j], kq[2 * j + 1] * skk[2 * j + 1]); w1[j] = pk2(kq[8 + 2 * j] * skk[8 + 2 * j], kq[9 + 2 * j] * skk[9 + 2 * j]); }
              *(LAS u32x4*)(KbT + d * TLD + 16 * q16) = w0; *(LAS u32x4*)(KbT + d * TLD + 16 * q16 + 8) = w1;
#pragma unroll
              for (int j = 0; j < 4; ++j) { w0[j] = pk2(vq[2 * j] * sbt[2 * j], vq[2 * j + 1] * sbt[2 * j + 1]); w1[j] = pk2(vq[8 + 2 * j] * sbt[8 + 2 * j], vq[9 + 2 * j] * sbt[9 + 2 * j]); }
              *(LAS u32x4*)(VbT + d * TLD + 16 * q16) = w0; *(LAS u32x4*)(VbT + d * TLD + 16 * q16 + 8) = w1;
              w0[0] = pk2(kq[0] * sek[0], kq[1] * sek[1]); w0[1] = pk2(kq[2] * sek[2], kq[3] * sek[3]); w0[2] = pk2(kq[8] * sek[8], kq[9] * sek[9]); w0[3] = pk2(kq[10] * sek[10], kq[11] * sek[11]);
              w1[0] = pk2(kq[4] * sek[4], kq[5] * sek[5]); w1[1] = pk2(kq[6] * sek[6], kq[7] * sek[7]); w1[2] = pk2(kq[12] * sek[12], kq[13] * sek[13]); w1[3] = pk2(kq[14] * sek[14], kq[15] * sek[15]);
              *(LAS u32x4*)(KgTl + d * TLD + 16 * q16) = w0; *(LAS u32x4*)(KgTl + d * TLD + 16 * q16 + 8) = w1; }
            { const int ti = (wave >> 1) & 1, tj = wave & 1; const bool isP = wave >= 4;
              const LAS bf16* Asrc = isP ? Ql : Kl;
              f32x16 acc;
#pragma unroll
              for (int i = 0; i < 16; ++i) acc[i] = 0.f;
#pragma unroll
              for (int s = 0; s < 8; ++s) { const bf16x8 a = *(const LAS bf16x8*)(Asrc + (32 * ti + r) * QLD + 16 * s + 8 * h2), bb = *(const LAS bf16x8*)(Kl + (32 * tj + r) * QLD + 16 * s + 8 * h2); acc = MFMA32(a, bb, acc); }
              const int j = 32 * tj + r; const float Gj = Gw[j];
#pragma unroll
              for (int i = 0; i < 16; ++i) { const int row = 32 * ti + (i & 3) + 8 * (i >> 2) + 4 * h2; const float Gi = Gw[row];
                  if (isP) { const float v = row >= j ? acc[i] * __expf(Gi - Gj) : 0.f; PM[(size_t)unit * 4096 + row * 64 + perm16c(j)] = f2bf(v); }
                  else { const float v = row > j ? acc[i] * __expf(Gi - Gj) * Gw[64 + row] : 0.f; Al[row * ALD + j] = v; } } }
            __syncthreads();
            if (wave < 2) {
                const int j = lane & 31, kh = lane >> 5, o = 32 * wave;
                f32x2 R[8];
#pragma unroll
                for (int m = 0; m < 8; ++m) R[m] = (f32x2){0.f, 0.f};
                const LAS float* abase = Al + o * ALD + o + 2 * kh;
#pragma unroll
                for (int i = 0; i < 32; ++i) {
                    f32x2 acc = {0.f, 0.f};
#pragma unroll
                    for (int m = 0; m < (i + 3) / 4; ++m) acc = __builtin_elementwise_fma(*(const LAS f32x2*)(abase + i * ALD + 4 * m), R[m], acc);
                    const float part = acc.x + acc.y;
                    const auto sw = __builtin_amdgcn_permlane32_swap(__float_as_uint(part), __float_as_uint(part), false, false);
                    const float t = ((j == i) ? 1.f : 0.f) - (__uint_as_float(sw[0]) + __uint_as_float(sw[1]));
                    if (kh == ((i >> 1) & 1)) { if (i & 1) R[i >> 2].y = t; else R[i >> 2].x = t; }
                    if (kh == 0) Tl[(o + i) * TLD + o + j] = f2bf(t);
                }
                if (wave == 0) {
#pragma unroll
                    for (int m = 0; m < 8; ++m) *(LAS unsigned*)(TT + j * 40 + 4 * m + 2 * kh) = pk2(R[m].x, R[m].y); }
            } else if (wave == 2) {
                const u32x4 z = {0u, 0u, 0u, 0u};
                *(LAS u32x4*)(Tl + (lane >> 1) * TLD + 32 + (lane & 1) * 16) = z; *(LAS u32x4*)(Tl + (lane >> 1) * TLD + 32 + (lane & 1) * 16 + 8) = z;
            } else {
#pragma unroll
                for (int rep = 0; rep < 4; ++rep) { const int id = (tidv - 192) + 320 * rep;
                    if (id < 1024) { const int row = id >> 3, chk = id & 7; *(u32x4*)(KGT + (size_t)unit * 8192 + row * 64 + chk * 8) = *(const LAS u32x4*)(KgTl + row * TLD + chk * 8); } }
            }
            __syncthreads();
            if (wave == 0) {
                f32x16 X;
#pragma unroll
                for (int i = 0; i < 16; ++i) X[i] = 0.f;
#pragma unroll
                for (int s2 = 0; s2 < 2; ++s2) { const LAS float* ap = Al + (32 + r) * ALD + 16 * s2 + 8 * h2; const f32x4 a0 = *(const LAS f32x4*)ap, a1 = *(const LAS f32x4*)(ap + 4);
                    u32x4 aw; aw[0] = pk2(a0[0], a0[1]); aw[1] = pk2(a0[2], a0[3]); aw[2] = pk2(a1[0], a1[1]); aw[3] = pk2(a1[2], a1[3]);
                    const bf16x8 bfr = *(const LAS bf16x8*)(TT + r * 40 + 16 * s2 + 8 * h2);
                    X = MFMA32(__builtin_bit_cast(bf16x8, aw), bfr, X); }
                f32x16 Y;
#pragma unroll
                for (int i = 0; i < 16; ++i) Y[i] = 0.f;
#pragma unroll
                for (int s2 = 0; s2 < 2; ++s2) { u32x4 xw;
#pragma unroll
                    for (int q = 0; q < 4; ++q) xw[q] = pk2(X[8 * s2 + 2 * q], X[8 * s2 + 2 * q + 1]);
                    const LAS bf16* tp = Tl + (32 + r) * TLD + 32 + 16 * s2 + 4 * h2; const u32x2 lo = *(const LAS u32x2*)tp, hi = *(const LAS u32x2*)(tp + 8);
                    Y = MFMA32(__builtin_bit_cast(bf16x8, (u32x4){lo.x, lo.y, hi.x, hi.y}), __builtin_bit_cast(bf16x8, xw), Y); }
#pragma unroll
                for (int i = 0; i < 16; ++i) Tl[(32 + (i & 3) + 8 * (i >> 2) + 4 * h2) * TLD + r] = f2bf(-Y[i]);
            }
            __syncthreads();
        }
        if (more) {
            oa_dma(PROJ, zeros, lds + OB2_QL, unit + G, tidv, wave);
            if (part == 0) { const int un = unit + G; const bf16* pr = PROJ + (size_t)((un >> 9) * T_P + ((un >> 3) & 63) * 64 + tl) * ODD_PAD + 4 * DNW + (un & 7); lograw[2 * tl] = pr[0]; lograw[2 * tl + 1] = pr[DNH]; } }
        if (real) {
#pragma unroll
            for (int rep = 0; rep < 2; ++rep) {
                const int id = wave + 8 * rep, which = id >> 3, ti = (id >> 2) & 1, tj = id & 3;
                const LAS bf16* Bsrc = which ? KbT : VbT;
                f32x16 acc;
#pragma unroll
                for (int i = 0; i < 16; ++i) acc[i] = 0.f;
#pragma unroll
                for (int s = 0; s < 4; ++s) { const bf16x8 a = *(const LAS bf16x8*)(Tl + (32 * ti + r) * TLD + 16 * s + 8 * h2), bb = *(const LAS bf16x8*)(Bsrc + (32 * tj + r) * TLD + 16 * s + 8 * h2); acc = MFMA32(a, bb, acc); }
                if (which) { bf16* dst = WK + (size_t)unit * 8192; const int colp = perm16c(32 * tj + r);
#pragma unroll
                    for (int i = 0; i < 16; ++i) { const int row = 32 * ti + (i & 3) + 8 * (i >> 2) + 4 * h2; dst[row * DND + colp] = f2bf(acc[i]); } }
                else { u32x4 w0, w1;
#pragma unroll
                    for (int j = 0; j < 4; ++j) { w0[j] = pk2(acc[2 * j], acc[2 * j + 1]); w1[j] = pk2(acc[8 + 2 * j], acc[8 + 2 * j + 1]); }
                    bf16* dst = UV + (size_t)unit * 8192 + (size_t)(((tj * 2 + ti) * 64) + lane) * 16; *(u32x4*)dst = w0; *(u32x4*)(dst + 8) = w1; }
            }
        }
        asm volatile("s_waitcnt vmcnt(0)" ::: "memory");
        __syncthreads();
    }
}
constexpr int OB_WK = 0, OB_QG = 17408, OB_KGT = 34816, OB_PM = 53248, OB_BUF = 62464;
DI bf16x8 pack8(const f32x16& x, int s) {
    u32x4 w;
#pragma unroll
    for (int j = 0; j < 4; ++j) w[j] = pk2(x[8 * s + 2 * j], x[8 * s + 2 * j + 1]);
    return __builtin_bit_cast(bf16x8, w);
}
#define CH_BARRIER() do { asm volatile("s_waitcnt lgkmcnt(0)" ::: "memory"); __builtin_amdgcn_s_barrier(); asm volatile("" ::: "memory"); } while (0)
struct ChainRegs { u32x4 wk[4], qg[4], kg[4], pm[2]; };
DI void chain_load(ChainRegs& R, const bf16* WK, const bf16* QG, const bf16* KGT, const bf16* PM, size_t u, int lt) {
#pragma unroll
    for (int rep = 0; rep < 4; ++rep) { const int id = lt + 256 * rep;
        R.wk[rep] = *(const u32x4*)(WK + u * 8192 + id * 8); R.qg[rep] = *(const u32x4*)(QG + u * 8192 + id * 8); R.kg[rep] = *(const u32x4*)(KGT + u * 8192 + id * 8); }
#pragma unroll
    for (int rep = 0; rep < 2; ++rep) R.pm[rep] = *(const u32x4*)(PM + u * 4096 + (lt + 256 * rep) * 8);
}
DI void chain_store(const ChainRegs& R, LAS unsigned char* buf, int lt) {
#pragma unroll
    for (int rep = 0; rep < 4; ++rep) { const int id = lt + 256 * rep;
        *(LAS u32x4*)(buf + OB_WK + ((id >> 4) * QLD + (id & 15) * 8) * 2) = R.wk[rep]; *(LAS u32x4*)(buf + OB_QG + ((id >> 4) * QLD + (id & 15) * 8) * 2) = R.qg[rep];
        *(LAS u32x4*)(buf + OB_KGT + ((id >> 3) * TLD + (id & 7) * 8) * 2) = R.kg[rep]; }
#pragma unroll
    for (int rep = 0; rep < 2; ++rep) { const int id = lt + 256 * rep; *(LAS u32x4*)(buf + OB_PM + ((id >> 3) * TLD + (id & 7) * 8) * 2) = R.pm[rep]; }
}
DI void chain_step(f32x16 (&Sacc)[4], u32x4 (&uv)[4], const LAS unsigned char* buf, float gl, const bf16* uv_next, bf16* oraw, int r, int h2) {
    const LAS bf16* WKl = (const LAS bf16*)(buf + OB_WK) + r * QLD + 8 * h2; const LAS bf16* QGl = (const LAS bf16*)(buf + OB_QG) + r * QLD + 8 * h2;
    const LAS bf16* KGTl = (const LAS bf16*)(buf + OB_KGT) + r * TLD + 8 * h2; const LAS bf16* PMl = (const LAS bf16*)(buf + OB_PM) + r * TLD + 8 * h2;
#define FR(base, ld, rowblk, kk) (*(const LAS bf16x8*)((base) + (32 * (rowblk)) * (ld) + 16 * (kk)))
    f32x16 U[2], accO[2];
#pragma unroll
    for (int ti = 0; ti < 2; ++ti)
#pragma unroll
        for (int i = 0; i < 16; ++i) { U[ti][i] = 0.f; accO[ti][i] = 0.f; }
    bf16x8 fw[2][2], fq[2][2];
    fw[0][0] = FR(WKl, QLD, 0, 0); fw[0][1] = FR(WKl, QLD, 1, 0); fq[0][0] = FR(QGl, QLD, 0, 0); fq[0][1] = FR(QGl, QLD, 1, 0);
#pragma unroll
    for (int kk = 0; kk < 8; ++kk) { const int cb = kk & 1, nb = cb ^ 1;
        if (kk < 7) { fw[nb][0] = FR(WKl, QLD, 0, kk + 1); fw[nb][1] = FR(WKl, QLD, 1, kk + 1); fq[nb][0] = FR(QGl, QLD, 0, kk + 1); fq[nb][1] = FR(QGl, QLD, 1, kk + 1); }
        const bf16x8 sf = pack8(Sacc[kk >> 1], kk & 1);
        __builtin_amdgcn_sched_barrier(0);
        U[0] = MFMA32(fw[cb][0], sf, U[0]); U[1] = MFMA32(fw[cb][1], sf, U[1]); accO[0] = MFMA32(fq[cb][0], sf, accO[0]); accO[1] = MFMA32(fq[cb][1], sf, accO[1]);
        __builtin_amdgcn_sched_barrier(0); }
    bf16x8 fk[2][4];
#pragma unroll
    for (int d = 0; d < 2; ++d)
#pragma unroll
        for (int k2 = 0; k2 < 4; ++k2) fk[d][k2] = FR(KGTl, TLD, d, k2);
    __builtin_amdgcn_sched_barrier(0);
#pragma unroll
    for (int ti = 0; ti < 2; ++ti)
#pragma unroll
        for (int j = 0; j < 8; ++j) { const unsigned w = uv[2 * ti + (j >> 2)][j & 3]; U[ti][2 * j] = bflo(w) - U[ti][2 * j]; U[ti][2 * j + 1] = bfhi(w) - U[ti][2 * j + 1]; }
    if (uv_next) {
#pragma unroll
        for (int q = 0; q < 4; ++q) uv[q] = *(const u32x4*)(uv_next + (size_t)((q >> 1) * 64) * 16 + (q & 1) * 8); }
    bf16x8 Uf[4];
#pragma unroll
    for (int k2 = 0; k2 < 4; ++k2) Uf[k2] = pack8(U[k2 >> 1], k2 & 1);
    bf16x8 fp[4];
#pragma unroll
    for (int k2 = 0; k2 < 4; ++k2) fp[k2] = FR(PMl, TLD, 0, k2);
    __builtin_amdgcn_sched_barrier(0);
#pragma unroll
    for (int d = 0; d < 2; ++d) {
#pragma unroll
        for (int i = 0; i < 16; ++i) Sacc[d][i] *= gl;
#pragma unroll
        for (int k2 = 0; k2 < 4; ++k2) Sacc[d] = MFMA32(fk[d][k2], Uf[k2], Sacc[d]); }
#pragma unroll
    for (int d = 0; d < 2; ++d)
#pragma unroll
        for (int k2 = 0; k2 < 4; ++k2) fk[d][k2] = FR(KGTl, TLD, 2 + d, k2);
    __builtin_amdgcn_sched_barrier(0);
#pragma unroll
    for (int k2 = 0; k2 < 4; ++k2) accO[0] = MFMA32(fp[k2], Uf[k2], accO[0]);
#pragma unroll
    for (int k2 = 0; k2 < 4; ++k2) fp[k2] = FR(PMl, TLD, 1, k2);
    __builtin_amdgcn_sched_barrier(0);
#pragma unroll
    for (int d = 0; d < 2; ++d) {
#pragma unroll
        for (int i = 0; i < 16; ++i) Sacc[2 + d][i] *= gl;
#pragma unroll
        for (int k2 = 0; k2 < 4; ++k2) Sacc[2 + d] = MFMA32(fk[d][k2], Uf[k2], Sacc[2 + d]); }
#pragma unroll
    for (int k2 = 0; k2 < 4; ++k2) accO[1] = MFMA32(fp[k2], Uf[k2], accO[1]);
#pragma unroll
    for (int ti = 0; ti < 2; ++ti) { u32x4 w0, w1;
#pragma unroll
        for (int j = 0; j < 4; ++j) { w0[j] = pk2(accO[ti][2 * j], accO[ti][2 * j + 1]); w1[j] = pk2(accO[ti][8 + 2 * j], accO[ti][8 + 2 * j + 1]); }
        *(u32x4*)(oraw + (size_t)(ti * 64) * 16) = w0; *(u32x4*)(oraw + (size_t)(ti * 64) * 16 + 8) = w1; }
#undef FR
}
DI void dn_chain_unit(const Params& p, LAS unsigned char* lds, int tid_, int wave, int b, int h, int half) {
    unsigned char* ws = p.ws;
    const bf16* UV = (const bf16*)(ws + WS_UV); const bf16* WK = (const bf16*)(ws + WS_WK); const bf16* QG = (const bf16*)(ws + WS_QG); const bf16* KGT = (const bf16*)(ws + WS_KGT); const bf16* PM = (const bf16*)(ws + WS_PM);
    const float* GL = (const float*)(ws + WS_GL); bf16* OR = (bf16*)(ws + WS_OR);
    int tid = tid_; asm volatile("" : "+v"(tid));
    const size_t ub = (size_t)(b * 64) * 8 + h;
    if (wave >= 4) {
        const int lt = tid - 256;
        ChainRegs R0, R1, R2;
#define CH_CHUNK(i) (ub + 8 * ((i) < 64 ? (i) : 63))
#define CH_LSTEP(n_, RL, RS) do { chain_load(RL, WK, QG, KGT, PM, CH_CHUNK((n_) + 3), lt); chain_store(RS, lds + (((n_) + 1) & 1) * OB_BUF, lt); CH_BARRIER(); } while (0)
        chain_load(R0, WK, QG, KGT, PM, CH_CHUNK(0), lt); chain_load(R1, WK, QG, KGT, PM, CH_CHUNK(1), lt); chain_load(R2, WK, QG, KGT, PM, CH_CHUNK(2), lt);
        chain_store(R0, lds, lt);
        CH_BARRIER();
#pragma unroll 1
        for (int n = 0; n < 63; n += 3) { CH_LSTEP(n, R0, R1); CH_LSTEP(n + 1, R1, R2); CH_LSTEP(n + 2, R2, R0); }
        CH_LSTEP(63, R0, R1);
#undef CH_LSTEP
#undef CH_CHUNK
    } else if (wave >= 2) {
        for (int n = 0; n < 65; ++n) CH_BARRIER();
    } else {
        const int lane = tid & 63, r = lane & 31, h2 = lane >> 5, w = 2 * half + wave;
        f32x16 Sacc[4];
#pragma unroll
        for (int d = 0; d < 4; ++d)
#pragma unroll
            for (int i = 0; i < 16; ++i) Sacc[d][i] = 0.f;
        const size_t lofs = (size_t)((w * 2) * 64 + lane) * 16;
        u32x4 uv[4];
#pragma unroll
        for (int q = 0; q < 4; ++q) uv[q] = *(const u32x4*)(UV + ub * 8192 + lofs + (size_t)((q >> 1) * 64) * 16 + (q & 1) * 8);
        float gl = GL[ub];
        CH_BARRIER();
#pragma unroll 1
        for (int n = 0; n < 64; n += 2) {
            const float gl1 = GL[ub + 8 * (n + 1)];
            chain_step(Sacc, uv, lds, gl, UV + (ub + 8 * (n + 1)) * 8192 + lofs, OR + (ub + 8 * n) * 8192 + lofs, r, h2);
            CH_BARRIER();
            gl = (n + 2 < 64) ? GL[ub + 8 * (n + 2)] : 0.f;
            chain_step(Sacc, uv, lds + OB_BUF, gl1, (n + 2 < 64) ? UV + (ub + 8 * (n + 2)) * 8192 + lofs : (const bf16*)nullptr, OR + (ub + 8 * (n + 1)) * 8192 + lofs, r, h2);
            CH_BARRIER();
        }
        float* so = p.out + O_DSP + (size_t)((b * DNH + h) * DND) * DND;
#pragma unroll
        for (int d = 0; d < 4; ++d)
#pragma unroll
            for (int i = 0; i < 16; ++i) so[(size_t)(32 * d + (i & 3) + 8 * (i >> 2) + 4 * h2) * DND + 32 * w + r] = Sacc[d][i];
    }
    __syncthreads();
}
DI void dn_sample_unit(const Params& p, LAS unsigned char* lds, int tid_, int wave, int s, int h) {
    unsigned char* ws = p.ws;
    const bf16* PROJ = (const bf16*)(ws + WS_PROJ); bf16* AO = (bf16*)(ws + WS_AO);
    LAS float* qkvl = (LAS float*)lds;
    LAS float* red = (LAS float*)(lds + 6144);
    LAS float* red2 = (LAS float*)(lds + 8192);
    LAS float* ol = (LAS float*)(lds + 10240);
    int tid = tid_; asm volatile("" : "+v"(tid));
    const int lane = tid & 63;
    const float* cw = (const float*)p.in[I_DCW];
    if (tid < 384) {
        const int chan = (tid >> 7) * DNW + h * DND + (tid & 127);
        float xp[7];
#pragma unroll
        for (int i = 0; i < 3; ++i) xp[i] = ((const float*)p.in[I_SDC])[(size_t)(s * 3 + i) * 3 * DNW + chan];
#pragma unroll
        for (int t = 0; t < 4; ++t) xp[3 + t] = bf2f(PROJ[(size_t)(MP + 4 * s + t) * ODD_PAD + chan]);
        const float w0 = cw[chan], w1 = cw[3 * DNW + chan], w2 = cw[2 * 3 * DNW + chan], w3 = cw[3 * 3 * DNW + chan];
#pragma unroll
        for (int t = 0; t < 4; ++t) qkvl[t * 384 + tid] = fsilu(w0 * xp[t] + w1 * xp[t + 1] + w2 * xp[t + 2] + w3 * xp[t + 3]);
#pragma unroll
        for (int i = 0; i < 3; ++i) (p.out + O_DCS)[(size_t)(s * 3 + i) * 3 * DNW + chan] = xp[4 + i];
    }
    __syncthreads();
    { const int t = wave >> 1, tn = wave & 1; LAS float* v = qkvl + t * 384 + tn * 128;
      const float a = v[lane], bq = v[lane + 64]; const float sc = frsq(wave_sum(a * a + bq * bq) + EPS) * (tn == 0 ? 0.08838834764831845f : 1.0f);
      v[lane] = a * sc; v[lane + 64] = bq * sc; }
    __syncthreads();
    const int e = tid & 127, qd = tid >> 7;
    float S[32];
    const float* s0 = (const float*)p.in[I_SDS] + ((size_t)(s * DNH + h) * DND + 32 * qd) * DND + e;
#pragma unroll
    for (int j = 0; j < 32; ++j) S[j] = s0[(size_t)j * DND];
    const float negA = -__expf(((const float*)p.in[I_DAL])[h]), dtb = ((const float*)p.in[I_DDT])[h];
#pragma unroll 1
    for (int t = 0; t < 4; ++t) {
        const size_t m = MP + 4 * s + t;
        const float beta = fsigmoid(bf2f(PROJ[m * ODD_PAD + 4 * DNW + h])), dec = __expf(negA * fsoftplus(bf2f(PROJ[m * ODD_PAD + 4 * DNW + DNH + h]) + dtb));
        const LAS float* qt = qkvl + t * 384 + 32 * qd; const LAS float* kt = qt + 128;
        float part = 0.f;
#pragma unroll
        for (int j = 0; j < 32; ++j) { S[j] *= dec; part += kt[j] * S[j]; }
        red[qd * 128 + e] = part;
        __syncthreads();
        const float kS = (red[e] + red[128 + e]) + (red[256 + e] + red[384 + e]);
        const float u = beta * (qkvl[t * 384 + 256 + e] - kS);
        float part2 = 0.f;
#pragma unroll
        for (int j = 0; j < 32; ++j) { S[j] += kt[j] * u; part2 += qt[j] * S[j]; }
        red2[qd * 128 + e] = part2;
        __syncthreads();
        if (qd == 0) ol[t * 128 + e] = (red2[e] + red2[128 + e]) + (red2[256 + e] + red2[384 + e]);
    }
    __syncthreads();
    if (wave < 4) { const int t = wave; const float a = ol[t * 128 + lane], bq = ol[t * 128 + lane + 64];
        const float rn = frsq(wave_sum(a * a + bq * bq) * (1.f / DND) + EPS);
        const size_t m = MP + 4 * s + t; const float* og = (const float*)p.in[I_DOG];
        const float z0 = bf2f(PROJ[m * ODD_PAD + 3 * DNW + h * DND + lane]), z1 = bf2f(PROJ[m * ODD_PAD + 3 * DNW + h * DND + lane + 64]);
        AO[m * DM + h * DND + lane] = f2bf(a * rn * og[lane] * fsilu(z0)); AO[m * DM + h * DND + lane + 64] = f2bf(bq * rn * og[lane + 64] * fsilu(z1)); }
    float* so = p.out + O_DSS + ((size_t)(s * DNH + h) * DND + 32 * qd) * DND + e;
#pragma unroll
    for (int j = 0; j < 32; ++j) so[(size_t)j * DND] = S[j];
    __syncthreads();
}
DI void phase_odd_b(const Params& p, LAS unsigned char* lds, int tid, int lane, int wave, int G, int qsel = 1) {
    unsigned* head = (unsigned*)(p.ws + WS_CTL) + CW_QUEUE + 64 * qsel;
    volatile LAS unsigned* slot = (volatile LAS unsigned*)(lds + LDSCTL_OFF + 128);
    constexpr unsigned N_CH = 2 * NB_P * DNH, N_SMP = NB_S * DNH, N_ALL = N_CH + N_SMP;
    for (;;) {
        unsigned u = queue_next(head, slot, tid);
        if (u >= N_ALL) break;
        const int mode = p.mode;
        if (u < N_CH) { if (mode != 2) dn_chain_unit(p, lds, tid, wave, (int)(u >> 4), (int)((u >> 1) & 7), (int)(u & 1)); continue; }
        u -= N_CH;
        if (mode != 1) dn_sample_unit(p, lds, tid, wave, (int)(u >> 3), (int)(u & 7));
    }
    { unsigned* headC = head + 32; LAS float* scr = (LAS float*)(lds + wave * 16384);
      for (;;) { const unsigned bt = queue_next(headC, slot, tid); if (bt * 8 >= (unsigned)DEF_N) break;
          const int v = (int)bt * 8 + wave; if (v < DEF_N) convert_item(p, scr, defer_item(v), lane & 63); } }
}

DI void phase_odd_c(const Params& p, LAS unsigned char* lds, int tid_, int wave, int G) {
    unsigned char* ws = p.ws;
    const bf16* PROJ = (const bf16*)(ws + WS_PROJ); const bf16* OR = (const bf16*)(ws + WS_OR); bf16* AO = (bf16*)(ws + WS_AO);
    LAS bf16* Ot = (LAS bf16*)lds;
    int tid = tid_; asm volatile("" : "+v"(tid));
    const int tl = tid >> 3, part = tid & 7;
    const float* og = (const float*)p.in[I_DOG] + part * 16;
    const f32x4 g0 = *(const f32x4*)og, g1 = *(const f32x4*)(og + 4), g2 = *(const f32x4*)(og + 8), g3 = *(const f32x4*)(og + 12);
    const float gg[16] = {g0[0], g0[1], g0[2], g0[3], g1[0], g1[1], g1[2], g1[3], g2[0], g2[1], g2[2], g2[3], g3[0], g3[1], g3[2], g3[3]};
    constexpr int NU = NB_P * 64 * DNH;
    u32x4 orn[2], zn[2];
    { const int u0 = (int)blockIdx.x < NU ? (int)blockIdx.x : 0; const int h = u0 & 7, c = (u0 >> 3) & 63, b = u0 >> 9; const size_t m = (size_t)(b * T_P + c * 64 + tl);
#pragma unroll
      for (int rep = 0; rep < 2; ++rep) orn[rep] = *(const u32x4*)(OR + (size_t)u0 * 8192 + (size_t)(tid + 512 * rep) * 8);
      zn[0] = *(const u32x4*)(PROJ + m * ODD_PAD + 3 * DNW + h * DND + part * 16); zn[1] = *(const u32x4*)(PROJ + m * ODD_PAD + 3 * DNW + h * DND + part * 16 + 8); }
    for (int unit = blockIdx.x; unit < NU; unit += G) {
        const int h = unit & 7, c = (unit >> 3) & 63, b = unit >> 9, m0 = b * T_P + c * 64;
        const u32x4 z0 = zn[0], z1 = zn[1];
#pragma unroll
        for (int rep = 0; rep < 2; ++rep) { const int q = tid + 512 * rep;
            const int half = q & 1, lane = (q >> 1) & 63, ti = (q >> 7) & 1, w = q >> 8, r = lane & 31, h2 = lane >> 5;
            const u32x4 v = orn[rep];
#pragma unroll
            for (int j = 0; j < 8; ++j) { const int i = 8 * half + j, tok = 32 * ti + (i & 3) + 8 * (i >> 2) + 4 * h2;
                Ot[tok * QLD + 32 * w + r] = (bf16)((j & 1) ? (v[j >> 1] >> 16) : (v[j >> 1] & 0xffffu)); } }
        { const int un = unit + G < NU ? unit + G : unit; const int hn = un & 7, cn = (un >> 3) & 63, bn = un >> 9; const size_t mn = (size_t)(bn * T_P + cn * 64 + tl);
#pragma unroll
          for (int rep = 0; rep < 2; ++rep) orn[rep] = *(const u32x4*)(OR + (size_t)un * 8192 + (size_t)(tid + 512 * rep) * 8);
          zn[0] = *(const u32x4*)(PROJ + mn * ODD_PAD + 3 * DNW + hn * DND + part * 16); zn[1] = *(const u32x4*)(PROJ + mn * ODD_PAD + 3 * DNW + hn * DND + part * 16 + 8); }
        const size_t m = m0 + tl;
        __syncthreads();
        const u32x4 o0 = *(const LAS u32x4*)(Ot + tl * QLD + part * 16), o1 = *(const LAS u32x4*)(Ot + tl * QLD + part * 16 + 8);
        float o[16], z[16];
#pragma unroll
        for (int j = 0; j < 4; ++j) { o[2 * j] = bflo(o0[j]); o[2 * j + 1] = bfhi(o0[j]); o[8 + 2 * j] = bflo(o1[j]); o[8 + 2 * j + 1] = bfhi(o1[j]);
            z[2 * j] = bflo(z0[j]); z[2 * j + 1] = bfhi(z0[j]); z[8 + 2 * j] = bflo(z1[j]); z[8 + 2 * j + 1] = bfhi(z1[j]); }
        float ss = 0.f;
#pragma unroll
        for (int j = 0; j < 16; ++j) ss += o[j] * o[j];
#pragma unroll
        for (int of = 1; of < 8; of <<= 1) ss += __shfl_xor(ss, of);
        const float rn = frsq(ss * (1.f / DND) + EPS);
        u32x4 w0, w1;
#pragma unroll
        for (int j = 0; j < 4; ++j) { w0[j] = pk2(o[2 * j] * rn * gg[2 * j] * fsilu(z[2 * j]), o[2 * j + 1] * rn * gg[2 * j + 1] * fsilu(z[2 * j + 1]));
            w1[j] = pk2(o[8 + 2 * j] * rn * gg[8 + 2 * j] * fsilu(z[8 + 2 * j]), o[8 + 2 * j + 1] * rn * gg[8 + 2 * j + 1] * fsilu(z[8 + 2 * j + 1])); }
        bf16* dst = AO + m * DM + h * DND + part * 16; *(u32x4*)dst = w0; *(u32x4*)(dst + 8) = w1;
        __syncthreads();
    }
}
DI void small_swiglu(LAS unsigned char* lds, const bf16* XB, const bf16* Wt, bf16* HB, const float* ssq, int tid, int wave, int G) {
    for (int su = G - 1 - (int)blockIdx.x; su < 4 * (DFF / 32); su += G) { const int rt = su & 3, j = su >> 2, n0 = ((32 * j) >> 7) * 256 + ((32 * j) & 127);
        gemm_small_unit<128>(lds, XB, Wt, DM, MP + 128 * rt, n0, n0 + 128, SEpiSwiglu{HB, 32 * j, ssq}, tid, wave); }
}
template <bool BASE_F32, bool OUT_F32> DI void small_res(LAS unsigned char* lds, const bf16* A, const bf16* Wt, int K, const void* base, void* out, float alpha, float* ssq, int tid, int wave, int G) {
    for (int su = G - 1 - (int)blockIdx.x; su < 8 * (DM / 64); su += G) { const int rt = su & 7, j = su >> 3;
        gemm_small_unit<64>(lds, A, Wt, K, MP + 64 * rt, 64 * j, 64 * j + 32, SEpiResT<BASE_F32, OUT_F32>{base, out, ssq, alpha}, tid, wave); }
}
DI void small_proj_e(LAS unsigned char* lds, const bf16* XB, const bf16* Wt, bf16* PROJ, const float* ssq, int tid, int wave, int G) {
    if ((int)blockIdx.x < G / 2) return;
    for (int su = G - 1 - (int)blockIdx.x; su < 4 * (EVEN_IN / 64); su += G / 2) { const int rt = su & 3, j = su >> 2;
        gemm_small_unit<128>(lds, XB, Wt, DM, MP + 128 * rt, 64 * j, 64 * j + 32, SEpiProj{PROJ, EVEN_IN, ssq}, tid, wave); }
}
DI void small_proj(LAS unsigned char* lds, const bf16* XB, const bf16* Wt, bf16* PROJ, int ldc, int ngrp, int with_logits, const float* ssq, int tid, int wave, int G) {
    const int nsmp = 2 * ngrp, nall = nsmp + (with_logits ? MP / 256 : 0);
    for (int su = G - 1 - (int)blockIdx.x; su < nall; su += G) {
        int m0, j; if (su < nsmp) { m0 = MP + 256 * (su & 1); j = su >> 1; } else { m0 = 256 * (su - nsmp); j = ngrp - 1; }
        gemm_small_unit<256>(lds, XB, Wt, DM, m0, 64 * j, 64 * j + 32, SEpiProj{PROJ, ldc, ssq}, tid, wave); }
}
#ifndef PROBE_MASK
#define PROBE_MASK 0
#endif
#ifndef PROBE_MODE
#define PROBE_MODE 0
#endif
#define IN(k) (lo <= (k) && (k) < hi)
#define SEAM(k) do { if (IN(k) && IN((k) + 1)) xcd_barrier(bar); } while (0)
template <int l> DI void run_layer(const Params& p, LAS unsigned char* lds, const XcdBarrier& bar, int lo, int hi, int tid, int lane, int wave, int G, int gw, int NGW) {
    unsigned char* ws = p.ws;
    float* X = (float*)(ws + WS_X); bf16* XB = (bf16*)(ws + WS_XN); bf16* HB = (bf16*)(ws + WS_H); bf16* PROJ = (bf16*)(ws + WS_PROJ); bf16* AO = (bf16*)(ws + WS_AO);
    float* Xs = X + (size_t)MP * DM;
    float* SSQ = (float*)(ws + WS_CTL) + CW_SSQ;
    const float* xp = (const float*)p.in[I_XP]; const float* xs = (const float*)p.in[I_XS];
    const int pb = PH_L0 + l * PH_PER_LAYER;
    if (IN(pb + LP_FIN1)) {
        const bf16* Wt = (const bf16*)(ws + WS_WFIN) + (size_t)(l * 2) * 2 * DFF * DM; const float* sq = SSQ + (size_t)(3 * l + 0) * MT;
        pg8::Gemm g{XB, Wt, MP, 2 * DFF, DM}; pg8::StaticOrder S; S.init(MP, 2 * DFF, G, (int)blockIdx.x);
        pg8::EpiSwiglu E{HB, DFF, sq};
        pg8::gemm_phase<pg8::EpiSwiglu, pg8::StaticOrder, PG8_ALIGN, PG8_SP2>(lds, g, S, E);
        small_swiglu(lds, XB, Wt, HB, sq, tid, wave, G);
    }
    SEAM(pb + LP_FIN1);
    if (IN(pb + LP_FOUT1)) {
        const bf16* Wt = (const bf16*)(ws + WS_WFOUT) + (size_t)(l * 2) * DM * DFF; float* sq = SSQ + (size_t)(3 * l + 1) * MT;
        pg8::Gemm g{HB, Wt, MP, DM, DFF}; pg8::StaticOrder S; S.init(MP, DM, G, (int)blockIdx.x);
        if (l == 0) { pg8::EpiResT<true, false> E{xp, XB, sq, 0.5f}; pg8::gemm_phase<pg8::EpiResT<true, false>, pg8::StaticOrder, PG8_ALIGN, PG8_SP2>(lds, g, S, E);
            small_res<true, false>(lds, HB, Wt, DFF, xs, XB, 0.5f, sq, tid, wave, G); }
        else { pg8::EpiResT<false, false> E{XB, XB, sq, 0.5f}; pg8::gemm_phase<pg8::EpiResT<false, false>, pg8::StaticOrder, PG8_ALIGN, PG8_SP2>(lds, g, S, E);
            small_res<false, false>(lds, HB, Wt, DFF, XB, XB, 0.5f, sq, tid, wave, G); }
    }
    SEAM(pb + LP_FOUT1);
    if (IN(pb + LP_PROJ)) {
        const float* sq = SSQ + (size_t)(3 * l + 1) * MT;
        if (l == 0) {
            pg8::Gemm g{XB, (const bf16*)(ws + WS_WINE), MP, EVEN_IN, DM}; pg8::StaticOrder S; S.init(MP, EVEN_IN, G, (int)blockIdx.x);
            pg8::EpiProj E{PROJ, EVEN_IN, sq};
            pg8::gemm_phase<pg8::EpiProj, pg8::StaticOrder, PG8_ALIGN, PG8_SP2>(lds, g, S, E);
            small_proj_e(lds, XB, (const bf16*)(ws + WS_WINE), PROJ, sq, tid, wave, G);
            { unsigned* headC = (unsigned*)(ws + WS_CTL) + CW_QUEUE + 128; volatile LAS unsigned* slot = (volatile LAS unsigned*)(lds + LDSCTL_OFF + 128); LAS float* scr = (LAS float*)(lds + wave * 16384);
              for (;;) { const unsigned bt = queue_next(headC, slot, tid); if (bt * 8 >= (unsigned)DEF2_N) break;
                  const int v = (int)bt * 8 + wave; if (v < DEF2_N) convert_item(p, scr, defer2_item(v), lane); } }
        } else {
            pg8::Gemm g{XB, (const bf16*)(ws + WS_WINO), MP, 4 * DNW, DM}; pg8::StaticOrder S; S.init(MP, 4 * DNW, G, (int)blockIdx.x);
            pg8::EpiProj E{PROJ, ODD_PAD, sq};
            pg8::gemm_phase<pg8::EpiProj, pg8::StaticOrder, PG8_ALIGN, PG8_SP2>(lds, g, S, E);
            small_proj(lds, XB, (const bf16*)(ws + WS_WINO), PROJ, ODD_PAD, 4 * DNW / 64 + 1, 1, sq, tid, wave, G);
        }
    }
    SEAM(pb + LP_PROJ);
    if (IN(pb + LP_MIXA)) { if (l == 0) phase_even_a(p, lds, tid, lane, wave, G); else phase_odd_a(p, lds, tid, lane, wave, G); }
    SEAM(pb + LP_MIXA);
    if (IN(pb + LP_MIXB)) { if (l == 0) phase_even_b(p, lds, tid, lane, wave, G); else phase_odd_b(p, lds, tid, lane, wave, G); }
    SEAM(pb + LP_MIXB);
    if (l == 1) { if (IN(pb + LP_MIXC)) phase_odd_c(p, lds, tid, wave, G); SEAM(pb + LP_MIXC); }
    if (IN(pb + LP_OUT)) {
        const bf16* Wt = (const bf16*)(ws + (l == 0 ? WS_WOUTE : WS_WOUTO)); float* sq = SSQ + (size_t)(3 * l + 2) * MT;
        pg8::Gemm g{AO, Wt, MP, DM, DM}; pg8::StaticOrder S; S.init(MP, DM, G, (int)blockIdx.x);
        pg8::EpiResT<false, false> E{XB, XB, sq, 1.0f};
        pg8::gemm_phase<pg8::EpiResT<false, false>, pg8::StaticOrder, PG8_ALIGN, PG8_SP2>(lds, g, S, E);
        small_res<false, false>(lds, AO, Wt, DM, XB, XB, 1.0f, sq, tid, wave, G);
    }
    SEAM(pb + LP_OUT);
    if (IN(pb + LP_FIN2)) {
        const bf16* Wt = (const bf16*)(ws + WS_WFIN) + (size_t)(l * 2 + 1) * 2 * DFF * DM; const float* sq = SSQ + (size_t)(3 * l + 2) * MT;
        pg8::Gemm g{XB, Wt, MP, 2 * DFF, DM}; pg8::StaticOrder S; S.init(MP, 2 * DFF, G, (int)blockIdx.x);
        pg8::EpiSwiglu E{HB, DFF, sq};
        pg8::gemm_phase<pg8::EpiSwiglu, pg8::StaticOrder, PG8_ALIGN, PG8_SP2>(lds, g, S, E);
        small_swiglu(lds, XB, Wt, HB, sq, tid, wave, G);
    }
    SEAM(pb + LP_FIN2);
    if (IN(pb + LP_FOUT2)) {
        const bf16* Wt = (const bf16*)(ws + WS_WFOUT) + (size_t)(l * 2 + 1) * DM * DFF; float* sq = l == 0 ? SSQ + (size_t)3 * MT : (float*)nullptr;
        pg8::Gemm g{HB, Wt, MP, DM, DFF}; pg8::StaticOrder S; S.init(MP, DM, G, (int)blockIdx.x);
        if (l == 0) { pg8::EpiResT<false, false> E{XB, XB, sq, 0.5f}; pg8::gemm_phase<pg8::EpiResT<false, false>, pg8::StaticOrder, PG8_ALIGN, PG8_SP2>(lds, g, S, E);
            small_res<false, false>(lds, HB, Wt, DFF, XB, XB, 0.5f, sq, tid, wave, G); }
        else { pg8::EpiResT<false, true> E{XB, p.out + O_YP, sq, 0.5f}; pg8::gemm_phase<pg8::EpiResT<false, true>, pg8::StaticOrder, PG8_ALIGN, PG8_SP2>(lds, g, S, E);
            small_res<false, true>(lds, HB, Wt, DFF, XB, p.out + O_YS, 0.5f, sq, tid, wave, G); }
    }
    SEAM(pb + LP_FOUT2);
}
__global__ void __launch_bounds__(NTHR, 2) mega(Params p) {
    extern __shared__ __attribute__((aligned(16))) unsigned char lds_raw[];
    LAS unsigned char* lds = (LAS unsigned char*)lds_raw;
    const int tid = threadIdx.x, lane = tid & 63, wave = __builtin_amdgcn_readfirstlane(tid >> 6);
    const int G = gridDim.x, gw = blockIdx.x * NWAVES + wave, NGW = G * NWAVES;
    unsigned char* ws = p.ws;
    unsigned* ctl = (unsigned*)(ws + WS_CTL);
    for (int u = tid; u < (LDS_BYTES - LDSCTL_OFF) / 4; u += NTHR) ((LAS unsigned*)(lds + LDSCTL_OFF))[u] = 0u;
    __syncthreads();
    const int lo = p.ph_lo, hi = p.ph_hi;
    XcdBarrier bar; bar.bar = ctl + CW_BAR; bar.x = 0; bar.st = nullptr;
    if (hi - lo > 1) bar = xcd_barrier_post(ctl + CW_BAR, (volatile LAS unsigned*)(lds + LDSCTL_OFF + 64));

    float* X = (float*)(ws + WS_X); bf16* XN = (bf16*)(ws + WS_XN); bf16* HB = (bf16*)(ws + WS_H); bf16* PROJ = (bf16*)(ws + WS_PROJ); bf16* AO = (bf16*)(ws + WS_AO);
    const float* xp = (const float*)p.in[I_XP]; const float* xs = (const float*)p.in[I_XS];

    if (IN(PH_PRO)) { phase_prologue(p, lds, gw, NGW, wave, lane); phase_input_rows(xp, xs, XN, (float*)(ws + WS_CTL) + CW_SSQ, gw, NGW, lane); }
    SEAM(PH_PRO);

    run_layer<0>(p, lds, bar, lo, hi, tid, lane, wave, G, gw, NGW);
    run_layer<1>(p, lds, bar, lo, hi, tid, lane, wave, G, gw, NGW);
#undef IN
#undef SEAM
}

#ifndef MK_ONE_LAUNCH
#define MK_ONE_LAUNCH 1
#endif
extern "C" void kernel_launch(void* const* d_in, const int* in_sizes, int n_in, void* d_out, int out_size, void* d_ws, size_t ws_size, hipStream_t stream) {
    static int grid = 0;
    if (grid == 0) {
        if (n_in != N_IN || (size_t)out_size != O_END || ws_size < WS_END) { fprintf(stderr, "kernel_launch: unexpected problem: n_in %d out %d ws %zu\n", n_in, out_size, ws_size); grid = -1; return; }
        int dev = 0, cus = 0;
        if (hipGetDevice(&dev) != hipSuccess || hipDeviceGetAttribute(&cus, hipDeviceAttributeMultiprocessorCount, dev) != hipSuccess) { grid = -1; return; }
        if (hipFuncSetAttribute((const void*)mega, hipFuncAttributeMaxDynamicSharedMemorySize, LDS_BYTES) != hipSuccess) { fprintf(stderr, "kernel_launch: hipFuncSetAttribute failed\n"); grid = -1; return; }
        int per_cu = 0;
        if (hipOccupancyMaxActiveBlocksPerMultiprocessor(&per_cu, (const void*)mega, NTHR, LDS_BYTES) != hipSuccess || per_cu < 1) fprintf(stderr, "kernel_launch: occupancy query says %d\n", per_cu);
        (void)hipGetLastError();
        grid = cus;
    }
    if (grid < 0) return;
    if (hipMemsetAsync((char*)d_ws + WS_CTL, 0, CTL_ZERO_BYTES, stream) != hipSuccess) return;
    Params p{};
    for (int i = 0; i < N_IN; ++i) p.in[i] = d_in[i];
    p.out = (float*)d_out; p.ws = (unsigned char*)d_ws;
#if PROBE_MASK
    { int lo = 0;
      for (int ph = 0; ph < NPH; ++ph) if ((PROBE_MASK >> ph) & 1) {
          p.ph_lo = lo; p.ph_hi = ph + 1; hipLaunchKernelGGL(mega, dim3(grid), dim3(NTHR), LDS_BYTES, stream, p);
          (void)hipMemsetAsync((char*)d_ws + WS_CTL, 0, CW_SSQ * 4, stream);
          p.ph_lo = ph; p.ph_hi = ph + 1; p.mode = PROBE_MODE; hipLaunchKernelGGL(mega, dim3(grid), dim3(NTHR), LDS_BYTES, stream, p); p.mode = 0;
          (void)hipMemsetAsync((char*)d_ws + WS_CTL, 0, CW_SSQ * 4, stream);
          lo = ph + 1; }
      if (lo < NPH) { p.ph_lo = lo; p.ph_hi = NPH; hipLaunchKernelGGL(mega, dim3(grid), dim3(NTHR), LDS_BYTES, stream, p); } }
#elif MK_ONE_LAUNCH
    p.ph_lo = 0; p.ph_hi = NPH;
    hipLaunchKernelGGL(mega, dim3(grid), dim3(NTHR), LDS_BYTES, stream, p);
#else
    for (int ph = 0; ph < NPH; ++ph) { p.ph_lo = ph; p.ph_hi = ph + 1; hipLaunchKernelGGL(mega, dim3(grid), dim3(NTHR), LDS_BYTES, stream, p); }
#endif
}
```

```cpp
#include <hip/hip_runtime.h>
#include <cstdio>
#include <cstdint>

#define GAS __attribute__((address_space(1)))
#define LAS __attribute__((address_space(3)))
typedef unsigned short bf16;
typedef short bf16x8 __attribute__((ext_vector_type(8)));
typedef short bf16x4 __attribute__((ext_vector_type(4)));
typedef float f32x2 __attribute__((ext_vector_type(2)));
typedef float f32x4 __attribute__((ext_vector_type(4)));
typedef float f32x16 __attribute__((ext_vector_type(16)));
typedef unsigned u32x2 __attribute__((ext_vector_type(2)));
typedef unsigned u32x4 __attribute__((ext_vector_type(4)));
typedef __bf16 bf16v2 __attribute__((ext_vector_type(2)));
#define DI __device__ __forceinline__
DI unsigned pk2(float lo, float hi) { f32x2 v = {lo, hi}; return __builtin_bit_cast(unsigned, __builtin_convertvector(v, bf16v2)); }
DI bf16 f2bf(float f) { return (bf16)(pk2(f, 0.f) & 0xffffu); }
DI float bf2f(bf16 b) { return __builtin_bit_cast(float, ((unsigned)b) << 16); }
DI float bflo(unsigned w) { return __builtin_bit_cast(float, w << 16); }
DI float bfhi(unsigned w) { return __builtin_bit_cast(float, w & 0xffff0000u); }
DI float fexp2(float x) { return __builtin_amdgcn_exp2f(x); }
DI float flog2(float x) { return __builtin_amdgcn_logf(x); }
DI float frcp(float x) { return __builtin_amdgcn_rcpf(x); }
DI float frsq(float x) { return __builtin_amdgcn_rsqf(x); }
#define LOG2E 1.4426950408889634f
#define LN2 0.6931471805599453f
DI float fsigmoid(float x) { return frcp(1.0f + fexp2(-x * LOG2E)); }
DI float fsilu(float x) { return x * fsigmoid(x); }
DI float fsoftplus(float x) { return x > 20.f ? x : LN2 * flog2(1.0f + fexp2(x * LOG2E)); }
DI float fgelu_tanh(float x) { const float u = 0.7978845608028654f * (x + 0.044715f * x * x * x); return x * fsigmoid(2.0f * u); }
DI float fnegexpm1(float x) { const float pl = -x * (1.f + x * (0.5f + x * (0.16666667f + x * (0.041666668f + x * (0.0083333338f + x * 0.0013888889f))))); return x > -0.25f ? pl : 1.0f - fexp2(x * LOG2E); }
#define MFMA32(a, b, c) __builtin_amdgcn_mfma_f32_32x32x16_bf16((a), (b), (c), 0, 0, 0)
#define LDS_WAIT() asm volatile("s_waitcnt lgkmcnt(0)" ::: "memory")
#define VM_WAIT() asm volatile("s_waitcnt vmcnt(0)" ::: "memory")
DI float wave_sum(float v) {
#pragma unroll
    for (int o = 1; o < 64; o <<= 1) v += __shfl_xor(v, o);
    return v;
}

constexpr int DM = 1024, NB_P = 4, T_P = 4096, MP = NB_P * T_P  , NB_S = 128, T_S = 4, MS = NB_S * T_S  , MT = MP + MS  ;
constexpr int PAST = 2048, PAGE = 128, NPAGES = 16, NPOOL = 2560;
constexpr int SBH = 8, SBD = 64, SBW = 512, LRW = 512, DNH = 8, DND = 128, DNW = 1024, DFF = 2048;
constexpr int EVEN_IN = 2560, ODD_IN = 4112, ODD_PAD = 4352;
constexpr float EPS = 1e-6f;
namespace pg8 {
#define PG8_LAS __attribute__((address_space(3)))
typedef unsigned short bf16_t;
constexpr int BM = 256, BK = 64, HALF = 128, HTB = HALF * BK * 2  , STAGE_BYTES = 8 * HTB, NXCD = 8, WGM = 8;

__host__ __device__ __forceinline__ int lds_byte(int r, int c) { const int st = (r >> 4) * 2 + (c >> 5), rr = r & 15, cc = c & 31, ob = rr * 64 + cc * 2; return st * 1024 + (ob ^ (((ob >> 9) & 1) << 5)); }
__host__ __device__ __forceinline__ void stage_rc(int b, int& R, int& C) { const int st = b / 1024, sb = b % 1024, swz = sb ^ (((sb >> 9) & 1) << 5); R = (st >> 1) * 16 + swz / 64; C = (st & 1) * 32 + (swz % 64) / 2; }
__host__ __device__ __forceinline__ int perm32(int rho) { const int n = rho >> 4, i = rho & 15; return 8 * (i >> 2) + 4 * n + (i & 3); }

struct Unit { int pm, pn; };
struct Gemm { const bf16_t* A; const bf16_t* Bt; int M, N, K; };

struct StaticOrder {
    int nM, nN, nwg, G, c;
    __host__ __device__ void init(int M, int N, int G_, int c_) { nM = M / BM; nN = N / BM; nwg = nM * nN; G = G_; c = c_; }
    __host__ __device__ bool next(int i, Unit& u) const {
        const long L = (long)i * G + c; if (L >= nwg) return false;
        int wgid = (int)L; { const int q = nwg / NXCD, r = nwg % NXCD, xcd = wgid % NXCD, off = wgid / NXCD; wgid = (xcd < r ? xcd * (q + 1) : r * (q + 1) + (xcd - r) * q) + off; }
        const int nig = WGM * nN, gid = wgid / nig, fm = gid * WGM, gsz = (nM - fm) < WGM ? (nM - fm) : WGM;
        u.pm = fm + ((wgid % nig) % gsz); u.pn = (wgid % nig) / gsz; return true;
    }
    __device__ __forceinline__ void a_ready(const Unit&) const {}
    __device__ __forceinline__ void done(const Unit&) const {}
};


DI float row_rstd(const float* ssq, int row) { return frsq((float)((const unsigned*)ssq)[row] * (1.f / 1024.f) * (1.f / DM) + EPS); }
DI void ssq_add(float* ssq, int row, float s) { atomicAdd((unsigned*)ssq + row, (unsigned)(s * 1024.f + 0.5f)); }
struct PreNone {};
struct PreRs { unsigned raw[2][4]; DI float rs(int ai, int m) const { return frsq((float)raw[ai][m] * (1.f / 1024.f) * (1.f / DM) + EPS); } };
DI PreRs pre_rstd(const float* ssq, const Unit& u, int wr, int fr) { PreRs p;
#pragma unroll
    for (int ai = 0; ai < 2; ++ai)
#pragma unroll
        for (int m = 0; m < 4; ++m) p.raw[ai][m] = ((const unsigned*)ssq)[u.pm * BM + wr * 64 + fr + ai * HALF + m * 16];
    return p; }
struct EpiSwiglu {
    static constexpr bool PERM = true, AFTER_DRAIN = false;
    bf16_t* H; int ldc; const float* ssq;
    typedef PreRs Pre; DI Pre pre(const Unit& u, int wr, int fr) const { return pre_rstd(ssq, u, wr, fr); }
    __device__ __forceinline__ void operator()(const f32x4 (&acc)[2][2][4][2], const Unit& u, int wr, int wc, int fr, int fq, const Pre& P) const {
        const int row0 = u.pm * BM + wr * 64 + fr, col0 = u.pn * HALF + wc * 32 + 8 * fq;
#pragma unroll
        for (int ai = 0; ai < 2; ++ai)
#pragma unroll
            for (int m = 0; m < 4; ++m) {
                const int row = row0 + ai * HALF + m * 16; const float rs = P.rs(ai, m);
                bf16_t* rowp = H + (size_t)row * ldc + col0;
                const f32x4 g0 = acc[ai][0][m][0] * rs, g1 = acc[ai][0][m][1] * rs, u0 = acc[ai][1][m][0] * rs, u1 = acc[ai][1][m][1] * rs;
                u32x4 w;
                w.x = pk2(fsilu(g0[0]) * u0[0], fsilu(g0[1]) * u0[1]); w.y = pk2(fsilu(g0[2]) * u0[2], fsilu(g0[3]) * u0[3]);
                w.z = pk2(fsilu(g1[0]) * u1[0], fsilu(g1[1]) * u1[1]); w.w = pk2(fsilu(g1[2]) * u1[2], fsilu(g1[3]) * u1[3]);
                *(u32x4*)rowp = w;
            }
    }
};
template <bool BASE_F32, bool OUT_F32> struct EpiResT {
    static constexpr bool PERM = true, AFTER_DRAIN = false;
    const void* base; void* out; float* ssq; float alpha;
    typedef PreNone Pre; DI Pre pre(const Unit&, int, int) const { return Pre{}; }
    __device__ __forceinline__ void operator()(const f32x4 (&acc)[2][2][4][2], const Unit& u, int wr, int wc, int fr, int fq, const Pre&) const {
        const int row0 = u.pm * BM + wr * 64 + fr, col0 = u.pn * BM + wc * 32 + 8 * fq;
#pragma unroll
        for (int ai = 0; ai < 2; ++ai)
#pragma unroll
            for (int m = 0; m < 4; ++m) {
                const int row = row0 + ai * HALF + m * 16; const size_t off = (size_t)row * DM + col0; float s = 0.f;
#pragma unroll
                for (int bj = 0; bj < 2; ++bj) {
                    f32x4 b0, b1;
                    if (BASE_F32) { const float* bp = (const float*)base + off + bj * HALF; b0 = *(const f32x4*)bp; b1 = *(const f32x4*)(bp + 4); }
                    else { const u32x4 w = *(const u32x4*)((const bf16_t*)base + off + bj * HALF); b0 = (f32x4){bflo(w.x), bfhi(w.x), bflo(w.y), bfhi(w.y)}; b1 = (f32x4){bflo(w.z), bfhi(w.z), bflo(w.w), bfhi(w.w)}; }
                    const f32x4 o0 = b0 + acc[ai][bj][m][0] * alpha, o1 = b1 + acc[ai][bj][m][1] * alpha;
                    if (OUT_F32) { float* op = (float*)out + off + bj * HALF; *(f32x4*)op = o0; *(f32x4*)(op + 4) = o1; }
                    else { u32x4 w; w.x = pk2(o0[0], o0[1]); w.y = pk2(o0[2], o0[3]); w.z = pk2(o1[0], o1[1]); w.w = pk2(o1[2], o1[3]); *(u32x4*)((bf16_t*)out + off + bj * HALF) = w; }
                    s += ((o0[0] * o0[0] + o0[1] * o0[1]) + (o0[2] * o0[2] + o0[3] * o0[3])) + ((o1[0] * o1[0] + o1[1] * o1[1]) + (o1[2] * o1[2] + o1[3] * o1[3]));
                }
                if (ssq) { s += __shfl_xor(s, 16); s += __shfl_xor(s, 32); if (fq == 0) ssq_add(ssq, row, s); }
            }
    }
};
struct EpiProj {
    static constexpr bool PERM = true, AFTER_DRAIN = false;
    bf16_t* O; int ldc; const float* ssq;
    typedef PreRs Pre; DI Pre pre(const Unit& u, int wr, int fr) const { return pre_rstd(ssq, u, wr, fr); }
    __device__ __forceinline__ void operator()(const f32x4 (&acc)[2][2][4][2], const Unit& u, int wr, int wc, int fr, int fq, const Pre& P) const {
        const int row0 = u.pm * BM + wr * 64 + fr, col0 = u.pn * BM + wc * 32 + 8 * fq;
#pragma unroll
        for (int ai = 0; ai < 2; ++ai)
#pragma unroll
            for (int m = 0; m < 4; ++m) {
                const int row = row0 + ai * HALF + m * 16; const float rs = P.rs(ai, m);
                bf16_t* rowp = O + (size_t)row * ldc + col0;
#pragma unroll
                for (int bj = 0; bj < 2; ++bj) { const f32x4 v0 = acc[ai][bj][m][0] * rs, v1 = acc[ai][bj][m][1] * rs;
                    u32x4 w; w.x = pk2(v0[0], v0[1]); w.y = pk2(v0[2], v0[3]); w.z = pk2(v1[0], v1[1]); w.w = pk2(v1[2], v1[3]);
                    *(u32x4*)(rowp + bj * HALF) = w; }
            }
    }
};

template <class Epi, class Sched, bool ALIGN_EPI = false, bool SP2 = false>
__device__ __forceinline__ void gemm_phase(PG8_LAS unsigned char* lds, const Gemm g, const Sched& S, const Epi& E) {
    const int tid = threadIdx.x, wid = __builtin_amdgcn_readfirstlane(tid >> 6), lane = tid & 63, wr = wid >> 2, wc = wid & 3, fr = lane & 15, fq = lane >> 4;
    const int K = g.K, nt = K / BK;
    unsigned voffA[2], voffB[2];
#pragma unroll
    for (int i = 0; i < 2; ++i) { int R, C; stage_rc(tid * 16 + i * 8192, R, C); const int Rb = Epi::PERM ? ((R & ~31) + perm32(R & 31)) : R;
        voffA[i] = (unsigned)(R * K + C) * 2u; voffB[i] = (unsigned)(Rb * K + C) * 2u; }
    const size_t kstep = (size_t)(BK * 2);
    const size_t hstep = (size_t)HALF * K * 2;
    const size_t tstep = 2 * hstep;
    const unsigned ldsw = (unsigned)wid * 1024u;
    const int aoff = lds_byte(wr * 64 + fr, fq * 8), boff = lds_byte(wc * 32 + fr, fq * 8);
#define PG8_SA(b, h) (((b) * 2 + (h)) * HTB)
#define PG8_SB(b, h) ((4 + (b) * 2 + (h)) * HTB)
#define PG8_STAGE(bufoff, gbase, voff) do { _Pragma("unroll") for (int _i = 0; _i < 2; ++_i) \
        __builtin_amdgcn_global_load_lds((const unsigned*)((const char*)(gbase) + (voff)[_i]), (PG8_LAS unsigned*)(lds + (bufoff) + ldsw + _i * 8192), 16, 0, 0); } while (0)
#define PG8_LDA(dst, b, h) do { _Pragma("unroll") for (int m = 0; m < 4; ++m) _Pragma("unroll") for (int k = 0; k < 2; ++k) dst[m][k] = *(const PG8_LAS bf16x8*)(lds + PG8_SA(b, h) + aoff + m * 2048 + k * 1024); } while (0)
#define PG8_LDB(dst, b, h) do { _Pragma("unroll") for (int n = 0; n < 2; ++n) _Pragma("unroll") for (int k = 0; k < 2; ++k) dst[n][k] = *(const PG8_LAS bf16x8*)(lds + PG8_SB(b, h) + boff + n * 2048 + k * 1024); } while (0)
#define PG8_MMA(ai, bj, At, Bt) do { __builtin_amdgcn_s_setprio(1); _Pragma("unroll") for (int m = 0; m < 4; ++m) _Pragma("unroll") for (int n = 0; n < 2; ++n) _Pragma("unroll") for (int k = 0; k < 2; ++k) \
        acc[ai][bj][m][n] = __builtin_amdgcn_mfma_f32_16x16x32_bf16(Bt[n][k], At[m][k], acc[ai][bj][m][n], 0, 0, 0); __builtin_amdgcn_s_setprio(0); } while (0)
#define PG8_WAIT_V(n) asm volatile("s_waitcnt vmcnt(" #n ")" ::: "memory")
#define PG8_WAIT_L(n) asm volatile("s_waitcnt lgkmcnt(" #n ")" ::: "memory")
#define PG8_BAR __builtin_amdgcn_s_barrier()
#define PG8_SCHED __builtin_amdgcn_sched_barrier(0)
    Unit cur, nxt; int ui = 0;
    if (!S.next(0, cur)) return;
    f32x4 acc[2][2][4][2];
#pragma unroll
    for (int a = 0; a < 2; ++a)
#pragma unroll
        for (int b = 0; b < 2; ++b)
#pragma unroll
            for (int m = 0; m < 4; ++m)
#pragma unroll
                for (int n = 0; n < 2; ++n) acc[a][b][m][n] = (f32x4){0.f, 0.f, 0.f, 0.f};
    bf16x8 At[4][2], B0[2][2], B1[2][2];
    const char* cA = (const char*)g.A + (size_t)cur.pm * tstep; const char* cB = (const char*)g.Bt + (size_t)cur.pn * tstep;
    S.a_ready(cur);
    if constexpr (SP2) {
        PG8_STAGE(PG8_SB(0, 0), cB, voffB); PG8_STAGE(PG8_SB(0, 1), cB + hstep, voffB); PG8_STAGE(PG8_SA(0, 0), cA, voffA); PG8_STAGE(PG8_SA(0, 1), cA + hstep, voffA);
        if (wr == 1) PG8_BAR;
        PG8_WAIT_V(2); PG8_BAR;
        PG8_STAGE(PG8_SB(1, 0), cB + kstep, voffB); PG8_STAGE(PG8_SA(1, 0), cA + kstep, voffA); PG8_STAGE(PG8_SB(1, 1), cB + hstep + kstep, voffB);
        PG8_WAIT_V(6); PG8_BAR;
    } else {
        PG8_STAGE(PG8_SB(0, 0), cB, voffB); PG8_STAGE(PG8_SA(0, 0), cA, voffA); PG8_STAGE(PG8_SB(0, 1), cB + hstep, voffB); PG8_STAGE(PG8_SA(0, 1), cA + hstep, voffA);
        if (wr == 1) PG8_BAR;
        PG8_WAIT_V(4); PG8_BAR;
        PG8_STAGE(PG8_SB(1, 0), cB + kstep, voffB); PG8_STAGE(PG8_SA(1, 0), cA + kstep, voffA); PG8_STAGE(PG8_SB(1, 1), cB + hstep + kstep, voffB);
        PG8_WAIT_V(6); PG8_BAR;
    }
    for (;;) {
        const bool has_next = S.next(ui + 1, nxt);
        const char* nA = has_next ? (const char*)g.A + (size_t)nxt.pm * tstep : cA; const char* nB = has_next ? (const char*)g.Bt + (size_t)nxt.pn * tstep : cB;
        const typename Epi::Pre pre = E.pre(cur, wr, fr);
        for (int t = 0; t < nt; t += 2) {
            const bool last = (t == nt - 2);
            const char* a1 = cA + (size_t)(t + 1) * kstep;
            const char* a2 = last ? nA : cA + (size_t)(t + 2) * kstep; const char* b2 = last ? nB : cB + (size_t)(t + 2) * kstep;
            const char* a3 = a2 + kstep; const char* b3 = b2 + kstep;
            if (last && has_next) S.a_ready(nxt);
            if constexpr (SP2) {
            PG8_LDB(B0, 0, 0); PG8_LDB(B1, 0, 1); PG8_SCHED; PG8_LDA(At, 0, 0); PG8_STAGE(PG8_SA(1, 1), a1 + hstep, voffA);
            PG8_WAIT_V(8); PG8_WAIT_L(0); PG8_BAR; PG8_MMA(0, 0, At, B0); PG8_MMA(0, 1, At, B1); PG8_BAR; PG8_SCHED;
            PG8_LDA(At, 0, 1); PG8_STAGE(PG8_SB(0, 0), b2, voffB); PG8_STAGE(PG8_SB(0, 1), b2 + hstep, voffB); PG8_STAGE(PG8_SA(0, 0), a2, voffA);
            PG8_WAIT_V(8); PG8_WAIT_L(0); PG8_BAR; PG8_MMA(1, 0, At, B0); PG8_MMA(1, 1, At, B1); PG8_BAR; PG8_SCHED;
            PG8_LDB(B0, 1, 0); PG8_LDB(B1, 1, 1); PG8_SCHED; PG8_LDA(At, 1, 0); PG8_STAGE(PG8_SA(0, 1), a2 + hstep, voffA);
            PG8_WAIT_V(8); PG8_WAIT_L(0); PG8_BAR; PG8_MMA(0, 0, At, B0); PG8_MMA(0, 1, At, B1); PG8_BAR; PG8_SCHED;
            PG8_LDA(At, 1, 1); PG8_STAGE(PG8_SB(1, 0), b3, voffB); PG8_STAGE(PG8_SB(1, 1), b3 + hstep, voffB); PG8_STAGE(PG8_SA(1, 0), a3, voffA);
            PG8_WAIT_V(8); PG8_WAIT_L(0); PG8_BAR; PG8_MMA(1, 0, At, B0); PG8_MMA(1, 1, At, B1); PG8_BAR; PG8_SCHED;
            } else {
            PG8_LDB(B0, 0, 0); PG8_SCHED; PG8_LDA(At, 0, 0); PG8_STAGE(PG8_SA(1, 1), a1 + hstep, voffA);
            PG8_WAIT_L(8); PG8_BAR; PG8_WAIT_L(0); PG8_MMA(0, 0, At, B0); PG8_BAR; PG8_SCHED;
            PG8_LDB(B1, 0, 1); PG8_STAGE(PG8_SB(0, 0), b2, voffB);
            PG8_BAR; PG8_WAIT_L(0); PG8_MMA(0, 1, At, B1); PG8_BAR;
            PG8_LDA(At, 0, 1); PG8_STAGE(PG8_SA(0, 0), a2, voffA);
            PG8_BAR; PG8_WAIT_L(0); PG8_MMA(1, 0, At, B0); PG8_BAR; PG8_SCHED;
            PG8_STAGE(PG8_SB(0, 1), b2 + hstep, voffB);
            PG8_WAIT_V(6); PG8_BAR; PG8_MMA(1, 1, At, B1); PG8_BAR;
            PG8_LDB(B0, 1, 0); PG8_SCHED; PG8_LDA(At, 1, 0); PG8_STAGE(PG8_SA(0, 1), a2 + hstep, voffA);
            PG8_WAIT_L(8); PG8_BAR; PG8_WAIT_L(0); PG8_MMA(0, 0, At, B0); PG8_BAR; PG8_SCHED;
            PG8_LDB(B1, 1, 1); PG8_STAGE(PG8_SB(1, 0), b3, voffB);
            PG8_BAR; PG8_WAIT_L(0); PG8_MMA(0, 1, At, B1); PG8_BAR;
            PG8_LDA(At, 1, 1); PG8_STAGE(PG8_SA(1, 0), a3, voffA);
            PG8_BAR; PG8_WAIT_L(0); PG8_MMA(1, 0, At, B0); PG8_BAR; PG8_SCHED;
            PG8_STAGE(PG8_SB(1, 1), b3 + hstep, voffB);
            PG8_WAIT_V(6); PG8_BAR; PG8_MMA(1, 1, At, B1); PG8_BAR;
            }
        }
        if constexpr (ALIGN_EPI) { if (wr == 0) PG8_BAR; }
        if constexpr (!Epi::AFTER_DRAIN) { E(acc, cur, wr, wc, fr, fq, pre); S.done(cur); }
        if (!has_next) break;
#pragma unroll
        for (int a = 0; a < 2; ++a)
#pragma unroll
            for (int b = 0; b < 2; ++b)
#pragma unroll
                for (int m = 0; m < 4; ++m)
#pragma unroll
                    for (int n = 0; n < 2; ++n) acc[a][b][m][n] = (f32x4){0.f, 0.f, 0.f, 0.f};
        cur = nxt; cA = nA; cB = nB; ++ui;
        if constexpr (ALIGN_EPI) { if (wr == 1) PG8_BAR; }
    }
    PG8_WAIT_V(0);
    if constexpr (!ALIGN_EPI) { if (wr == 0) PG8_BAR; }
    PG8_BAR;
    if constexpr (Epi::AFTER_DRAIN) { E.fused(acc, cur, wr, wc, fr, fq, lds, wid, lane); S.done(cur); }
#undef PG8_SA
#undef PG8_SB
#undef PG8_STAGE
#undef PG8_LDA
#undef PG8_LDB
#undef PG8_MMA
#undef PG8_WAIT_V
#undef PG8_WAIT_L
#undef PG8_BAR
#undef PG8_SCHED
}
}
#define PG8_SP2 true
#define PG8_ALIGN true
#define XB_TMO      128
#define XB_XCNT(j)  (256  + 64 * (j))
#define XB_XSUB(j)  (1280 + 64 * (j))
#define XB_XGEN(j)  (2304 + 64 * (j))
#define XB_TOP      3328
#define XB_TOPGEN   3392
#define XCD_BAR_WORDS 3456
#define XB_SPIN_CAP (1u << 18)


__device__ __forceinline__ unsigned xb_ld(unsigned* p)              { return __hip_atomic_load(p, __ATOMIC_RELAXED, __HIP_MEMORY_SCOPE_AGENT); }
__device__ __forceinline__ unsigned xb_add(unsigned* p, unsigned v) { return __hip_atomic_fetch_add(p, v, __ATOMIC_RELAXED, __HIP_MEMORY_SCOPE_AGENT); }
__device__ __forceinline__ unsigned xb_xcc_id() { return (unsigned)__builtin_amdgcn_s_getreg((3 << 11) | 20) & 0xFu; }
#define XB_SPIN(cond, bar) do { unsigned _sp = 0; while (cond) { __builtin_amdgcn_s_sleep(1); \
    if ((++_sp & 255u) == 0u) { if (xb_ld(&(bar)[XB_TMO])) break; if (_sp > XB_SPIN_CAP) { atomicAdd(&(bar)[XB_TMO], 1u); break; } } } } while (0)

struct XcdBarrier {
    unsigned* bar; unsigned x;
    volatile LAS unsigned* st;
};

__device__ __forceinline__ XcdBarrier xcd_barrier_post(unsigned* bar, volatile LAS unsigned* st) {
    XcdBarrier b; b.bar = bar; b.x = xb_xcc_id(); b.st = st;
    if (threadIdx.x == 0) (void)xb_add(&bar[XB_XCNT(b.x)], 1u);
    return b;
}
__device__ __forceinline__ void xcd_barrier_complete(unsigned* bar, unsigned x, unsigned& nloc, unsigned& nx) {
    const unsigned G = gridDim.x * gridDim.y * gridDim.z;
    unsigned sum, cnt, mine, sp = 0u;
    for (;;) {
        sum = 0u; cnt = 0u; mine = 0u;
#pragma unroll
        for (unsigned j = 0; j < 16; ++j) { const unsigned c = xb_ld(&bar[XB_XCNT(j)]); sum += c; cnt += (c > 0u) ? 1u : 0u; mine = (j == x) ? c : mine; }
        if (sum == G) break;
        __builtin_amdgcn_s_sleep(1);
        if ((++sp & 255u) == 0u) { if (xb_ld(&bar[XB_TMO])) break; if (sp > XB_SPIN_CAP) { atomicAdd(&bar[XB_TMO], 1u); break; } }
    }
    nloc = mine > 0u ? mine : 1u; nx = cnt > 0u ? cnt : 1u;
}

__device__ __forceinline__ void xcd_barrier(const XcdBarrier& b) {
    asm volatile("s_waitcnt vmcnt(0)" ::: "memory");
    __syncthreads();
    if (threadIdx.x == 0) {
        unsigned* bar = b.bar;
        __builtin_amdgcn_s_waitcnt(0);
        unsigned nloc = b.st[0], nx = b.st[1];
        if (nloc == 0u) { xcd_barrier_complete(bar, b.x, nloc, nx); b.st[0] = nloc; b.st[1] = nx; }
        const unsigned old = xb_add(&bar[XB_XSUB(b.x)], 1u);
        const unsigned gen = old / nloc;
        if (old + 1u == (gen + 1u) * nloc) {
            __builtin_amdgcn_fence(__ATOMIC_RELEASE, "agent");
            asm volatile("s_waitcnt vmcnt(0)" ::: "memory");
            const unsigned og = xb_add(&bar[XB_TOP], 1u);
            const unsigned tg = og / nx;
            if (og + 1u == (tg + 1u) * nx) xb_add(&bar[XB_TOPGEN], 1u);
            else XB_SPIN(xb_ld(&bar[XB_TOPGEN]) == tg, bar);
            __builtin_amdgcn_fence(__ATOMIC_ACQUIRE, "agent");
            xb_add(&bar[XB_XGEN(b.x)], 1u);
            asm volatile("s_waitcnt vmcnt(0)" ::: "memory");
        } else {
            XB_SPIN(xb_ld(&bar[XB_XGEN(b.x)]) == gen, bar);
            __builtin_amdgcn_fence(__ATOMIC_ACQUIRE, "agent");
            asm volatile("s_waitcnt vmcnt(0)" ::: "memory");
        }
    }
    __syncthreads();
}

constexpr size_t MiB = 1u << 20;
constexpr size_t WS_CTL = 0, CTL_ZERO_BYTES = 1 * MiB;
constexpr size_t WS_WFIN = 1 * MiB;
constexpr size_t WS_WFOUT = 33 * MiB;
constexpr size_t WS_WINE = 49 * MiB;
constexpr size_t WS_WOUTE = 54 * MiB;
constexpr size_t WS_WINO = 56 * MiB;
constexpr size_t WS_WOUTO = 65 * MiB;
constexpr size_t WS_X = 68 * MiB;
constexpr size_t WS_XN = 134 * MiB;
constexpr size_t WS_H = 167 * MiB;
constexpr size_t WS_PROJ = 233 * MiB;
constexpr size_t WS_QB = 374 * MiB;
constexpr size_t WS_KB = 391 * MiB;
constexpr size_t WS_VT = 408 * MiB;
constexpr size_t WS_VS = 424 * MiB;
constexpr size_t WS_AO = 425 * MiB;
constexpr size_t WS_HL = 458 * MiB;
constexpr size_t WS_PP = 474 * MiB;
constexpr size_t WS_AGG = 490 * MiB;
constexpr size_t WS_UV = 491 * MiB, WS_WK = 523 * MiB, WS_QG = 555 * MiB, WS_KGT = 587 * MiB;
constexpr size_t WS_PM = 619 * MiB;
constexpr size_t WS_GL = 635 * MiB;
constexpr size_t WS_OR = 636 * MiB;
constexpr size_t WS_SPART = 668 * MiB;
constexpr size_t WS_END = 672 * MiB;
constexpr int CW_BAR = 4096;
constexpr int CW_SSQ = 65536;
constexpr int CW_SMPCNT = 32768;
constexpr int CW_QUEUE = 16384;

constexpr size_t O_YP = 0, O_YS = 16777216, O_KP = 17301504, O_VP = 25690112, O_LCP = 34078720, O_LHP = 34084864, O_DCP = 34086912, O_DSP = 34123776,
                 O_KS = 34648064, O_VS = 34910208, O_LCS = 35172352, O_LHS = 35368960, O_DCS = 35434496, O_DSS = 36614144, O_END = 53391360;

constexpr int RING_BYTES = 131072;
constexpr int LDSCTL_OFF = RING_BYTES;
constexpr int LDS_BYTES = 147456;

enum InIdx { I_XP = 0, I_XS, I_CK, I_CV, I_SLC, I_SLH, I_SDC, I_SDS, I_PT, I_NF1, I_WF1I, I_WF1O, I_NM, I_NF2, I_WF2I, I_WF2O,
             I_WINE, I_QG, I_KG, I_SBB, I_LCW, I_LCB, I_LWA, I_LBA, I_LWI, I_LBI, I_LAM, I_WOUTE, I_WINO, I_DCW, I_DAL, I_DDT, I_DOG, I_WOUTO, N_IN };
struct Params { const void* in[N_IN]; float* out; unsigned char* ws; int ph_lo, ph_hi, mode, pad; };
static_assert(sizeof(Params) == (N_IN + 2) * 8 + 16, "Params has no padding");

constexpr int NWAVES = 8, NTHR = 512;
constexpr int PH_PRO = 0, PH_L0 = 1, PH_PER_LAYER = 9, NPH = 1 + 2 * PH_PER_LAYER;
enum LayerPhase { LP_FIN1 = 0, LP_FOUT1, LP_PROJ, LP_MIXA, LP_MIXB, LP_MIXC, LP_OUT, LP_FIN2, LP_FOUT2 };

struct RowId { DI int operator()(int n) const { return n; } };
struct RowSwiglu { DI int operator()(int n) const { return n < DFF ? ((n >> 7) << 8) + (n & 127) : (((n - DFF) >> 7) << 8) + 128 + ((n - DFF) & 127); } };
template <class RM> DI void transpose_item(const float* W, int K, int N, bf16* WT, RM rm, LAS float* scrf, int item, int lane, const float* gain = nullptr) {
    LAS bf16* scr = (LAS bf16*)scrf;
    const int nblk = (N + 63) / 64, kb = item / nblk, nb = item % nblk, k0 = 64 * kb, n0 = 64 * nb;
    { const int kk = lane >> 4, n4 = 4 * (lane & 15); const bool ok = n0 + n4 < N;
      f32x4 v[16];
#pragma unroll
      for (int i = 0; i < 16; ++i) v[i] = ok ? *(const f32x4*)(W + (size_t)(k0 + 4 * i + kk) * N + n0 + n4) : (f32x4){0.f, 0.f, 0.f, 0.f};
      if (gain) {
#pragma unroll
          for (int i = 0; i < 16; ++i) v[i] = v[i] * gain[k0 + 4 * i + kk]; }
#pragma unroll
      for (int i = 0; i < 16; ++i) { u32x2 w; w.x = pk2(v[i][0], v[i][1]); w.y = pk2(v[i][2], v[i][3]); *(LAS u32x2*)(scr + (4 * i + kk) * 68 + n4) = w; } }
    LDS_WAIT(); asm volatile("" ::: "memory");
    const int c = lane & 7;
#pragma unroll
    for (int j = 0; j < 8; ++j) { const int nn = (lane >> 3) + 8 * j, n = n0 + nn; const LAS bf16* s = scr + (8 * c) * 68 + nn;
        u32x4 o;
#pragma unroll
        for (int q = 0; q < 4; ++q) o[q] = (unsigned)s[(2 * q) * 68] | ((unsigned)s[(2 * q + 1) * 68] << 16);
        if (n < N) *(u32x4*)(WT + (size_t)rm(n) * K + k0 + 8 * c) = o; }
    LDS_WAIT(); asm volatile("" ::: "memory");
}
constexpr int I_FIN = (DM / 64) * (2 * DFF / 64), I_FOUT = (DFF / 64) * (DM / 64), I_INE = (DM / 64) * (EVEN_IN / 64), I_SQ = (DM / 64) * (DM / 64), I_INO = (DM / 64) * ((ODD_IN + 63) / 64);
constexpr int IT_FIN = 0, IT_FOUT = 4 * I_FIN, IT_INE = IT_FOUT + 4 * I_FOUT, IT_OUTE = IT_INE + I_INE, IT_OUTO = IT_OUTE + I_SQ, IT_INO = IT_OUTO + I_SQ;
DI void convert_item(const Params& p, LAS float* scr, int it, int lane) {
    unsigned char* ws = p.ws;
    int r = it;
    if (r < 4 * I_FIN) { const int w = r / I_FIN, l = w >> 1, which = w & 1;
        transpose_item((const float*)p.in[which ? I_WF2I : I_WF1I] + (size_t)l * DM * 2 * DFF, DM, 2 * DFF, (bf16*)(ws + WS_WFIN) + (size_t)w * 2 * DFF * DM, RowSwiglu(), scr, r % I_FIN, lane, (const float*)p.in[which ? I_NF2 : I_NF1] + l * DM); return; }
    r -= 4 * I_FIN;
    if (r < 4 * I_FOUT) { const int w = r / I_FOUT, l = w >> 1, which = w & 1;
        transpose_item((const float*)p.in[which ? I_WF2O : I_WF1O] + (size_t)l * DFF * DM, DFF, DM, (bf16*)(ws + WS_WFOUT) + (size_t)w * DM * DFF, RowId(), scr, r % I_FOUT, lane); return; }
    r -= 4 * I_FOUT;
    if (r < I_INE) { transpose_item((const float*)p.in[I_WINE], DM, EVEN_IN, (bf16*)(ws + WS_WINE), RowId(), scr, r, lane, (const float*)p.in[I_NM]); return; }
    r -= I_INE;
    if (r < I_SQ) { transpose_item((const float*)p.in[I_WOUTE], DM, DM, (bf16*)(ws + WS_WOUTE), RowId(), scr, r, lane); return; }
    r -= I_SQ;
    if (r < I_SQ) { transpose_item((const float*)p.in[I_WOUTO], DM, DM, (bf16*)(ws + WS_WOUTO), RowId(), scr, r, lane); return; }
    r -= I_SQ;
    transpose_item((const float*)p.in[I_WINO], DM, ODD_IN, (bf16*)(ws + WS_WINO), RowId(), scr, r, lane, (const float*)p.in[I_NM] + DM);
}
constexpr int DEF_N = I_FIN + I_FOUT + I_SQ;
DI int defer_item(int v) { return v < I_FIN ? IT_FIN + 3 * I_FIN + v : v < I_FIN + I_FOUT ? IT_FOUT + 3 * I_FOUT + (v - I_FIN) : IT_OUTO + (v - I_FIN - I_FOUT); }
DI bool is_deferred(int it) { return (it >= IT_FIN + 1 * I_FIN && it < IT_FIN + 2 * I_FIN) || (it >= IT_FIN + 3 * I_FIN && it < IT_FIN + 4 * I_FIN) || (it >= IT_FOUT + 1 * I_FOUT && it < IT_FOUT + 2 * I_FOUT) ||
                                     (it >= IT_FOUT + 3 * I_FOUT && it < IT_FOUT + 4 * I_FOUT) || (it >= IT_OUTE && it < IT_OUTO + I_SQ); }
constexpr int DEF3_N = I_FIN + I_FOUT + I_SQ;
DI int defer3_item(int v) { return v < I_FIN ? IT_FIN + 1 * I_FIN + v : v < I_FIN + I_FOUT ? IT_FOUT + 1 * I_FOUT + (v - I_FIN) : IT_OUTE + (v - I_FIN - I_FOUT); }
DI void phase_prologue(const Params& p, LAS unsigned char* lds, int gw, int NGW, int wave, int lane) {
    LAS float* scr = (LAS float*)(lds + wave * 16384);
    constexpr int NITEMS = IT_INO + I_INO;
    for (int it = gw; it < NITEMS; it += NGW) if (!is_deferred(it)) convert_item(p, scr, it, lane);
    { u32x4* z = (u32x4*)((bf16*)(p.ws + WS_WINO) + (size_t)ODD_IN * DM); const int n16 = (ODD_PAD - ODD_IN) * DM * 2 / 16;
      for (int i = gw * 64 + lane; i < n16; i += NGW * 64) z[i] = (u32x4){0u, 0u, 0u, 0u}; }
}
DI void phase_input_rows(const float* src_p, const float* src_s, bf16* xb, float* ssq, int gw, int NGW, int lane) {
    for (int m = gw; m < MT; m += 2 * NGW) {
        const int m1 = m + NGW < MT ? m + NGW : m;
        const float* r0 = m < MP ? src_p + (size_t)m * DM : src_s + (size_t)(m - MP) * DM;
        const float* r1 = m1 < MP ? src_p + (size_t)m1 * DM : src_s + (size_t)(m1 - MP) * DM;
        const f32x4* x0 = (const f32x4*)r0 + lane; const f32x4* x1 = (const f32x4*)r1 + lane; f32x4 v[4], w[4]; float s = 0.f, t = 0.f;
#pragma unroll
        for (int j = 0; j < 4; ++j) { v[j] = x0[64 * j]; w[j] = x1[64 * j]; }
#pragma unroll
        for (int j = 0; j < 4; ++j) { s += (v[j].x * v[j].x + v[j].y * v[j].y) + (v[j].z * v[j].z + v[j].w * v[j].w); t += (w[j].x * w[j].x + w[j].y * w[j].y) + (w[j].z * w[j].z + w[j].w * w[j].w); }
        s = wave_sum(s); t = wave_sum(t);
        u32x2* o0 = (u32x2*)(xb + (size_t)m * DM) + lane; u32x2* o1 = (u32x2*)(xb + (size_t)m1 * DM) + lane;
#pragma unroll
        for (int j = 0; j < 4; ++j) { u32x2 a; a.x = pk2(v[j].x, v[j].y); a.y = pk2(v[j].z, v[j].w); o0[64 * j] = a; }
        if (m1 != m) {
#pragma unroll
            for (int j = 0; j < 4; ++j) { u32x2 a; a.x = pk2(w[j].x, w[j].y); a.y = pk2(w[j].z, w[j].w); o1[64 * j] = a; } }
        if (lane == 0) { ((unsigned*)ssq)[m] = (unsigned)(s * 1024.f + 0.5f); if (m1 != m) ((unsigned*)ssq)[m1] = (unsigned)(t * 1024.f + 0.5f); }
    }
}
constexpr int GS_LD = 72;
template <int ROWS> struct GsRegs { u32x4 a[ROWS / 64], b; };
template <int ROWS> DI void gs_load(GsRegs<ROWS>& R, const bf16* ap, const bf16* bp, int K, int kt) {
#pragma unroll
    for (int rep = 0; rep < ROWS / 64; ++rep) R.a[rep] = *(const u32x4*)(ap + (size_t)(64 * rep) * K + kt * 64);
    R.b = *(const u32x4*)(bp + kt * 64);
}
template <int ROWS> DI void gs_store(const GsRegs<ROWS>& R, LAS unsigned char* buf, int soff) {
#pragma unroll
    for (int rep = 0; rep < ROWS / 64; ++rep) *(LAS u32x4*)(buf + soff + rep * (64 * GS_LD * 2)) = R.a[rep];
    *(LAS u32x4*)(buf + ROWS * GS_LD * 2 + soff) = R.b;
}
template <int ROWS> DI void gs_compute(f32x16& acc0, f32x16& acc1, const LAS unsigned char* ab, int wave, int r, int h2) {
    const LAS unsigned char* bb = ab + ROWS * GS_LD * 2;
#pragma unroll
    for (int s = 0; s < 4; ++s) {
        const bf16x8 a = *(const LAS bf16x8*)(ab + ((32 * wave + r) * GS_LD + 16 * s + 8 * h2) * 2);
        const bf16x8 b0 = *(const LAS bf16x8*)(bb + (r * GS_LD + 16 * s + 8 * h2) * 2), b1 = *(const LAS bf16x8*)(bb + ((32 + r) * GS_LD + 16 * s + 8 * h2) * 2);
        acc0 = MFMA32(a, b0, acc0); acc1 = MFMA32(a, b1, acc1);
    }
}
template <int ROWS, class Epi> DI void gemm_small_unit(LAS unsigned char* lds, const bf16* A, const bf16* Bt, int K, int m0, int n0, int n1, const Epi& E, int tid_, int wave) {
    constexpr int BUF = (ROWS + 64) * GS_LD * 2;
    int tid = tid_; asm volatile("" : "+v"(tid));
    const int lane = tid & 63, r = lane & 31, h2 = lane >> 5;
    const int arow = tid >> 3, ck = tid & 7;
    const bf16* ap = A + (size_t)(m0 + arow) * K + ck * 8;
    const bf16* bp = Bt + (size_t)(arow < 32 ? n0 + arow : n1 + arow - 32) * K + ck * 8;
    const int soff = (arow * GS_LD + ck * 8) * 2;
    f32x16 acc0, acc1;
#pragma unroll
    for (int i = 0; i < 16; ++i) { acc0[i] = 0.f; acc1[i] = 0.f; }
    GsRegs<ROWS> R0, R1, R2, R3;
    gs_load<ROWS>(R0, ap, bp, K, 0); gs_load<ROWS>(R1, ap, bp, K, 1); gs_load<ROWS>(R2, ap, bp, K, 2); gs_load<ROWS>(R3, ap, bp, K, 3);
    gs_store<ROWS>(R0, lds, soff);
    __syncthreads();
    const int nkt = K >> 6;
#define GS_STEP(RF, RN, t) do { gs_load<ROWS>(RF, ap, bp, K, ((t) + 4 < nkt) ? (t) + 4 : nkt - 1); \
        if (wave < ROWS / 32) gs_compute<ROWS>(acc0, acc1, lds + ((t) & 1) * BUF, wave, r, h2); \
        gs_store<ROWS>(RN, lds + (((t) + 1) & 1) * BUF, soff); \
        __syncthreads(); } while (0)
#pragma unroll 1
    for (int kt = 0; kt < nkt; kt += 4) { GS_STEP(R0, R1, kt); GS_STEP(R1, R2, kt + 1); GS_STEP(R2, R3, kt + 2); GS_STEP(R3, R0, kt + 3); }
#undef GS_STEP
    if (wave < ROWS / 32) E(acc0, acc1, m0 + 32 * wave, n0, n1, r, h2);
}
struct SEpiSwiglu { bf16* H; int colbase; const float* ssq;
    DI void operator()(const f32x16& a0, const f32x16& a1, int row0, int, int, int r, int h2) const {
#pragma unroll
        for (int i = 0; i < 16; ++i) { const int row = row0 + (i & 3) + 8 * (i >> 2) + 4 * h2; const float rs = pg8::row_rstd(ssq, row); H[(size_t)row * DFF + colbase + r] = f2bf(fsilu(a0[i] * rs) * (a1[i] * rs)); } } };
template <bool BASE_F32, bool OUT_F32> struct SEpiResT { const void* base; void* out; float* ssq; float alpha;
    DI void operator()(const f32x16& a0, const f32x16& a1, int row0, int n0, int n1, int r, int h2) const {
#pragma unroll
        for (int i = 0; i < 16; ++i) { const int row = row0 + (i & 3) + 8 * (i >> 2) + 4 * h2; const size_t ol = (size_t)(row - MP) * DM, og = (size_t)row * DM;
            const float b0 = BASE_F32 ? ((const float*)base)[ol + n0 + r] : bf2f(((const bf16*)base)[og + n0 + r]), b1 = BASE_F32 ? ((const float*)base)[ol + n1 + r] : bf2f(((const bf16*)base)[og + n1 + r]);
            const float v0 = b0 + alpha * a0[i], v1 = b1 + alpha * a1[i];
            if (OUT_F32) { ((float*)out)[ol + n0 + r] = v0; ((float*)out)[ol + n1 + r] = v1; } else { ((bf16*)out)[og + n0 + r] = f2bf(v0); ((bf16*)out)[og + n1 + r] = f2bf(v1); }
            if (ssq) { float s = v0 * v0 + v1 * v1;
#pragma unroll
                for (int of = 1; of < 32; of <<= 1) s += __shfl_xor(s, of);
                if (r == 0) pg8::ssq_add(ssq, row, s); } } } };
struct SEpiProj { bf16* O; int ldc; const float* ssq;
    DI void operator()(const f32x16& a0, const f32x16& a1, int row0, int n0, int n1, int r, int h2) const {
#pragma unroll
        for (int i = 0; i < 16; ++i) { const int row = row0 + (i & 3) + 8 * (i >> 2) + 4 * h2; const float rs = pg8::row_rstd(ssq, row); const size_t o = (size_t)row * ldc; O[o + n0 + r] = f2bf(a0[i] * rs); O[o + n1 + r] = f2bf(a1[i] * rs); } } };
DI void qkv_row(const Params& p, const bf16* PROJ, int m, int lane, float* kout, float* vout, u32x4& vraw) {
    bf16* QB = (bf16*)(p.ws + WS_QB); bf16* KB = (bf16*)(p.ws + WS_KB);
    const bf16* pr = PROJ + (size_t)m * EVEN_IN;
    const u32x4 q8 = *(const u32x4*)(pr + 8 * lane), k8 = *(const u32x4*)(pr + SBW + 8 * lane), v8 = *(const u32x4*)(pr + 2 * SBW + 8 * lane);
    float q[8], k[8], v[8];
#pragma unroll
    for (int j = 0; j < 4; ++j) { q[2 * j] = bflo(q8[j]); q[2 * j + 1] = bfhi(q8[j]); k[2 * j] = bflo(k8[j]); k[2 * j + 1] = bfhi(k8[j]); v[2 * j] = bflo(v8[j]); v[2 * j + 1] = bfhi(v8[j]); }
    float sq = 0.f, sk = 0.f;
#pragma unroll
    for (int j = 0; j < 8; ++j) { sq += q[j] * q[j]; sk += k[j] * k[j]; }
#pragma unroll
    for (int o = 1; o < 8; o <<= 1) { sq += __shfl_xor(sq, o); sk += __shfl_xor(sk, o); }
    const float rq = frsq(sq * (1.f / SBD) + EPS) * (0.125f * LOG2E), rk = frsq(sk * (1.f / SBD) + EPS);
    const float* qg = (const float*)p.in[I_QG] + 8 * (lane & 7); const float* kg = (const float*)p.in[I_KG] + 8 * (lane & 7);
    const f32x4 qg0 = *(const f32x4*)qg, qg1 = *(const f32x4*)(qg + 4), kg0 = *(const f32x4*)kg, kg1 = *(const f32x4*)(kg + 4);
    float qn[8], kn[8];
#pragma unroll
    for (int j = 0; j < 4; ++j) { qn[j] = q[j] * rq * qg0[j]; qn[4 + j] = q[4 + j] * rq * qg1[j]; kn[j] = k[j] * rk * kg0[j]; kn[4 + j] = k[4 + j] * rk * kg1[j]; }
    u32x4 qo, ko;
#pragma unroll
    for (int j = 0; j < 4; ++j) { qo[j] = pk2(qn[2 * j], qn[2 * j + 1]); ko[j] = pk2(kn[2 * j], kn[2 * j + 1]); }
    *(u32x4*)(QB + (size_t)m * SBW + 8 * lane) = qo; *(u32x4*)(KB + (size_t)m * SBW + 8 * lane) = ko;
    *(f32x4*)(kout + 8 * lane) = (f32x4){kn[0], kn[1], kn[2], kn[3]}; *(f32x4*)(kout + 8 * lane + 4) = (f32x4){kn[4], kn[5], kn[6], kn[7]};
    *(f32x4*)(vout + 8 * lane) = (f32x4){v[0], v[1], v[2], v[3]}; *(f32x4*)(vout + 8 * lane + 4) = (f32x4){v[4], v[5], v[6], v[7]};
    vraw = v8;
}
DI void lru_ab(float r_pre, float i_pre, float xc, float sp_lam8, float& a, float& b) {
    const float rr = fsigmoid(r_pre), ii = fsigmoid(i_pre);
    const float log_a = -sp_lam8 * rr;
    a = fexp2(log_a * LOG2E);
    b = __builtin_amdgcn_sqrtf(fnegexpm1(2.0f * log_a)) * (ii * xc);
}
DI void phase_even_a(const Params& p, LAS unsigned char* lds, int tid, int lane_, int wave, int G) {
    unsigned char* ws = p.ws;
    const bf16* PROJ = (const bf16*)(ws + WS_PROJ);
    bf16* VT = (bf16*)(ws + WS_VT); bf16* VS = (bf16*)(ws + WS_VS); bf16* AO = (bf16*)(ws + WS_AO);
    bf16* HL = (bf16*)(ws + WS_HL); bf16* PP = (bf16*)(ws + WS_PP); float* AGG = (float*)(ws + WS_AGG);
    constexpr int VLD = SBW + 8;
    LAS bf16* vt = (LAS bf16*)lds;
    LAS float* xc = (LAS float*)lds;
    const int ch0 = tid, lane0 = lane_;
    const float* cw = (const float*)p.in[I_LCW];
    const float cw0 = cw[ch0], cw1 = cw[LRW + ch0], cw2 = cw[2 * LRW + ch0], cw3 = cw[3 * LRW + ch0], cb = ((const float*)p.in[I_LCB])[ch0];
    const float b_a = ((const float*)p.in[I_LBA])[ch0], b_i = ((const float*)p.in[I_LBI])[ch0];
    const float sp_lam8 = 8.0f * fsoftplus(-((const float*)p.in[I_LAM])[ch0]);
    f32x2 wa[32], wi[32];
    { const float* pa = (const float*)p.in[I_LWA] + (size_t)wave * 4096 + lane0; const float* pi = (const float*)p.in[I_LWI] + (size_t)wave * 4096 + lane0;
#pragma unroll
      for (int c = 0; c < 32; ++c) { wa[c].x = pa[(2 * c) * 64]; wa[c].y = pa[(2 * c + 1) * 64]; wi[c].x = pi[(2 * c) * 64]; wi[c].y = pi[(2 * c + 1) * 64]; } }
    for (int unit = blockIdx.x; unit < NB_P * 64 + NB_S; unit += G) {
        const bool smp = unit >= NB_P * 64;
        if (!smp) {
            const int b = unit >> 6, c = unit & 63, t0 = c * 64, m0 = b * T_P + t0;
            int tidv = tid; asm volatile("" : "+v"(tidv)); const int lane = tidv & 63, ch = tidv;
#pragma unroll 2
            for (int i = 0; i < 8; ++i) { const int tl = wave * 8 + i, m = m0 + tl; u32x4 vraw;
                qkv_row(p, PROJ, m, lane, p.out + O_KP + (size_t)m * SBW, p.out + O_VP + (size_t)m * SBW, vraw);
                *(LAS u32x4*)(vt + tl * VLD + 8 * lane) = vraw; }
            __syncthreads();
            { const int col = tidv; bf16* dst = VT + ((size_t)(b * SBH) * SBD + col) * T_P + t0;
#pragma unroll
              for (int j = 0; j < 8; ++j) { unsigned w[4];
#pragma unroll
                  for (int i = 0; i < 4; ++i) w[i] = (unsigned)vt[(8 * j + 2 * i) * VLD + col] | ((unsigned)vt[(8 * j + 2 * i + 1) * VLD + col] << 16);
                  *(u32x4*)(dst + 8 * j) = (u32x4){w[0], w[1], w[2], w[3]}; } }
            __syncthreads();
            float x0 = 0.f, x1 = 0.f, x2 = 0.f;
            if (c > 0) { x0 = bf2f(PROJ[(size_t)(m0 - 3) * EVEN_IN + 3 * SBW + ch]); x1 = bf2f(PROJ[(size_t)(m0 - 2) * EVEN_IN + 3 * SBW + ch]); x2 = bf2f(PROJ[(size_t)(m0 - 1) * EVEN_IN + 3 * SBW + ch]); }
#pragma unroll 1
            for (int tb = 0; tb < 64; tb += 16) {
                bf16 xr[16];
#pragma unroll
                for (int t = 0; t < 16; ++t) xr[t] = PROJ[(size_t)(m0 + tb + t) * EVEN_IN + 3 * SBW + ch];
#pragma unroll
                for (int t = 0; t < 16; ++t) { const float x3 = bf2f(xr[t]); xc[(tb + t) * LRW + ch] = cb + cw0 * x0 + cw1 * x1 + cw2 * x2 + cw3 * x3; x0 = x1; x1 = x2; x2 = x3; } }
            if (c == 63) { float* o = p.out + O_LCP + (size_t)b * 3 * LRW + ch; o[0] = x0; o[LRW] = x1; o[2 * LRW] = x2; }
            __syncthreads();
            float h = 0.f, P = 1.f;
#pragma unroll 1
            for (int t = 0; t < 64; ++t) {
                const LAS f32x4* xr4 = (const LAS f32x4*)(xc + t * LRW + wave * 64);
                f32x2 ra = {b_a, 0.f}, rb = {0.f, 0.f}, ia = {b_i, 0.f}, ib = {0.f, 0.f};
#pragma unroll
                for (int c4 = 0; c4 < 16; ++c4) { const f32x4 x = xr4[c4];
                    const f32x2 xl = {x[0], x[1]}, xh = {x[2], x[3]};
                    ra = __builtin_elementwise_fma(xl, wa[2 * c4], ra); rb = __builtin_elementwise_fma(xh, wa[2 * c4 + 1], rb);
                    ia = __builtin_elementwise_fma(xl, wi[2 * c4], ia); ib = __builtin_elementwise_fma(xh, wi[2 * c4 + 1], ib);
                    if ((c4 & 3) == 3) asm volatile("" ::: "memory"); }
                float a, bb; lru_ab((ra.x + ra.y) + (rb.x + rb.y), (ia.x + ia.y) + (ib.x + ib.y), xc[t * LRW + ch], sp_lam8, a, bb);
                h = a * h + bb; P *= a;
                HL[(size_t)(m0 + t) * LRW + ch] = f2bf(h); PP[(size_t)(m0 + t) * LRW + ch] = f2bf(P);
            }
            AGG[((size_t)(b * 64 + c) * 2 + 0) * LRW + ch] = P; AGG[((size_t)(b * 64 + c) * 2 + 1) * LRW + ch] = h;
            __syncthreads();
        } else {
            const int s = unit - NB_P * 64, m0 = MP + 4 * s;
            int chs = tid; asm volatile("" : "+v"(chs)); const int lane = chs & 63;
            if (wave < 4) { const int m = m0 + wave; u32x4 vraw;
                qkv_row(p, PROJ, m, lane, p.out + O_KS + (size_t)(4 * s + wave) * SBW, p.out + O_VS + (size_t)(4 * s + wave) * SBW, vraw);
                *(u32x4*)(VS + (size_t)(4 * s + wave) * SBW + 8 * lane) = vraw; }
            const float* st = (const float*)p.in[I_SLC] + (size_t)s * 3 * LRW + chs;
            float xp[7]; xp[0] = st[0]; xp[1] = st[LRW]; xp[2] = st[2 * LRW];
#pragma unroll
            for (int t = 0; t < 4; ++t) xp[3 + t] = bf2f(PROJ[(size_t)(m0 + t) * EVEN_IN + 3 * SBW + chs]);
#pragma unroll
            for (int t = 0; t < 4; ++t) xc[t * LRW + chs] = cb + cw0 * xp[t] + cw1 * xp[t + 1] + cw2 * xp[t + 2] + cw3 * xp[t + 3];
            { float* o = p.out + O_LCS + (size_t)s * 3 * LRW + chs; o[0] = xp[4]; o[LRW] = xp[5]; o[2 * LRW] = xp[6]; }
            __syncthreads();
            float h = ((const float*)p.in[I_SLH])[(size_t)s * LRW + chs];
#pragma unroll 1
            for (int t = 0; t < 4; ++t) {
                const LAS f32x4* xr4 = (const LAS f32x4*)(xc + t * LRW + wave * 64);
                f32x2 ra = {b_a, 0.f}, rb = {0.f, 0.f}, ia = {b_i, 0.f}, ib = {0.f, 0.f};
#pragma unroll
                for (int c4 = 0; c4 < 16; ++c4) { const f32x4 x = xr4[c4];
                    const f32x2 xl = {x[0], x[1]}, xh = {x[2], x[3]};
                    ra = __builtin_elementwise_fma(xl, wa[2 * c4], ra); rb = __builtin_elementwise_fma(xh, wa[2 * c4 + 1], rb);
                    ia = __builtin_elementwise_fma(xl, wi[2 * c4], ia); ib = __builtin_elementwise_fma(xh, wi[2 * c4 + 1], ib);
                    if ((c4 & 3) == 3) asm volatile("" ::: "memory"); }
                float a, bb; lru_ab((ra.x + ra.y) + (rb.x + rb.y), (ia.x + ia.y) + (ib.x + ib.y), xc[t * LRW + chs], sp_lam8, a, bb);
                h = a * h + bb;
                const float xg = bf2f(PROJ[(size_t)(m0 + t) * EVEN_IN + 4 * SBW + chs]);
                AO[(size_t)(m0 + t) * DM + SBW + chs] = f2bf(h * fgelu_tanh(xg));
            }
            (p.out + O_LHS)[(size_t)s * LRW + chs] = h;
            __syncthreads();
        }
    }
}
DI unsigned queue_next(unsigned* head, volatile LAS unsigned* slot, int tid) {
    if (tid == 0) *slot = __hip_atomic_fetch_add(head, 1u, __ATOMIC_RELAXED, __HIP_MEMORY_SCOPE_AGENT);
    __syncthreads();
    const unsigned u = __builtin_amdgcn_readfirstlane(*slot);
    __syncthreads();
    return u;
}
template <int CTRL> DI float dppf(float x) { return __builtin_bit_cast(float, __builtin_amdgcn_mov_dpp(__builtin_bit_cast(int, x), CTRL, 0xf, 0xf, true)); }
struct SmpAcc { float carry; f32x4 acc[4]; };
struct SmpKV { f32x4 k[4], v[4]; };
DI void smp_key(SmpAcc& A, const f32x4 (&q)[4], const f32x4 K4, const f32x4 V4, float bias2, int c, bool masked) {
    const f32x2 Kl = __builtin_shufflevector(K4, K4, 0, 1), Kh = __builtin_shufflevector(K4, K4, 2, 3);
    f32x2 t0 = Kl * __builtin_shufflevector(q[0], q[0], 0, 1), t1 = Kl * __builtin_shufflevector(q[1], q[1], 0, 1), t2 = Kl * __builtin_shufflevector(q[2], q[2], 0, 1), t3 = Kl * __builtin_shufflevector(q[3], q[3], 0, 1);
    t0 = __builtin_elementwise_fma(Kh, __builtin_shufflevector(q[0], q[0], 2, 3), t0); t1 = __builtin_elementwise_fma(Kh, __builtin_shufflevector(q[1], q[1], 2, 3), t1);
    t2 = __builtin_elementwise_fma(Kh, __builtin_shufflevector(q[2], q[2], 2, 3), t2); t3 = __builtin_elementwise_fma(Kh, __builtin_shufflevector(q[3], q[3], 2, 3), t3);
    const float z0 = t0.x + t0.y, z1 = t1.x + t1.y, z2 = t2.x + t2.y, z3 = t3.x + t3.y;
    const bool b0 = c & 1, b1 = c & 2;
    const float y0 = (b0 ? z2 : z0) + dppf<0xB1>(b0 ? z0 : z2), y1 = (b0 ? z3 : z1) + dppf<0xB1>(b0 ? z1 : z3);
    float x = (b1 ? y1 : y0) + dppf<0x4E>(b1 ? y0 : y1);
    x += dppf<0x124>(x); x += dppf<0x128>(x);
    const float zz = fminf(x + bias2, 80.f), e = fexp2(zz); float kp = frcp(1.0f + e), sg = e * kp;
    if (masked) { kp = 1.f; sg = 0.f; }
    const float w = sg * A.carry;
    A.carry *= kp;
    const float w0 = dppf<0x00>(w), w1 = dppf<0xAA>(w), w2 = dppf<0x55>(w), w3 = dppf<0xFF>(w);
    A.acc[0] += V4 * w0; A.acc[1] += V4 * w1; A.acc[2] += V4 * w2; A.acc[3] += V4 * w3;
}
DI void smp_load(SmpKV& R, const float* ck, const float* cv, int phys, int pos0, int hg, int lane) {
    const size_t base = ((size_t)phys * PAGE + pos0) * SBW + hg * 256 + lane * 4;
#pragma unroll
    for (int u = 0; u < 4; ++u) { R.k[u] = __builtin_nontemporal_load((const f32x4*)(ck + base + (size_t)u * SBW)); R.v[u] = __builtin_nontemporal_load((const f32x4*)(cv + base + (size_t)u * SBW)); }
}
DI void attn_sample_unit(const Params& p, LAS unsigned char* lds, int lane_, int wave, int s, int half) {
    unsigned char* ws = p.ws;
    const bf16* QB = (const bf16*)(ws + WS_QB); const bf16* KB = (const bf16*)(ws + WS_KB); const bf16* VS = (const bf16*)(ws + WS_VS); bf16* AO = (bf16*)(ws + WS_AO);
    int lane = lane_; asm volatile("" : "+v"(lane));
    const int hg = wave & 1, seg = wave >> 1, hh = lane >> 4, c = lane & 15, h = 4 * hg + hh, qme = 2 * (c & 1) + ((c >> 1) & 1);
    const float bias2 = ((const float*)p.in[I_SBB])[h] * LOG2E;
    f32x4 q[4];
#pragma unroll
    for (int i = 0; i < 4; ++i) { const u32x2 w = *(const u32x2*)(QB + (size_t)(MP + 4 * s + i) * SBW + h * SBD + 4 * c); q[i] = (f32x4){bflo(w.x), bfhi(w.x), bflo(w.y), bfhi(w.y)}; }
    SmpAcc A; A.carry = 1.f;
#pragma unroll
    for (int i = 0; i < 4; ++i) A.acc[i] = (f32x4){0.f, 0.f, 0.f, 0.f};
    if (half && seg == 0) {
#pragma unroll
        for (int n = 3; n >= 0; --n) { const u32x2 kw = *(const u32x2*)(KB + (size_t)(MP + 4 * s + n) * SBW + h * SBD + 4 * c), vw = *(const u32x2*)(VS + (size_t)(4 * s + n) * SBW + h * SBD + 4 * c);
            smp_key(A, q, (f32x4){bflo(kw.x), bfhi(kw.x), bflo(kw.y), bfhi(kw.y)}, (f32x4){bflo(vw.x), bfhi(vw.x), bflo(vw.y), bfhi(vw.y)}, bias2, c, n >= qme); } }
    const float* ck = (const float*)p.in[I_CK]; const float* cv = (const float*)p.in[I_CV];
    typedef const __attribute__((address_space(4))) int* cint_p;
    cint_p pt = (cint_p)(unsigned long long)p.in[I_PT] + s * NPAGES + half * 8 + 6 - 2 * seg;
    SmpKV R0, R1, R2, R3;
#define SMP_LOAD(R, sidx) do { const int sn_ = (sidx) < 64 ? (sidx) : 63; const int ph_ = __builtin_amdgcn_readfirstlane(pt[1 - (sn_ >> 5)]); smp_load(R, ck, cv, ph_, 124 - 4 * (sn_ & 31), hg, lane); __builtin_amdgcn_sched_barrier(0); } while (0)
#define SMP_COMP(R) do { _Pragma("unroll") for (int u = 3; u >= 0; --u) smp_key(A, q, R.k[u], R.v[u], bias2, c, false); } while (0)
    SMP_LOAD(R0, 0); SMP_LOAD(R1, 1); SMP_LOAD(R2, 2);
#pragma unroll 1
    for (int st = 0; st < 64; st += 4) {
        SMP_LOAD(R3, st + 3); SMP_COMP(R0);
        SMP_LOAD(R0, st + 4); SMP_COMP(R1);
        SMP_LOAD(R1, st + 5); SMP_COMP(R2);
        SMP_LOAD(R2, st + 6); SMP_COMP(R3);
    }
#undef SMP_LOAD
#undef SMP_COMP
    const float P[4] = {dppf<0x00>(A.carry), dppf<0xAA>(A.carry), dppf<0x55>(A.carry), dppf<0xFF>(A.carry)};
    LAS float* xo = (LAS float*)lds;
    LAS float* xp = (LAS float*)(lds + 32768);
#pragma unroll
    for (int i = 0; i < 4; ++i) *(LAS f32x4*)(xo + ((wave * 4 + i) * 64 + lane) * 4) = A.acc[i];
    *(LAS f32x4*)(xp + (wave * 64 + lane) * 4) = (f32x4){P[0], P[1], P[2], P[3]};
    __syncthreads();
    if (seg == 0) {
        f32x4 o[4]; f32x4 pt_ = {1.f, 1.f, 1.f, 1.f};
#pragma unroll
        for (int i = 0; i < 4; ++i) o[i] = (f32x4){0.f, 0.f, 0.f, 0.f};
#pragma unroll
        for (int sg_ = 3; sg_ >= 0; --sg_) { const int wv = 2 * sg_ + hg; const f32x4 ps = *(const LAS f32x4*)(xp + (wv * 64 + lane) * 4);
#pragma unroll
            for (int i = 0; i < 4; ++i) o[i] = *(const LAS f32x4*)(xo + ((wv * 4 + i) * 64 + lane) * 4) + o[i] * ps[i];
            pt_ = pt_ * ps; }
        float* rec = (float*)(ws + WS_SPART) + (size_t)((s * 2 + hg) * 2 + half) * 1280;
#pragma unroll
        for (int i = 0; i < 4; ++i) *(f32x4*)(rec + (i * 64 + lane) * 4) = o[i];
        *(f32x4*)(rec + 1024 + lane * 4) = pt_;
        asm volatile("s_waitcnt vmcnt(0)" ::: "memory");
        __threadfence();
        asm volatile("s_waitcnt vmcnt(0)" ::: "memory");
        unsigned old = 0;
        if (lane == 0) old = __hip_atomic_fetch_add((unsigned*)(ws + WS_CTL) + CW_SMPCNT + s * 2 + hg, 1u, __ATOMIC_RELAXED, __HIP_MEMORY_SCOPE_AGENT);
        old = __builtin_amdgcn_readfirstlane(old);
        if (old == 1u) {
            __threadfence();
            asm volatile("s_waitcnt vmcnt(0)" ::: "memory");
            const float* orec = (const float*)(ws + WS_SPART) + (size_t)((s * 2 + hg) * 2 + (half ^ 1)) * 1280;
            const f32x4 Po = *(const f32x4*)(orec + 1024 + lane * 4);
#pragma unroll
            for (int i = 0; i < 4; ++i) { const f32x4 oo = *(const f32x4*)(orec + (i * 64 + lane) * 4);
                const f32x4 r = half ? o[i] + oo * pt_[i] : oo + o[i] * Po[i];
                u32x2 w; w.x = pk2(r[0], r[1]); w.y = pk2(r[2], r[3]); *(u32x2*)(AO + (size_t)(MP + 4 * s + i) * DM + h * SBD + 4 * c) = w; }
        }
    }
    __syncthreads();
}
DI void lru_fix_unit(const Params& p, int tid, int b, int c) {
    unsigned char* ws = p.ws;
    const bf16* PROJ = (const bf16*)(ws + WS_PROJ); const bf16* HL = (const bf16*)(ws + WS_HL); const bf16* PP = (const bf16*)(ws + WS_PP); const float* AGG = (const float*)(ws + WS_AGG); bf16* AO = (bf16*)(ws + WS_AO);
    int ch = tid; asm volatile("" : "+v"(ch));
    float carry = 0.f;
#pragma unroll 1
    for (int c0 = 0; c0 < c; c0 += 16) { float P[16], hh[16];
#pragma unroll
        for (int j = 0; j < 16; ++j) { const int cc = c0 + j < c ? c0 + j : c - 1; P[j] = AGG[((size_t)(b * 64 + cc) * 2 + 0) * LRW + ch]; hh[j] = AGG[((size_t)(b * 64 + cc) * 2 + 1) * LRW + ch]; }
#pragma unroll
        for (int j = 0; j < 16; ++j) if (c0 + j < c) carry = P[j] * carry + hh[j]; }
    const int m0 = b * T_P + c * 64; float hlast = 0.f;
#pragma unroll 1
    for (int t0 = 0; t0 < 64; t0 += 16) { bf16 hl[16], pp[16], xg[16];
#pragma unroll
        for (int j = 0; j < 16; ++j) { const size_t m = m0 + t0 + j; hl[j] = HL[m * LRW + ch]; pp[j] = PP[m * LRW + ch]; xg[j] = PROJ[m * EVEN_IN + 4 * SBW + ch]; }
#pragma unroll
        for (int j = 0; j < 16; ++j) { const size_t m = m0 + t0 + j; const float hv = bf2f(hl[j]) + bf2f(pp[j]) * carry; hlast = hv; AO[m * DM + SBW + ch] = f2bf(hv * fgelu_tanh(bf2f(xg[j]))); } }
    if (c == 63) (p.out + O_LHP)[(size_t)b * LRW + ch] = hlast;
}
DI void prompt_tile(const LAS unsigned char* kc, const LAS unsigned char* vc, const bf16x8 (&qf)[4], f32x16 (&accO)[2], float& carry, float bias2, int key0, int Q0, int r, int h2) {
    constexpr int KLD = 72, VLD = 68;
    if (key0 < Q0 + 31) {
        f32x16 sk[2];
#pragma unroll
        for (int kb = 0; kb < 2; ++kb) {
#pragma unroll
            for (int i = 0; i < 16; ++i) sk[kb][i] = bias2;
#pragma unroll
            for (int s = 0; s < 4; ++s) { const bf16x8 a = *(const LAS bf16x8*)(kc + (32 * kb + r) * (KLD * 2) + (16 * s + 8 * h2) * 2); sk[kb] = MFMA32(a, qf[s], sk[kb]); }
        }
        const bool need_mask = key0 + 63 >= Q0;
        f32x2 kp[2][8];
#pragma unroll
        for (int kb = 0; kb < 2; ++kb)
#pragma unroll
            for (int pq = 0; pq < 8; ++pq) {
                f32x2 e2; e2.x = fexp2(sk[kb][2 * pq]); e2.y = fexp2(sk[kb][2 * pq + 1]);
                const f32x2 d2 = e2 + 1.0f;
                f32x2 k2; k2.x = frcp(d2.x); k2.y = frcp(d2.y);
                kp[kb][pq] = k2;
            }
        if (need_mask) {
            asm volatile("" ::: "memory");
            const int lim = Q0 + r - key0 - 4 * h2;
#pragma unroll
            for (int kb = 0; kb < 2; ++kb)
#pragma unroll
                for (int pq = 0; pq < 8; ++pq) { const int ko = 32 * kb + ((2 * pq) & 3) + 8 * ((2 * pq) >> 2); if (ko >= lim) kp[kb][pq].x = 1.f; if (ko + 1 >= lim) kp[kb][pq].y = 1.f; }
        }
        float R[2][4], Rp[2][4];
#pragma unroll
        for (int kb = 0; kb < 2; ++kb)
#pragma unroll
            for (int q = 0; q < 4; ++q) { const f32x2 pr = kp[kb][2 * q] * kp[kb][2 * q + 1]; R[kb][q] = pr.x * pr.y; Rp[kb][q] = __shfl_xor(R[kb][q], 32); }
        float c = carry;
#pragma unroll
        for (int kb = 1; kb >= 0; --kb)
#pragma unroll
            for (int q = 3; q >= 0; --q) {
                const float E3 = c * (h2 ? 1.0f : Rp[kb][q]);
                c *= R[kb][q] * Rp[kb][q];
                const f32x2 ka = kp[kb][2 * q], kc = kp[kb][2 * q + 1];
                const float E2 = E3 * kc.y, E1 = E2 * kc.x, E0 = E1 * ka.y;
                const f32x2 w01 = (1.0f - ka) * (f32x2){E0, E1}, w23 = (1.0f - kc) * (f32x2){E2, E3};
                sk[kb][4 * q] = w01.x; sk[kb][4 * q + 1] = w01.y; sk[kb][4 * q + 2] = w23.x; sk[kb][4 * q + 3] = w23.y;
            }
        carry = c;
#pragma unroll
        for (int kb = 0; kb < 2; ++kb)
#pragma unroll
            for (int s = 0; s < 2; ++s) {
                u32x4 wp;
#pragma unroll
                for (int j = 0; j < 4; ++j) wp[j] = pk2(sk[kb][8 * s + 2 * j], sk[kb][8 * s + 2 * j + 1]);
                const bf16x8 wf = __builtin_bit_cast(bf16x8, wp);
#pragma unroll
                for (int db = 0; db < 2; ++db) {
                    const LAS unsigned char* va = vc + (32 * db + r) * (VLD * 2) + (32 * kb + 16 * s + 4 * h2) * 2;
                    const u32x2 lo = *(const LAS u32x2*)va, hi = *(const LAS u32x2*)(va + 16);
                    const bf16x8 vf = __builtin_bit_cast(bf16x8, (u32x4){lo.x, lo.y, hi.x, hi.y});
                    accO[db] = MFMA32(vf, wf, accO[db]);
                }
            }
    }
}
DI void sample_finish(const Params& p, LAS float* xo, LAS float* xp, const SmpAcc& A, int s, int half, int wave, int hg, int seg, int lane, int h, int c) {
    unsigned char* ws = p.ws; bf16* AO = (bf16*)(ws + WS_AO);
    const float P[4] = {dppf<0x00>(A.carry), dppf<0xAA>(A.carry), dppf<0x55>(A.carry), dppf<0xFF>(A.carry)};
#pragma unroll
    for (int i = 0; i < 4; ++i) *(LAS f32x4*)(xo + ((wave * 4 + i) * 64 + lane) * 4) = A.acc[i];
    *(LAS f32x4*)(xp + (wave * 64 + lane) * 4) = (f32x4){P[0], P[1], P[2], P[3]};
    __syncthreads();
    if (seg == 0) {
        f32x4 o[4]; f32x4 pt_ = {1.f, 1.f, 1.f, 1.f};
#pragma unroll
        for (int i = 0; i < 4; ++i) o[i] = (f32x4){0.f, 0.f, 0.f, 0.f};
#pragma unroll
        for (int sg_ = 3; sg_ >= 0; --sg_) { const int wv = 2 * sg_ + hg; const f32x4 ps = *(const LAS f32x4*)(xp + (wv * 64 + lane) * 4);
#pragma unroll
            for (int i = 0; i < 4; ++i) o[i] = *(const LAS f32x4*)(xo + ((wv * 4 + i) * 64 + lane) * 4) + o[i] * ps[i];
            pt_ = pt_ * ps; }
        float* rec = (float*)(ws + WS_SPART) + (size_t)((s * 2 + hg) * 2 + half) * 1280;
#pragma unroll
        for (int i = 0; i < 4; ++i) *(f32x4*)(rec + (i * 64 + lane) * 4) = o[i];
        *(f32x4*)(rec + 1024 + lane * 4) = pt_;
        asm volatile("s_waitcnt vmcnt(0)" ::: "memory");
        __threadfence();
        asm volatile("s_waitcnt vmcnt(0)" ::: "memory");
        unsigned old = 0;
        if (lane == 0) old = __hip_atomic_fetch_add((unsigned*)(ws + WS_CTL) + CW_SMPCNT + s * 2 + hg, 1u, __ATOMIC_RELAXED, __HIP_MEMORY_SCOPE_AGENT);
        old = __builtin_amdgcn_readfirstlane(old);
        if (old == 1u) {
            __threadfence();
            asm volatile("s_waitcnt vmcnt(0)" ::: "memory");
            const float* orec = (const float*)(ws + WS_SPART) + (size_t)((s * 2 + hg) * 2 + (half ^ 1)) * 1280;
            const f32x4 Po = *(const f32x4*)(orec + 1024 + lane * 4);
#pragma unroll
            for (int i = 0; i < 4; ++i) { const f32x4 oo = *(const f32x4*)(orec + (i * 64 + lane) * 4);
                const f32x4 rr = half ? o[i] + oo * pt_[i] : oo + o[i] * Po[i];
                u32x2 w; w.x = pk2(rr[0], rr[1]); w.y = pk2(rr[2], rr[3]); *(u32x2*)(AO + (size_t)(MP + 4 * s + i) * DM + h * SBD + 4 * c) = w; }
        }
    }
}
DI void phase_even_b(const Params& p, LAS unsigned char* lds, int tid_, int lane_, int wave, int G, int qsel = 0) {
    unsigned char* ws = p.ws;
    unsigned* headP = (unsigned*)(ws + WS_CTL) + CW_QUEUE + 64 * qsel; unsigned* headS = headP + 32;
    volatile LAS unsigned* slot = (volatile LAS unsigned*)(lds + LDSCTL_OFF + 128);
    const bf16* QB = (const bf16*)(ws + WS_QB); const bf16* KB = (const bf16*)(ws + WS_KB); const bf16* VT = (const bf16*)(ws + WS_VT); const bf16* VS = (const bf16*)(ws + WS_VS); bf16* AO = (bf16*)(ws + WS_AO);
    const float* ck = (const float*)p.in[I_CK]; const float* cv = (const float*)p.in[I_CV];
    typedef const __attribute__((address_space(4))) int* cint_p;
    constexpr unsigned N_ATT = NB_P * SBH * 16, N_FIX = NB_P * 64, N_PQ = N_ATT + N_FIX, N_SQ = 2 * NB_S;
    constexpr int KLD = 72, VLD = 68, KBUF = 64 * KLD * 2, VBUF = 64 * VLD * 2;
    LAS unsigned char* kl = lds; LAS unsigned char* vl = lds + 2 * KBUF;
    LAS float* xo = (LAS float*)(lds + 36864); LAS float* xp = (LAS float*)(lds + 36864 + 32768);
    int tid = tid_; asm volatile("" : "+v"(tid));
    const int lane = tid & 63, r = lane & 31, h2 = lane >> 5;
    bool pAct = false, pEmpty = (p.mode == 1); int pb = 0, ph = 0, Q0 = 0, kt = 0, cur = 0;
    bf16x8 qf[4]; f32x16 accO[2]; float pcarry = 1.f, pbias2 = 0.f; u32x4 kr0, vr0, kr1, vr1;
    const int srow = tid >> 3, sch = tid & 7, kdst = srow * (KLD * 2) + sch * 16, vdst = srow * (VLD * 2) + sch * 16;
    const bf16* ksrc = KB; const bf16* vsrc = VT;
    bool sAct = false, sEmpty = (p.mode == 2); int ss = 0, shalf = 0, st = 0;
    const int hg = wave & 1, seg = wave >> 1, hh = lane >> 4, c = lane & 15, sh = 4 * hg + hh, qme = 2 * (c & 1) + ((c >> 1) & 1);
    const float sbias2 = ((const float*)p.in[I_SBB])[sh] * LOG2E;
    LAS f32x4* sq = (LAS f32x4*)(lds + 36864 + 40960) + wave * 256 + lane;
    SmpAcc A; SmpKV R0, R1; cint_p spt = (cint_p)(unsigned long long)p.in[I_PT];
#pragma unroll
    for (int i = 0; i < 4; ++i) { qf[i] = (bf16x8){0, 0, 0, 0, 0, 0, 0, 0}; A.acc[i] = (f32x4){0.f, 0.f, 0.f, 0.f}; }
    A.carry = 1.f;
#pragma unroll
    for (int i = 0; i < 16; ++i) { accO[0][i] = 0.f; accO[1][i] = 0.f; }
    kr0 = (u32x4){0u, 0u, 0u, 0u}; vr0 = kr0; kr1 = kr0; vr1 = kr0;
#pragma unroll
    for (int u = 0; u < 4; ++u) { R0.k[u] = (f32x4){0.f, 0.f, 0.f, 0.f}; R0.v[u] = R0.k[u]; R1.k[u] = R0.k[u]; R1.v[u] = R0.k[u]; }
#define SMP_LOAD(R, sidx) do { const int sn_ = (sidx) < 64 ? (sidx) : 63; const int ph_ = __builtin_amdgcn_readfirstlane(spt[1 - (sn_ >> 5)]); smp_load(R, ck, cv, ph_, 124 - 4 * (sn_ & 31), hg, lane); __builtin_amdgcn_sched_barrier(0); } while (0)
#define EB_ITER(SA, SB, PKA, PVA, PKB, PVB) { \
    bool fresh = false; \
    if (!pAct && !pEmpty) { \
        for (;;) { const unsigned u = queue_next(headP, slot, tid); \
            if (u >= N_PQ) { pEmpty = true; break; } \
            if (u >= N_ATT) { lru_fix_unit(p, tid, (int)((u - N_ATT) >> 6), (int)((u - N_ATT) & 63)); continue; } \
            const int qb = 15 - (int)(u >> 5), bh = (int)(u & 31); pb = bh >> 3; ph = bh & 7; Q0 = qb * 256 + wave * 32; kt = 4 * qb + 3; cur = 0; pcarry = 1.f; \
            pbias2 = ((const float*)p.in[I_SBB])[ph] * LOG2E; \
            { const bf16* qp = QB + (size_t)(pb * T_P + Q0 + r) * SBW + ph * SBD + 8 * h2; _Pragma("unroll") for (int s_ = 0; s_ < 4; ++s_) qf[s_] = *(const bf16x8*)(qp + 16 * s_); } \
            _Pragma("unroll") for (int i = 0; i < 16; ++i) { accO[0][i] = 0.f; accO[1][i] = 0.f; } \
            ksrc = KB + (size_t)(pb * T_P + srow) * SBW + ph * SBD + sch * 8; vsrc = VT + ((size_t)(pb * SBH + ph) * SBD + srow) * T_P + sch * 8; \
            PKA = *(const u32x4*)(ksrc + (size_t)(64 * kt) * SBW); PVA = *(const u32x4*)(vsrc + 64 * kt); \
            { const int k1 = kt > 0 ? kt - 1 : 0; PKB = *(const u32x4*)(ksrc + (size_t)(64 * k1) * SBW); PVB = *(const u32x4*)(vsrc + 64 * k1); } \
            *(LAS u32x4*)(kl + kdst) = PKA; *(LAS u32x2*)(vl + vdst) = (u32x2){PVA.x, PVA.y}; *(LAS u32x2*)(vl + vdst + 8) = (u32x2){PVA.z, PVA.w}; \
            pAct = true; fresh = true; break; } } \
    if (!sAct && !sEmpty) { const unsigned u = queue_next(headS, slot, tid); \
        if (u >= N_SQ) sEmpty = true; \
        else { ss = (int)(u >> 1); shalf = (int)(u & 1); st = 0; sAct = true; A.carry = 1.f; \
            f32x4 q[4]; \
            _Pragma("unroll") for (int i = 0; i < 4; ++i) { A.acc[i] = (f32x4){0.f, 0.f, 0.f, 0.f}; const u32x2 w = *(const u32x2*)(QB + (size_t)(MP + 4 * ss + i) * SBW + sh * SBD + 4 * c); q[i] = (f32x4){bflo(w.x), bfhi(w.x), bflo(w.y), bfhi(w.y)}; sq[64 * i] = q[i]; } \
            spt = (cint_p)(unsigned long long)p.in[I_PT] + ss * NPAGES + shalf * 8 + 6 - 2 * seg; \
            SMP_LOAD(SA, 0); SMP_LOAD(SB, 1); \
            if (shalf && seg == 0) { _Pragma("unroll") for (int n = 3; n >= 0; --n) { const u32x2 kw = *(const u32x2*)(KB + (size_t)(MP + 4 * ss + n) * SBW + sh * SBD + 4 * c), vw = *(const u32x2*)(VS + (size_t)(4 * ss + n) * SBW + sh * SBD + 4 * c); \
                smp_key(A, q, (f32x4){bflo(kw.x), bfhi(kw.x), bflo(kw.y), bfhi(kw.y)}, (f32x4){bflo(vw.x), bfhi(vw.x), bflo(vw.y), bfhi(vw.y)}, sbias2, c, n >= qme); } } } } \
    if (!pAct && !sAct) break; \
    if (fresh) __syncthreads(); \
      \
    { const int k2 = kt > 1 ? kt - 2 : 0; PKA = *(const u32x4*)(ksrc + (size_t)(64 * k2) * SBW); PVA = *(const u32x4*)(vsrc + 64 * k2); __builtin_amdgcn_sched_barrier(0); } \
    if (pAct) { \
        prompt_tile(kl + cur * KBUF, vl + cur * VBUF, qf, accO, pcarry, pbias2, 64 * kt, Q0, r, h2); \
        if (kt > 0) { LAS unsigned char* kn = kl + (cur ^ 1) * KBUF; LAS unsigned char* vn = vl + (cur ^ 1) * VBUF; \
            *(LAS u32x4*)(kn + kdst) = PKB; *(LAS u32x2*)(vn + vdst) = (u32x2){PVB.x, PVB.y}; *(LAS u32x2*)(vn + vdst + 8) = (u32x2){PVB.z, PVB.w}; } } \
    if (sAct) { f32x4 q[4]; _Pragma("unroll") for (int i = 0; i < 4; ++i) q[i] = sq[64 * i]; \
        _Pragma("unroll") for (int u = 3; u >= 0; --u) smp_key(A, q, SA.k[u], SA.v[u], sbias2, c, false); } \
    SMP_LOAD(SA, st + 2); \
    __syncthreads(); \
    if (pAct) { cur ^= 1; if (--kt < 0) { pAct = false; \
            bf16* orow = AO + (size_t)(pb * T_P + Q0 + r) * DM + ph * SBD; \
            _Pragma("unroll") for (int db = 0; db < 2; ++db) _Pragma("unroll") for (int g = 0; g < 4; ++g) { u32x2 w; w.x = pk2(accO[db][4 * g], accO[db][4 * g + 1]); w.y = pk2(accO[db][4 * g + 2], accO[db][4 * g + 3]); \
                *(u32x2*)(orow + 32 * db + 8 * g + 4 * h2) = w; } } } \
    if (sAct && ++st == 64) { sAct = false; sample_finish(p, xo, xp, A, ss, shalf, wave, hg, seg, lane, sh, c); } }
    for (;;) { EB_ITER(R0, R1, kr0, vr0, kr1, vr1) EB_ITER(R1, R0, kr1, vr1, kr0, vr0) }
#undef EB_ITER
#undef SMP_LOAD
    if (p.mode == 0) { unsigned* headC = headP + 16; LAS float* scr = (LAS float*)(lds + wave * 16384);
      for (;;) { const unsigned bt = queue_next(headC, slot, tid); if (bt * 8 >= (unsigned)DEF3_N) break;
          const int v = (int)bt * 8 + wave; if (v < DEF3_N) convert_item(p, scr, defer3_item(v), lane); } }
}
constexpr int OA_QL = 0, OA_KL = 17408, OA_VL = 34816, OA_KBT = 52224, OA_VBT = 70656, OA_AL = 89088, OA_TL = 106496, OA_G = 115712, OA_BETA = 115968, OA_GRAW = 116224;
constexpr int QLD = 136, TLD = 72, ALD = 68;
constexpr int OA_RAW = OA_KBT, RAWLD = 384, OA_CW = 116480;
DI void oa_dma(const bf16* PROJ, const bf16* zeros, LAS unsigned char* rawb, int unit, int tid, int wave) {
    const int h = unit & 7, c = (unit >> 3) & 63, b = unit >> 9, m0 = b * T_P + c * 64;
#pragma unroll
    for (int rep = 0; rep < 7; ++rep) { const int id = tid + 512 * rep, row = id / 48, sg = id - row * 48, tn = sg >> 4, ck = sg & 15;
        const bool valid = id < 67 * 48 && !(c == 0 && row < 3);
        const bf16* src = valid ? PROJ + (size_t)(m0 - 3 + row) * ODD_PAD + tn * DNW + h * DND + ck * 8 : zeros + (tid & 63) * 8;
        __builtin_amdgcn_global_load_lds((const unsigned*)src, (LAS unsigned*)(rawb + (512 * rep + 64 * wave) * 16), 16, 0, 0); }
}
DI void oa_conv8(const LAS bf16* raw, const LAS float* cwl, int tl, int tn, int ch0, float (&y)[8]) {
    float acc[8];
#pragma unroll
    for (int j = 0; j < 8; ++j) acc[j] = 0.f;
#pragma unroll
    for (int i = 0; i < 4; ++i) {
        const u32x4 x = *(const LAS u32x4*)(raw + (tl + i) * RAWLD + tn * DND + ch0);
        const f32x4 w0 = *(const LAS f32x4*)(cwl + (tn * 4 + i) * DND + ch0), w1 = *(const LAS f32x4*)(cwl + (tn * 4 + i) * DND + ch0 + 4);
        acc[0] += w0[0] * bflo(x.x); acc[1] += w0[1] * bfhi(x.x); acc[2] += w0[2] * bflo(x.y); acc[3] += w0[3] * bfhi(x.y);
        acc[4] += w1[0] * bflo(x.z); acc[5] += w1[1] * bfhi(x.z); acc[6] += w1[2] * bflo(x.w); acc[7] += w1[3] * bfhi(x.w);
    }
#pragma unroll
    for (int j = 0; j < 8; ++j) y[j] = fsilu(acc[j]);
}
DI int perm16c(int k) { return (k & ~12) | ((k & 4) << 1) | ((k & 8) >> 1); }
DI void dn_conv8(const bf16* PROJ, const float* cw, int m, int t_in_seq, int chan, float (&y)[8]) {
    float acc[8];
#pragma unroll
    for (int j = 0; j < 8; ++j) acc[j] = 0.f;
#pragma unroll
    for (int i = 0; i < 4; ++i) {
        if (t_in_seq - 3 + i >= 0) {
            const u32x4 x = *(const u32x4*)(PROJ + (size_t)(m - 3 + i) * ODD_PAD + chan);
            const f32x4 w0 = *(const f32x4*)(cw + i * 3 * DNW + chan), w1 = *(const f32x4*)(cw + i * 3 * DNW + chan + 4);
            acc[0] += w0[0] * bflo(x.x); acc[1] += w0[1] * bfhi(x.x); acc[2] += w0[2] * bflo(x.y); acc[3] += w0[3] * bfhi(x.y);
            acc[4] += w1[0] * bflo(x.z); acc[5] += w1[1] * bfhi(x.z); acc[6] += w1[2] * bflo(x.w); acc[7] += w1[3] * bfhi(x.w);
        }
    }
#pragma unroll
    for (int j = 0; j < 8; ++j) y[j] = fsilu(acc[j]);
}
constexpr int OB2_QL = 0, OB2_KL = 17408, OB2_AL = 34816, OB2_KGT = 52224, OB2_KBT = 70656, OB2_VBT = 89088, OB2_TL = 107520  , OB2_CW = 124928, OB2_GB = 132096  , OB2_LOG = 140288;
DI void phase_odd_a(const Params& p, LAS unsigned char* lds, int tid, int lane_, int wave, int G) {
    unsigned char* ws = p.ws;
    const bf16* PROJ = (const bf16*)(ws + WS_PROJ);
    bf16* UV = (bf16*)(ws + WS_UV); bf16* WK = (bf16*)(ws + WS_WK); bf16* QG = (bf16*)(ws + WS_QG); bf16* KGT = (bf16*)(ws + WS_KGT); bf16* PM = (bf16*)(ws + WS_PM); float* GL = (float*)(ws + WS_GL);
    const float* cw = (const float*)p.in[I_DCW];
    LAS bf16* Ql = (LAS bf16*)(lds + OB2_QL); LAS bf16* Kl = (LAS bf16*)(lds + OB2_KL); LAS float* Al = (LAS float*)(lds + OB2_AL);
    LAS bf16* KgTl = (LAS bf16*)(lds + OB2_KGT); LAS bf16* KbT = (LAS bf16*)(lds + OB2_KBT); LAS bf16* VbT = (LAS bf16*)(lds + OB2_VBT); LAS bf16* Tl = (LAS bf16*)(lds + OB2_TL);
    LAS float* Gw = (LAS float*)(lds + OB2_GB) + wave * 256;
    LAS bf16* Vl = (LAS bf16*)(lds + OB2_TL);
    LAS float* cwl = (LAS float*)(lds + OB2_CW); LAS unsigned* lograw = (LAS unsigned*)(lds + OB2_LOG);
    LAS bf16* raw = (LAS bf16*)(lds + OB2_QL);
    LAS bf16* TT = (LAS bf16*)(lds + OB2_LOG + 512);
    int curh = -1;
    const bf16* zeros = (const bf16*)(ws + WS_WINO) + (size_t)ODD_IN * DM;
    const float negA_all = 0.f; (void)negA_all;
    for (int unit = (int)blockIdx.x - G; unit < NB_P * 64 * DNH; unit += G) {
        int tidv = tid; asm volatile("" : "+v"(tidv));
        const int lane = tidv & 63, r = lane & 31, h2 = lane >> 5, tl = tidv >> 3, part = tidv & 7;
        const bool real = unit >= 0, more = unit + G < NB_P * 64 * DNH;
        const int h = unit & 7, c = (unit >> 3) & 63, b = unit >> 9;
        if (real) {
            const int t0 = c * 64, m0 = b * T_P + t0, m = m0 + tl;
            if (h != curh) { curh = h;
#pragma unroll
                for (int rep = 0; rep < 3; ++rep) { const int id = tidv + 512 * rep, tn = id >> 9, i = (id >> 7) & 3, d = id & 127; cwl[id] = cw[i * 3 * DNW + tn * DNW + h * DND + d]; }
                __syncthreads(); }
            { const float bl = bf2f((bf16)lograw[2 * lane]), al = bf2f((bf16)lograw[2 * lane + 1]);
              float x = -__expf(((const float*)p.in[I_DAL])[h]) * fsoftplus(al + ((const float*)p.in[I_DDT])[h]);
#pragma unroll
              for (int o = 1; o < 64; o <<= 1) { const float y = __shfl_up(x, o); if (lane >= o) x += y; }
              const float be = fsigmoid(bl), glast = __shfl(x, 63);
              Gw[lane] = x; Gw[64 + lane] = be; Gw[128 + lane] = be * __expf(x); Gw[192 + lane] = __expf(glast - x); }
            float qv[16], kv[16], vv[16];
            { float y[8];
              oa_conv8(raw, cwl, tl, 0, part * 16, y);
#pragma unroll
              for (int j = 0; j < 8; ++j) qv[j] = y[j];
              oa_conv8(raw, cwl, tl, 0, part * 16 + 8, y);
#pragma unroll
              for (int j = 0; j < 8; ++j) qv[8 + j] = y[j];
              oa_conv8(raw, cwl, tl, 1, part * 16, y);
#pragma unroll
              for (int j = 0; j < 8; ++j) kv[j] = y[j];
              oa_conv8(raw, cwl, tl, 1, part * 16 + 8, y);
#pragma unroll
              for (int j = 0; j < 8; ++j) kv[8 + j] = y[j];
              oa_conv8(raw, cwl, tl, 2, part * 16, y);
#pragma unroll
              for (int j = 0; j < 8; ++j) vv[j] = y[j];
              oa_conv8(raw, cwl, tl, 2, part * 16 + 8, y);
#pragma unroll
              for (int j = 0; j < 8; ++j) vv[8 + j] = y[j]; }
            float sq = 0.f, sk = 0.f;
#pragma unroll
            for (int j = 0; j < 16; ++j) { sq += qv[j] * qv[j]; sk += kv[j] * kv[j]; }
#pragma unroll
            for (int o = 1; o < 8; o <<= 1) { sq += __shfl_xor(sq, o); sk += __shfl_xor(sk, o); }
            const float rq = frsq(sq + EPS) * 0.08838834764831845f, rk = frsq(sk + EPS);
#pragma unroll
            for (int j = 0; j < 16; ++j) { qv[j] *= rq; kv[j] *= rk; }
            if (c == 63 && tl >= 61) {
                float* o = p.out + O_DCP + (size_t)(b * 3 + (tl - 61)) * 3 * DNW;
#pragma unroll
                for (int tn = 0; tn < 3; ++tn)
#pragma unroll
                    for (int j = 0; j < 16; ++j) { const int chan = tn * DNW + h * DND + part * 16 + j; o[chan] = bf2f(PROJ[(size_t)m * ODD_PAD + chan]); }
            }
            const float Gt = Gw[tl], Glast = Gw[63], bt = Gw[64 + tl];
            __syncthreads();
            { u32x4 w0, w1;
#pragma unroll
              for (int j = 0; j < 4; ++j) { w0[j] = pk2(qv[2 * j], qv[2 * j + 1]); w1[j] = pk2(qv[8 + 2 * j], qv[8 + 2 * j + 1]); }
              *(LAS u32x4*)(Ql + tl * QLD + part * 16) = w0; *(LAS u32x4*)(Ql + tl * QLD + part * 16 + 8) = w1;
#pragma unroll
              for (int j = 0; j < 4; ++j) { w0[j] = pk2(kv[2 * j], kv[2 * j + 1]); w1[j] = pk2(kv[8 + 2 * j], kv[8 + 2 * j + 1]); }
              *(LAS u32x4*)(Kl + tl * QLD + part * 16) = w0; *(LAS u32x4*)(Kl + tl * QLD + part * 16 + 8) = w1;
#pragma unroll
              for (int j = 0; j < 4; ++j) { w0[j] = pk2(vv[2 * j], vv[2 * j + 1]); w1[j] = pk2(vv[8 + 2 * j], vv[8 + 2 * j + 1]); }
              *(LAS u32x4*)(Vl + tl * QLD + part * 16) = w0; *(LAS u32x4*)(Vl + tl * QLD + part * 16 + 8) = w1; }
            { const float eg = __expf(Gt);
              u32x4 w0, w1;
              w0[0] = pk2(qv[0] * eg, qv[1] * eg); w0[1] = pk2(qv[2] * eg, qv[3] * eg); w0[2] = pk2(qv[8] * eg, qv[9] * eg); w0[3] = pk2(qv[10] * eg, qv[11] * eg);
              w1[0] = pk2(qv[4] * eg, qv[5] * eg); w1[1] = pk2(qv[6] * eg, qv[7] * eg); w1[2] = pk2(qv[12] * eg, qv[13] * eg); w1[3] = pk2(qv[14] * eg, qv[15] * eg);
              bf16* qg = QG + (size_t)unit * 8192 + tl * DND + part * 16; *(u32x4*)qg = w0; *(u32x4*)(qg + 8) = w1; }
            if (tidv == 0) GL[unit] = __expf(Glast);
            __syncthreads();
            { const int d = tidv & 127, q16 = tidv >> 7;
              float kq[16], vq[16];
#pragma unroll
              for (int i = 0; i < 16; ++i) { kq[i] = bf2f(Kl[(16 * q16 + i) * QLD + d]); vq[i] = bf2f(Vl[(16 * q16 + i) * QLD + d]); }
              float skk[16], sbt[16], sek[16];
#pragma unroll
              for (int i4 = 0; i4 < 4; ++i4) { const f32x4 a = *(const LAS f32x4*)(Gw + 128 + 16 * q16 + 4 * i4), bq = *(const LAS f32x4*)(Gw + 64 + 16 * q16 + 4 * i4), e4 = *(const LAS f32x4*)(Gw + 192 + 16 * q16 + 4 * i4);
#pragma unroll
                  for (int j = 0; j < 4; ++j) { skk[4 * i4 + j] = a[j]; sbt[4 * i4 + j] = bq[j]; sek[4 * i4 + j] = e4[j]; } }
              u32x4 w0, w1;
#pragma unroll
              for (int j = 0; j < 4; ++j) { w0[j] = pk2(kq[2 * j] * skk[2 * j], kq[2 * j + 1] * skk[2 * j + 1]); w1[j] = pk2(kq[8 + 2 * j] * skk[8 + 2 * j], kq[9 + 2 * j] * skk[9 + 2 * j]); }
              *(LAS u32x4*)(KbT + d * TLD + 16 * q16) = w0; *(LAS u32x4*)(KbT + d * TLD + 16 * q16 + 8) = w1;
#pragma unroll
              for (int j = 0; j < 4; ++j) { w0[j] = pk2(vq[2 * j] * sbt[2 * j], vq[2 * j + 1] * sbt[2 * j + 1]); w1[j] = pk2(vq[8 + 2 * j] * sbt[8 + 2 * j], vq[9 + 2 * j] * sbt[9 + 2 * j]); }
              *(LAS u32x4*)(VbT + d * TLD + 16 * q16) = w0; *(LAS u32x4*)(VbT + d * TLD + 16 * q16 + 8) = w1;
              w0[0] = pk2(kq[0] * sek[0], kq[1] * sek[1]); w0[1] = pk2(kq[2] * sek[2], kq[3] * sek[3]); w0[2] = pk2(kq[8] * sek[8], kq[9] * sek[9]); w0[3] = pk2(kq[10] * sek[10], kq[11] * sek[11]);
              w1[0] = pk2(kq[4] * sek[4], kq[5] * sek[5]); w1[1] = pk2(kq[6] * sek[6], kq[7] * sek[7]); w1[2] = pk2(kq[12] * sek[12], kq[13] * sek[13]); w1[3] = pk2(kq[14] * sek[14], kq[15] * sek[15]);
              *(LAS u32x4*)(KgTl + d * TLD + 16 * q16) = w0; *(LAS u32x4*)(KgTl + d * TLD + 16 * q16 + 8) = w1; }
            { const int ti = (wave >> 1) & 1, tj = wave & 1; const bool isP = wave >= 4;
              const LAS bf16* Asrc = isP ? Ql : Kl;
              f32x16 acc;
#pragma unroll
              for (int i = 0; i < 16; ++i) acc[i] = 0.f;
#pragma unroll
              for (int s = 0; s < 8; ++s) { const bf16x8 a = *(const LAS bf16x8*)(Asrc + (32 * ti + r) * QLD + 16 * s + 8 * h2), bb = *(const LAS bf16x8*)(Kl + (32 * tj + r) * QLD + 16 * s + 8 * h2); acc = MFMA32(a, bb, acc); }
              const int j = 32 * tj + r; const float Gj = Gw[j];
#pragma unroll
              for (int i = 0; i < 16; ++i) { const int row = 32 * ti + (i & 3) + 8 * (i >> 2) + 4 * h2; const float Gi = Gw[row];
                  if (isP) { const float v = row >= j ? acc[i] * __expf(Gi - Gj) : 0.f; PM[(size_t)unit * 4096 + row * 64 + perm16c(j)] = f2bf(v); }
                  else { const float v = row > j ? acc[i] * __expf(Gi - Gj) * Gw[64 + row] : 0.f; Al[row * ALD + j] = v; } } }
            __syncthreads();
            if (wave < 2) {
                const int j = lane & 31, kh = lane >> 5, o = 32 * wave;
                f32x2 R[8];
#pragma unroll
                for (int m = 0; m < 8; ++m) R[m] = (f32x2){0.f, 0.f};
                const LAS float* abase = Al + o * ALD + o + 2 * kh;
#pragma unroll
                for (int i = 0; i < 32; ++i) {
                    f32x2 acc = {0.f, 0.f};
#pragma unroll
                    for (int m = 0; m < (i + 3) / 4; ++m) acc = __builtin_elementwise_fma(*(const LAS f32x2*)(abase + i * ALD + 4 * m), R[m], acc);
                    const float part = acc.x + acc.y;
                    const auto sw = __builtin_amdgcn_permlane32_swap(__float_as_uint(part), __float_as_uint(part), false, false);
                    const float t = ((j == i) ? 1.f : 0.f) - (__uint_as_float(sw[0]) + __uint_as_float(sw[1]));
                    if (kh == ((i >> 1) & 1)) { if (i & 1) R[i >> 2].y = t; else R[i >> 2].x = t; }
                    if (kh == 0) Tl[(o + i) * TLD + o + j] = f2bf(t);
                }
                if (wave == 0) {
#pragma unroll
                    for (int m = 0; m < 8; ++m) *(LAS unsigned*)(TT + j * 40 + 4 * m + 2 * kh) = pk2(R[m].x, R[m].y); }
            } else if (wave == 2) {
                const u32x4 z = {0u, 0u, 0u, 0u};
                *(LAS u32x4*)(Tl + (lane >> 1) * TLD + 32 + (lane & 1) * 16) = z; *(LAS u32x4*)(Tl + (lane >> 1) * TLD + 32 + (lane & 1) * 16 + 8) = z;
            } else {
#pragma unroll
                for (int rep = 0; rep < 4; ++rep) { const int id = (tidv - 192) + 320 * rep;
                    if (id < 1024) { const int row = id >> 3, chk = id & 7; *(u32x4*)(KGT + (size_t)unit * 8192 + row * 64 + chk * 8) = *(const LAS u32x4*)(KgTl + row * TLD + chk * 8); } }
            }
            __syncthreads();
            if (wave == 0) {
                f32x16 X;
#pragma unroll
                for (int i = 0; i < 16; ++i) X[i] = 0.f;
#pragma unroll
                for (int s2 = 0; s2 < 2; ++s2) { const LAS float* ap = Al + (32 + r) * ALD + 16 * s2 + 8 * h2; const f32x4 a0 = *(const LAS f32x4*)ap, a1 = *(const LAS f32x4*)(ap + 4);
                    u32x4 aw; aw[0] = pk2(a0[0], a0[1]); aw[1] = pk2(a0[2], a0[3]); aw[2] = pk2(a1[0], a1[1]); aw[3] = pk2(a1[2], a1[3]);
                    const bf16x8 bfr = *(const LAS bf16x8*)(TT + r * 40 + 16 * s2 + 8 * h2);
                    X = MFMA32(__builtin_bit_cast(bf16x8, aw), bfr, X); }
                f32x16 Y;
#pragma unroll
                for (int i = 0; i < 16; ++i) Y[i] = 0.f;
#pragma unroll
                for (int s2 = 0; s2 < 2; ++s2) { u32x4 xw;
#pragma unroll
                    for (int q = 0; q < 4; ++q) xw[q] = pk2(X[8 * s2 + 2 * q], X[8 * s2 + 2 * q + 1]);
                    const LAS bf16* tp = Tl + (32 + r) * TLD + 32 + 16 * s2 + 4 * h2; const u32x2 lo = *(const LAS u32x2*)tp, hi = *(const LAS u32x2*)(tp + 8);
                    Y = MFMA32(__builtin_bit_cast(bf16x8, (u32x4){lo.x, lo.y, hi.x, hi.y}), __builtin_bit_cast(bf16x8, xw), Y); }
#pragma unroll
                for (int i = 0; i < 16; ++i) Tl[(32 + (i & 3) + 8 * (i >> 2) + 4 * h2) * TLD + r] = f2bf(-Y[i]);
            }
            __syncthreads();
        }
        if (more) {
            oa_dma(PROJ, zeros, lds + OB2_QL, unit + G, tidv, wave);
            if (part == 0) { const int un = unit + G; const bf16* pr = PROJ + (size_t)((un >> 9) * T_P + ((un >> 3) & 63) * 64 + tl) * ODD_PAD + 4 * DNW + (un & 7); lograw[2 * tl] = pr[0]; lograw[2 * tl + 1] = pr[DNH]; } }
        if (real) {
#pragma unroll
            for (int rep = 0; rep < 2; ++rep) {
                const int id = wave + 8 * rep, which = id >> 3, ti = (id >> 2) & 1, tj = id & 3;
                const LAS bf16* Bsrc = which ? KbT : VbT;
                f32x16 acc;
#pragma unroll
                for (int i = 0; i < 16; ++i) acc[i] = 0.f;
#pragma unroll
                for (int s = 0; s < 4; ++s) { const bf16x8 a = *(const LAS bf16x8*)(Tl + (32 * ti + r) * TLD + 16 * s + 8 * h2), bb = *(const LAS bf16x8*)(Bsrc + (32 * tj + r) * TLD + 16 * s + 8 * h2); acc = MFMA32(a, bb, acc); }
                if (which) { bf16* dst = WK + (size_t)unit * 8192; const int colp = perm16c(32 * tj + r);
#pragma unroll
                    for (int i = 0; i < 16; ++i) { const int row = 32 * ti + (i & 3) + 8 * (i >> 2) + 4 * h2; dst[row * DND + colp] = f2bf(acc[i]); } }
                else { u32x4 w0, w1;
#pragma unroll
                    for (int j = 0; j < 4; ++j) { w0[j] = pk2(acc[2 * j], acc[2 * j + 1]); w1[j] = pk2(acc[8 + 2 * j], acc[8 + 2 * j + 1]); }
                    bf16* dst = UV + (size_t)unit * 8192 + (size_t)(((tj * 2 + ti) * 64) + lane) * 16; *(u32x4*)dst = w0; *(u32x4*)(dst + 8) = w1; }
            }
        }
        asm volatile("s_waitcnt vmcnt(0)" ::: "memory");
        __syncthreads();
    }
}
constexpr int OB_WK = 0, OB_QG = 17408, OB_KGT = 34816, OB_PM = 53248, OB_BUF = 62464;
DI bf16x8 pack8(const f32x16& x, int s) {
    u32x4 w;
#pragma unroll
    for (int j = 0; j < 4; ++j) w[j] = pk2(x[8 * s + 2 * j], x[8 * s + 2 * j + 1]);
    return __builtin_bit_cast(bf16x8, w);
}
#define CH_BARRIER() do { asm volatile("s_waitcnt lgkmcnt(0)" ::: "memory"); __builtin_amdgcn_s_barrier(); asm volatile("" ::: "memory"); } while (0)
struct ChainRegs { u32x4 wk[4], qg[4], kg[4], pm[2]; };
DI void chain_load(ChainRegs& R, const bf16* WK, const bf16* QG, const bf16* KGT, const bf16* PM, size_t u, int lt) {
#pragma unroll
    for (int rep = 0; rep < 4; ++rep) { const int id = lt + 256 * rep;
        R.wk[rep] = *(const u32x4*)(WK + u * 8192 + id * 8); R.qg[rep] = *(const u32x4*)(QG + u * 8192 + id * 8); R.kg[rep] = *(const u32x4*)(KGT + u * 8192 + id * 8); }
#pragma unroll
    for (int rep = 0; rep < 2; ++rep) R.pm[rep] = *(const u32x4*)(PM + u * 4096 + (lt + 256 * rep) * 8);
}
DI void chain_store(const ChainRegs& R, LAS unsigned char* buf, int lt) {
#pragma unroll
    for (int rep = 0; rep < 4; ++rep) { const int id = lt + 256 * rep;
        *(LAS u32x4*)(buf + OB_WK + ((id >> 4) * QLD + (id & 15) * 8) * 2) = R.wk[rep]; *(LAS u32x4*)(buf + OB_QG + ((id >> 4) * QLD + (id & 15) * 8) * 2) = R.qg[rep];
        *(LAS u32x4*)(buf + OB_KGT + ((id >> 3) * TLD + (id & 7) * 8) * 2) = R.kg[rep]; }
#pragma unroll
    for (int rep = 0; rep < 2; ++rep) { const int id = lt + 256 * rep; *(LAS u32x4*)(buf + OB_PM + ((id >> 3) * TLD + (id & 7) * 8) * 2) = R.pm[rep]; }
}
DI void chain_step(f32x16 (&Sacc)[4], u32x4 (&uv)[4], const LAS unsigned char* buf, float gl, const bf16* uv_next, bf16* oraw, int r, int h2) {
    const LAS bf16* WKl = (const LAS bf16*)(buf + OB_WK) + r * QLD + 8 * h2; const LAS bf16* QGl = (const LAS bf16*)(buf + OB_QG) + r * QLD + 8 * h2;
    const LAS bf16* KGTl = (const LAS bf16*)(buf + OB_KGT) + r * TLD + 8 * h2; const LAS bf16* PMl = (const LAS bf16*)(buf + OB_PM) + r * TLD + 8 * h2;
#define FR(base, ld, rowblk, kk) (*(const LAS bf16x8*)((base) + (32 * (rowblk)) * (ld) + 16 * (kk)))
    f32x16 U[2], accO[2];
#pragma unroll
    for (int ti = 0; ti < 2; ++ti)
#pragma unroll
        for (int i = 0; i < 16; ++i) { U[ti][i] = 0.f; accO[ti][i] = 0.f; }
    bf16x8 fw[2][2], fq[2][2];
    fw[0][0] = FR(WKl, QLD, 0, 0); fw[0][1] = FR(WKl, QLD, 1, 0); fq[0][0] = FR(QGl, QLD, 0, 0); fq[0][1] = FR(QGl, QLD, 1, 0);
#pragma unroll
    for (int kk = 0; kk < 8; ++kk) { const int cb = kk & 1, nb = cb ^ 1;
        if (kk < 7) { fw[nb][0] = FR(WKl, QLD, 0, kk + 1); fw[nb][1] = FR(WKl, QLD, 1, kk + 1); fq[nb][0] = FR(QGl, QLD, 0, kk + 1); fq[nb][1] = FR(QGl, QLD, 1, kk + 1); }
        const bf16x8 sf = pack8(Sacc[kk >> 1], kk & 1);
        __builtin_amdgcn_sched_barrier(0);
        U[0] = MFMA32(fw[cb][0], sf, U[0]); U[1] = MFMA32(fw[cb][1], sf, U[1]); accO[0] = MFMA32(fq[cb][0], sf, accO[0]); accO[1] = MFMA32(fq[cb][1], sf, accO[1]);
        __builtin_amdgcn_sched_barrier(0); }
    bf16x8 fk[2][4];
#pragma unroll
    for (int d = 0; d < 2; ++d)
#pragma unroll
        for (int k2 = 0; k2 < 4; ++k2) fk[d][k2] = FR(KGTl, TLD, d, k2);
    __builtin_amdgcn_sched_barrier(0);
#pragma unroll
    for (int ti = 0; ti < 2; ++ti)
#pragma unroll
        for (int j = 0; j < 8; ++j) { const unsigned w = uv[2 * ti + (j >> 2)][j & 3]; U[ti][2 * j] = bflo(w) - U[ti][2 * j]; U[ti][2 * j + 1] = bfhi(w) - U[ti][2 * j + 1]; }
    if (uv_next) {
#pragma unroll
        for (int q = 0; q < 4; ++q) uv[q] = *(const u32x4*)(uv_next + (size_t)((q >> 1) * 64) * 16 + (q & 1) * 8); }
    bf16x8 Uf[4];
#pragma unroll
    for (int k2 = 0; k2 < 4; ++k2) Uf[k2] = pack8(U[k2 >> 1], k2 & 1);
    bf16x8 fp[4];
#pragma unroll
    for (int k2 = 0; k2 < 4; ++k2) fp[k2] = FR(PMl, TLD, 0, k2);
    __builtin_amdgcn_sched_barrier(0);
#pragma unroll
    for (int d = 0; d < 2; ++d) {
#pragma unroll
        for (int i = 0; i < 16; ++i) Sacc[d][i] *= gl;
#pragma unroll
        for (int k2 = 0; k2 < 4; ++k2) Sacc[d] = MFMA32(fk[d][k2], Uf[k2], Sacc[d]); }
#pragma unroll
    for (int d = 0; d < 2; ++d)
#pragma unroll
        for (int k2 = 0; k2 < 4; ++k2) fk[d][k2] = FR(KGTl, TLD, 2 + d, k2);
    __builtin_amdgcn_sched_barrier(0);
#pragma unroll
    for (int k2 = 0; k2 < 4; ++k2) accO[0] = MFMA32(fp[k2], Uf[k2], accO[0]);
#pragma unroll
    for (int k2 = 0; k2 < 4; ++k2) fp[k2] = FR(PMl, TLD, 1, k2);
    __builtin_amdgcn_sched_barrier(0);
#pragma unroll
    for (int d = 0; d < 2; ++d) {
#pragma unroll
        for (int i = 0; i < 16; ++i) Sacc[2 + d][i] *= gl;
#pragma unroll
        for (int k2 = 0; k2 < 4; ++k2) Sacc[2 + d] = MFMA32(fk[d][k2], Uf[k2], Sacc[2 + d]); }
#pragma unroll
    for (int k2 = 0; k2 < 4; ++k2) accO[1] = MFMA32(fp[k2], Uf[k2], accO[1]);
#pragma unroll
    for (int ti = 0; ti < 2; ++ti) { u32x4 w0, w1;
#pragma unroll
        for (int j = 0; j < 4; ++j) { w0[j] = pk2(accO[ti][2 * j], accO[ti][2 * j + 1]); w1[j] = pk2(accO[ti][8 + 2 * j], accO[ti][8 + 2 * j + 1]); }
        *(u32x4*)(oraw + (size_t)(ti * 64) * 16) = w0; *(u32x4*)(oraw + (size_t)(ti * 64) * 16 + 8) = w1; }
#undef FR
}
DI void dn_chain_unit(const Params& p, LAS unsigned char* lds, int tid_, int wave, int b, int h, int half) {
    unsigned char* ws = p.ws;
    const bf16* UV = (const bf16*)(ws + WS_UV); const bf16* WK = (const bf16*)(ws + WS_WK); const bf16* QG = (const bf16*)(ws + WS_QG); const bf16* KGT = (const bf16*)(ws + WS_KGT); const bf16* PM = (const bf16*)(ws + WS_PM);
    const float* GL = (const float*)(ws + WS_GL); bf16* OR = (bf16*)(ws + WS_OR);
    int tid = tid_; asm volatile("" : "+v"(tid));
    const size_t ub = (size_t)(b * 64) * 8 + h;
    if (wave >= 4) {
        const int lt = tid - 256;
        ChainRegs R0, R1, R2;
#define CH_CHUNK(i) (ub + 8 * ((i) < 64 ? (i) : 63))
#define CH_LSTEP(n_, RL, RS) do { chain_load(RL, WK, QG, KGT, PM, CH_CHUNK((n_) + 3), lt); chain_store(RS, lds + (((n_) + 1) & 1) * OB_BUF, lt); CH_BARRIER(); } while (0)
        chain_load(R0, WK, QG, KGT, PM, CH_CHUNK(0), lt); chain_load(R1, WK, QG, KGT, PM, CH_CHUNK(1), lt); chain_load(R2, WK, QG, KGT, PM, CH_CHUNK(2), lt);
        chain_store(R0, lds, lt);
        CH_BARRIER();
#pragma unroll 1
        for (int n = 0; n < 63; n += 3) { CH_LSTEP(n, R0, R1); CH_LSTEP(n + 1, R1, R2); CH_LSTEP(n + 2, R2, R0); }
        CH_LSTEP(63, R0, R1);
#undef CH_LSTEP
#undef CH_CHUNK
    } else if (wave >= 2) {
        for (int n = 0; n < 65; ++n) CH_BARRIER();
    } else {
        const int lane = tid & 63, r = lane & 31, h2 = lane >> 5, w = 2 * half + wave;
        f32x16 Sacc[4];
#pragma unroll
        for (int d = 0; d < 4; ++d)
#pragma unroll
            for (int i = 0; i < 16; ++i) Sacc[d][i] = 0.f;
        const size_t lofs = (size_t)((w * 2) * 64 + lane) * 16;
        u32x4 uv[4];
#pragma unroll
        for (int q = 0; q < 4; ++q) uv[q] = *(const u32x4*)(UV + ub * 8192 + lofs + (size_t)((q >> 1) * 64) * 16 + (q & 1) * 8);
        float gl = GL[ub];
        CH_BARRIER();
#pragma unroll 1
        for (int n = 0; n < 64; n += 2) {
            const float gl1 = GL[ub + 8 * (n + 1)];
            chain_step(Sacc, uv, lds, gl, UV + (ub + 8 * (n + 1)) * 8192 + lofs, OR + (ub + 8 * n) * 8192 + lofs, r, h2);
            CH_BARRIER();
            gl = (n + 2 < 64) ? GL[ub + 8 * (n + 2)] : 0.f;
            chain_step(Sacc, uv, lds + OB_BUF, gl1, (n + 2 < 64) ? UV + (ub + 8 * (n + 2)) * 8192 + lofs : (const bf16*)nullptr, OR + (ub + 8 * (n + 1)) * 8192 + lofs, r, h2);
            CH_BARRIER();
        }
        float* so = p.out + O_DSP + (size_t)((b * DNH + h) * DND) * DND;
#pragma unroll
        for (int d = 0; d < 4; ++d)
#pragma unroll
            for (int i = 0; i < 16; ++i) so[(size_t)(32 * d + (i & 3) + 8 * (i >> 2) + 4 * h2) * DND + 32 * w + r] = Sacc[d][i];
    }
    __syncthreads();
}
DI void dn_sample_unit(const Params& p, LAS unsigned char* lds, int tid_, int wave, int s, int h) {
    unsigned char* ws = p.ws;
    const bf16* PROJ = (const bf16*)(ws + WS_PROJ); bf16* AO = (bf16*)(ws + WS_AO);
    LAS float* qkvl = (LAS float*)lds;
    LAS float* red = (LAS float*)(lds + 6144);
    LAS float* red2 = (LAS float*)(lds + 8192);
    LAS float* ol = (LAS float*)(lds + 10240);
    int tid = tid_; asm volatile("" : "+v"(tid));
    const int lane = tid & 63;
    const float* cw = (const float*)p.in[I_DCW];
    if (tid < 384) {
        const int chan = (tid >> 7) * DNW + h * DND + (tid & 127);
        float xp[7];
#pragma unroll
        for (int i = 0; i < 3; ++i) xp[i] = ((const float*)p.in[I_SDC])[(size_t)(s * 3 + i) * 3 * DNW + chan];
#pragma unroll
        for (int t = 0; t < 4; ++t) xp[3 + t] = bf2f(PROJ[(size_t)(MP + 4 * s + t) * ODD_PAD + chan]);
        const float w0 = cw[chan], w1 = cw[3 * DNW + chan], w2 = cw[2 * 3 * DNW + chan], w3 = cw[3 * 3 * DNW + chan];
#pragma unroll
        for (int t = 0; t < 4; ++t) qkvl[t * 384 + tid] = fsilu(w0 * xp[t] + w1 * xp[t + 1] + w2 * xp[t + 2] + w3 * xp[t + 3]);
#pragma unroll
        for (int i = 0; i < 3; ++i) (p.out + O_DCS)[(size_t)(s * 3 + i) * 3 * DNW + chan] = xp[4 + i];
    }
    __syncthreads();
    { const int t = wave >> 1, tn = wave & 1; LAS float* v = qkvl + t * 384 + tn * 128;
      const float a = v[lane], bq = v[lane + 64]; const float sc = frsq(wave_sum(a * a + bq * bq) + EPS) * (tn == 0 ? 0.08838834764831845f : 1.0f);
      v[lane] = a * sc; v[lane + 64] = bq * sc; }
    __syncthreads();
    const int e = tid & 127, qd = tid >> 7;
    float S[32];
    const float* s0 = (const float*)p.in[I_SDS] + ((size_t)(s * DNH + h) * DND + 32 * qd) * DND + e;
#pragma unroll
    for (int j = 0; j < 32; ++j) S[j] = s0[(size_t)j * DND];
    const float negA = -__expf(((const float*)p.in[I_DAL])[h]), dtb = ((const float*)p.in[I_DDT])[h];
#pragma unroll 1
    for (int t = 0; t < 4; ++t) {
        const size_t m = MP + 4 * s + t;
        const float beta = fsigmoid(bf2f(PROJ[m * ODD_PAD + 4 * DNW + h])), dec = __expf(negA * fsoftplus(bf2f(PROJ[m * ODD_PAD + 4 * DNW + DNH + h]) + dtb));
        const LAS float* qt = qkvl + t * 384 + 32 * qd; const LAS float* kt = qt + 128;
        float part = 0.f;
#pragma unroll
        for (int j = 0; j < 32; ++j) { S[j] *= dec; part += kt[j] * S[j]; }
        red[qd * 128 + e] = part;
        __syncthreads();
        const float kS = (red[e] + red[128 + e]) + (red[256 + e] + red[384 + e]);
        const float u = beta * (qkvl[t * 384 + 256 + e] - kS);
        float part2 = 0.f;
#pragma unroll
        for (int j = 0; j < 32; ++j) { S[j] += kt[j] * u; part2 += qt[j] * S[j]; }
        red2[qd * 128 + e] = part2;
        __syncthreads();
        if (qd == 0) ol[t * 128 + e] = (red2[e] + red2[128 + e]) + (red2[256 + e] + red2[384 + e]);
    }
    __syncthreads();
    if (wave < 4) { const int t = wave; const float a = ol[t * 128 + lane], bq = ol[t * 128 + lane + 64];
        const float rn = frsq(wave_sum(a * a + bq * bq) * (1.f / DND) + EPS);
        const size_t m = MP + 4 * s + t; const float* og = (const float*)p.in[I_DOG];
        const float z0 = bf2f(PROJ[m * ODD_PAD + 3 * DNW + h * DND + lane]), z1 = bf2f(PROJ[m * ODD_PAD + 3 * DNW + h * DND + lane + 64]);
        AO[m * DM + h * DND + lane] = f2bf(a * rn * og[lane] * fsilu(z0)); AO[m * DM + h * DND + lane + 64] = f2bf(bq * rn * og[lane + 64] * fsilu(z1)); }
    float* so = p.out + O_DSS + ((size_t)(s * DNH + h) * DND + 32 * qd) * DND + e;
#pragma unroll
    for (int j = 0; j < 32; ++j) so[(size_t)j * DND] = S[j];
    __syncthreads();
}
DI void phase_odd_b(const Params& p, LAS unsigned char* lds, int tid, int lane, int wave, int G, int qsel = 1) {
    unsigned* head = (unsigned*)(p.ws + WS_CTL) + CW_QUEUE + 64 * qsel;
    volatile LAS unsigned* slot = (volatile LAS unsigned*)(lds + LDSCTL_OFF + 128);
    constexpr unsigned N_CH = 2 * NB_P * DNH, N_SMP = NB_S * DNH, N_ALL = N_CH + N_SMP;
    for (;;) {
        unsigned u = queue_next(head, slot, tid);
        if (u >= N_ALL) break;
        const int mode = p.mode;
        if (u < N_CH) { if (mode != 2) dn_chain_unit(p, lds, tid, wave, (int)(u >> 4), (int)((u >> 1) & 7), (int)(u & 1)); continue; }
        u -= N_CH;
        if (mode != 1) dn_sample_unit(p, lds, tid, wave, (int)(u >> 3), (int)(u & 7));
    }
    { unsigned* headC = head + 32; LAS float* scr = (LAS float*)(lds + wave * 16384);
      for (;;) { const unsigned bt = queue_next(headC, slot, tid); if (bt * 8 >= (unsigned)DEF_N) break;
          const int v = (int)bt * 8 + wave; if (v < DEF_N) convert_item(p, scr, defer_item(v), lane & 63); } }
}

DI void phase_odd_c(const Params& p, LAS unsigned char* lds, int tid_, int wave, int G) {
    unsigned char* ws = p.ws;
    const bf16* PROJ = (const bf16*)(ws + WS_PROJ); const bf16* OR = (const bf16*)(ws + WS_OR); bf16* AO = (bf16*)(ws + WS_AO);
    LAS bf16* Ot = (LAS bf16*)lds;
    int tid = tid_; asm volatile("" : "+v"(tid));
    const int tl = tid >> 3, part = tid & 7;
    const float* og = (const float*)p.in[I_DOG] + part * 16;
    const f32x4 g0 = *(const f32x4*)og, g1 = *(const f32x4*)(og + 4), g2 = *(const f32x4*)(og + 8), g3 = *(const f32x4*)(og + 12);
    const float gg[16] = {g0[0], g0[1], g0[2], g0[3], g1[0], g1[1], g1[2], g1[3], g2[0], g2[1], g2[2], g2[3], g3[0], g3[1], g3[2], g3[3]};
    constexpr int NU = NB_P * 64 * DNH;
    u32x4 orn[2], zn[2];
    { const int u0 = (int)blockIdx.x < NU ? (int)blockIdx.x : 0; const int h = u0 & 7, c = (u0 >> 3) & 63, b = u0 >> 9; const size_t m = (size_t)(b * T_P + c * 64 + tl);
#pragma unroll
      for (int rep = 0; rep < 2; ++rep) orn[rep] = *(const u32x4*)(OR + (size_t)u0 * 8192 + (size_t)(tid + 512 * rep) * 8);
      zn[0] = *(const u32x4*)(PROJ + m * ODD_PAD + 3 * DNW + h * DND + part * 16); zn[1] = *(const u32x4*)(PROJ + m * ODD_PAD + 3 * DNW + h * DND + part * 16 + 8); }
    for (int unit = blockIdx.x; unit < NU; unit += G) {
        const int h = unit & 7, c = (unit >> 3) & 63, b = unit >> 9, m0 = b * T_P + c * 64;
        const u32x4 z0 = zn[0], z1 = zn[1];
#pragma unroll
        for (int rep = 0; rep < 2; ++rep) { const int q = tid + 512 * rep;
            const int half = q & 1, lane = (q >> 1) & 63, ti = (q >> 7) & 1, w = q >> 8, r = lane & 31, h2 = lane >> 5;
            const u32x4 v = orn[rep];
#pragma unroll
            for (int j = 0; j < 8; ++j) { const int i = 8 * half + j, tok = 32 * ti + (i & 3) + 8 * (i >> 2) + 4 * h2;
                Ot[tok * QLD + 32 * w + r] = (bf16)((j & 1) ? (v[j >> 1] >> 16) : (v[j >> 1] & 0xffffu)); } }
        { const int un = unit + G < NU ? unit + G : unit; const int hn = un & 7, cn = (un >> 3) & 63, bn = un >> 9; const size_t mn = (size_t)(bn * T_P + cn * 64 + tl);
#pragma unroll
          for (int rep = 0; rep < 2; ++rep) orn[rep] = *(const u32x4*)(OR + (size_t)un * 8192 + (size_t)(tid + 512 * rep) * 8);
          zn[0] = *(const u32x4*)(PROJ + mn * ODD_PAD + 3 * DNW + hn * DND + part * 16); zn[1] = *(const u32x4*)(PROJ + mn * ODD_PAD + 3 * DNW + hn * DND + part * 16 + 8); }
        const size_t m = m0 + tl;
        __syncthreads();
        const u32x4 o0 = *(const LAS u32x4*)(Ot + tl * QLD + part * 16), o1 = *(const LAS u32x4*)(Ot + tl * QLD + part * 16 + 8);
        float o[16], z[16];
#pragma unroll
        for (int j = 0; j < 4; ++j) { o[2 * j] = bflo(o0[j]); o[2 * j + 1] = bfhi(o0[j]); o[8 + 2 * j] = bflo(o1[j]); o[8 + 2 * j + 1] = bfhi(o1[j]);
            z[2 * j] = bflo(z0[j]); z[2 * j + 1] = bfhi(z0[j]); z[8 + 2 * j] = bflo(z1[j]); z[8 + 2 * j + 1] = bfhi(z1[j]); }
        float ss = 0.f;
#pragma unroll
        for (int j = 0; j < 16; ++j) ss += o[j] * o[j];
#pragma unroll
        for (int of = 1; of < 8; of <<= 1) ss += __shfl_xor(ss, of);
        const float rn = frsq(ss * (1.f / DND) + EPS);
        u32x4 w0, w1;
#pragma unroll
        for (int j = 0; j < 4; ++j) { w0[j] = pk2(o[2 * j] * rn * gg[2 * j] * fsilu(z[2 * j]), o[2 * j + 1] * rn * gg[2 * j + 1] * fsilu(z[2 * j + 1]));
            w1[j] = pk2(o[8 + 2 * j] * rn * gg[8 + 2 * j] * fsilu(z[8 + 2 * j]), o[8 + 2 * j + 1] * rn * gg[8 + 2 * j + 1] * fsilu(z[8 + 2 * j + 1])); }
        bf16* dst = AO + m * DM + h * DND + part * 16; *(u32x4*)dst = w0; *(u32x4*)(dst + 8) = w1;
        __syncthreads();
    }
}
DI void small_swiglu(LAS unsigned char* lds, const bf16* XB, const bf16* Wt, bf16* HB, const float* ssq, int tid, int wave, int G) {
    for (int su = G - 1 - (int)blockIdx.x; su < 4 * (DFF / 32); su += G) { const int rt = su & 3, j = su >> 2, n0 = ((32 * j) >> 7) * 256 + ((32 * j) & 127);
        gemm_small_unit<128>(lds, XB, Wt, DM, MP + 128 * rt, n0, n0 + 128, SEpiSwiglu{HB, 32 * j, ssq}, tid, wave); }
}
template <bool BASE_F32, bool OUT_F32> DI void small_res(LAS unsigned char* lds, const bf16* A, const bf16* Wt, int K, const void* base, void* out, float alpha, float* ssq, int tid, int wave, int G) {
    for (int su = G - 1 - (int)blockIdx.x; su < 8 * (DM / 64); su += G) { const int rt = su & 7, j = su >> 3;
        gemm_small_unit<64>(lds, A, Wt, K, MP + 64 * rt, 64 * j, 64 * j + 32, SEpiResT<BASE_F32, OUT_F32>{base, out, ssq, alpha}, tid, wave); }
}
DI void small_proj_e(LAS unsigned char* lds, const bf16* XB, const bf16* Wt, bf16* PROJ, const float* ssq, int tid, int wave, int G) {
    if ((int)blockIdx.x < G / 2) return;
    for (int su = G - 1 - (int)blockIdx.x; su < 4 * (EVEN_IN / 64); su += G / 2) { const int rt = su & 3, j = su >> 2;
        gemm_small_unit<128>(lds, XB, Wt, DM, MP + 128 * rt, 64 * j, 64 * j + 32, SEpiProj{PROJ, EVEN_IN, ssq}, tid, wave); }
}
DI void small_proj(LAS unsigned char* lds, const bf16* XB, const bf16* Wt, bf16* PROJ, int ldc, int ngrp, int with_logits, const float* ssq, int tid, int wave, int G) {
    const int nsmp = 2 * ngrp, nall = nsmp + (with_logits ? MP / 256 : 0);
    for (int su = G - 1 - (int)blockIdx.x; su < nall; su += G) {
        int m0, j; if (su < nsmp) { m0 = MP + 256 * (su & 1); j = su >> 1; } else { m0 = 256 * (su - nsmp); j = ngrp - 1; }
        gemm_small_unit<256>(lds, XB, Wt, DM, m0, 64 * j, 64 * j + 32, SEpiProj{PROJ, ldc, ssq}, tid, wave); }
}
#ifndef PROBE_MASK
#define PROBE_MASK 0
#endif
#ifndef PROBE_MODE
#define PROBE_MODE 0
#endif
#define IN(k) (lo <= (k) && (k) < hi)
#define SEAM(k) do { if (IN(k) && IN((k) + 1)) xcd_barrier(bar); } while (0)
template <int l> DI void run_layer(const Params& p, LAS unsigned char* lds, const XcdBarrier& bar, int lo, int hi, int tid, int lane, int wave, int G, int gw, int NGW) {
    unsigned char* ws = p.ws;
    float* X = (float*)(ws + WS_X); bf16* XB = (bf16*)(ws + WS_XN); bf16* HB = (bf16*)(ws + WS_H); bf16* PROJ = (bf16*)(ws + WS_PROJ); bf16* AO = (bf16*)(ws + WS_AO);
    float* Xs = X + (size_t)MP * DM;
    float* SSQ = (float*)(ws + WS_CTL) + CW_SSQ;
    const float* xp = (const float*)p.in[I_XP]; const float* xs = (const float*)p.in[I_XS];
    const int pb = PH_L0 + l * PH_PER_LAYER;
    if (IN(pb + LP_FIN1)) {
        const bf16* Wt = (const bf16*)(ws + WS_WFIN) + (size_t)(l * 2) * 2 * DFF * DM; const float* sq = SSQ + (size_t)(3 * l + 0) * MT;
        pg8::Gemm g{XB, Wt, MP, 2 * DFF, DM}; pg8::StaticOrder S; S.init(MP, 2 * DFF, G, (int)blockIdx.x);
        pg8::EpiSwiglu E{HB, DFF, sq};
        pg8::gemm_phase<pg8::EpiSwiglu, pg8::StaticOrder, PG8_ALIGN, PG8_SP2>(lds, g, S, E);
        small_swiglu(lds, XB, Wt, HB, sq, tid, wave, G);
    }
    SEAM(pb + LP_FIN1);
    if (IN(pb + LP_FOUT1)) {
        const bf16* Wt = (const bf16*)(ws + WS_WFOUT) + (size_t)(l * 2) * DM * DFF; float* sq = SSQ + (size_t)(3 * l + 1) * MT;
        pg8::Gemm g{HB, Wt, MP, DM, DFF}; pg8::StaticOrder S; S.init(MP, DM, G, (int)blockIdx.x);
        if (l == 0) { pg8::EpiResT<true, false> E{xp, XB, sq, 0.5f}; pg8::gemm_phase<pg8::EpiResT<true, false>, pg8::StaticOrder, PG8_ALIGN, PG8_SP2>(lds, g, S, E);
            small_res<true, false>(lds, HB, Wt, DFF, xs, XB, 0.5f, sq, tid, wave, G); }
        else { pg8::EpiResT<false, false> E{XB, XB, sq, 0.5f}; pg8::gemm_phase<pg8::EpiResT<false, false>, pg8::StaticOrder, PG8_ALIGN, PG8_SP2>(lds, g, S, E);
            small_res<false, false>(lds, HB, Wt, DFF, XB, XB, 0.5f, sq, tid, wave, G); }
    }
    SEAM(pb + LP_FOUT1);
    if (IN(pb + LP_PROJ)) {
        const float* sq = SSQ + (size_t)(3 * l + 1) * MT;
        if (l == 0) {
            pg8::Gemm g{XB, (const bf16*)(ws + WS_WINE), MP, EVEN_IN, DM}; pg8::StaticOrder S; S.init(MP, EVEN_IN, G, (int)blockIdx.x);
            pg8::EpiProj E{PROJ, EVEN_IN, sq};
            pg8::gemm_phase<pg8::EpiProj, pg8::StaticOrder, PG8_ALIGN, PG8_SP2>(lds, g, S, E);
            small_proj_e(lds, XB, (const bf16*)(ws + WS_WINE), PROJ, sq, tid, wave, G);
        } else {
            pg8::Gemm g{XB, (const bf16*)(ws + WS_WINO), MP, 4 * DNW, DM}; pg8::StaticOrder S; S.init(MP, 4 * DNW, G, (int)blockIdx.x);
            pg8::EpiProj E{PROJ, ODD_PAD, sq};
            pg8::gemm_phase<pg8::EpiProj, pg8::StaticOrder, PG8_ALIGN, PG8_SP2>(lds, g, S, E);
            small_proj(lds, XB, (const bf16*)(ws + WS_WINO), PROJ, ODD_PAD, 4 * DNW / 64 + 1, 1, sq, tid, wave, G);
        }
    }
    SEAM(pb + LP_PROJ);
    if (IN(pb + LP_MIXA)) { if (l == 0) phase_even_a(p, lds, tid, lane, wave, G); else phase_odd_a(p, lds, tid, lane, wave, G); }
    SEAM(pb + LP_MIXA);
    if (IN(pb + LP_MIXB)) { if (l == 0) phase_even_b(p, lds, tid, lane, wave, G); else phase_odd_b(p, lds, tid, lane, wave, G); }
    SEAM(pb + LP_MIXB);
    if (l == 1) { if (IN(pb + LP_MIXC)) phase_odd_c(p, lds, tid, wave, G); SEAM(pb + LP_MIXC); }
    if (IN(pb + LP_OUT)) {
        const bf16* Wt = (const bf16*)(ws + (l == 0 ? WS_WOUTE : WS_WOUTO)); float* sq = SSQ + (size_t)(3 * l + 2) * MT;
        pg8::Gemm g{AO, Wt, MP, DM, DM}; pg8::StaticOrder S; S.init(MP, DM, G, (int)blockIdx.x);
        pg8::EpiResT<false, false> E{XB, XB, sq, 1.0f};
        pg8::gemm_phase<pg8::EpiResT<false, false>, pg8::StaticOrder, PG8_ALIGN, PG8_SP2>(lds, g, S, E);
        small_res<false, false>(lds, AO, Wt, DM, XB, XB, 1.0f, sq, tid, wave, G);
    }
    SEAM(pb + LP_OUT);
    if (IN(pb + LP_FIN2)) {
        const bf16* Wt = (const bf16*)(ws + WS_WFIN) + (size_t)(l * 2 + 1) * 2 * DFF * DM; const float* sq = SSQ + (size_t)(3 * l + 2) * MT;
        pg8::Gemm g{XB, Wt, MP, 2 * DFF, DM}; pg8::StaticOrder S; S.init(MP, 2 * DFF, G, (int)blockIdx.x);
        pg8::EpiSwiglu E{HB, DFF, sq};
        pg8::gemm_phase<pg8::EpiSwiglu, pg8::StaticOrder, PG8_ALIGN, PG8_SP2>(lds, g, S, E);
        small_swiglu(lds, XB, Wt, HB, sq, tid, wave, G);
    }
    SEAM(pb + LP_FIN2);
    if (IN(pb + LP_FOUT2)) {
        const bf16* Wt = (const bf16*)(ws + WS_WFOUT) + (size_t)(l * 2 + 1) * DM * DFF; float* sq = l == 0 ? SSQ + (size_t)3 * MT : (float*)nullptr;
        pg8::Gemm g{HB, Wt, MP, DM, DFF}; pg8::StaticOrder S; S.init(MP, DM, G, (int)blockIdx.x);
        if (l == 0) { pg8::EpiResT<false, false> E{XB, XB, sq, 0.5f}; pg8::gemm_phase<pg8::EpiResT<false, false>, pg8::StaticOrder, PG8_ALIGN, PG8_SP2>(lds, g, S, E);
            small_res<false, false>(lds, HB, Wt, DFF, XB, XB, 0.5f, sq, tid, wave, G); }
        else { pg8::EpiResT<false, true> E{XB, p.out + O_YP, sq, 0.5f}; pg8::gemm_phase<pg8::EpiResT<false, true>, pg8::StaticOrder, PG8_ALIGN, PG8_SP2>(lds, g, S, E);
            small_res<false, true>(lds, HB, Wt, DFF, XB, p.out + O_YS, 0.5f, sq, tid, wave, G); }
    }
    SEAM(pb + LP_FOUT2);
}
__global__ void __launch_bounds__(NTHR, 2) mega(Params p) {
    extern __shared__ __attribute__((aligned(16))) unsigned char lds_raw[];
    LAS unsigned char* lds = (LAS unsigned char*)lds_raw;
    const int tid = threadIdx.x, lane = tid & 63, wave = __builtin_amdgcn_readfirstlane(tid >> 6);
    const int G = gridDim.x, gw = blockIdx.x * NWAVES + wave, NGW = G * NWAVES;
    unsigned char* ws = p.ws;
    unsigned* ctl = (unsigned*)(ws + WS_CTL);
    for (int u = tid; u < (LDS_BYTES - LDSCTL_OFF) / 4; u += NTHR) ((LAS unsigned*)(lds + LDSCTL_OFF))[u] = 0u;
    __syncthreads();
    const int lo = p.ph_lo, hi = p.ph_hi;
    XcdBarrier bar; bar.bar = ctl + CW_BAR; bar.x = 0; bar.st = nullptr;
    if (hi - lo > 1) bar = xcd_barrier_post(ctl + CW_BAR, (volatile LAS unsigned*)(lds + LDSCTL_OFF + 64));

    float* X = (float*)(ws + WS_X); bf16* XN = (bf16*)(ws + WS_XN); bf16* HB = (bf16*)(ws + WS_H); bf16* PROJ = (bf16*)(ws + WS_PROJ); bf16* AO = (bf16*)(ws + WS_AO);
    const float* xp = (const float*)p.in[I_XP]; const float* xs = (const float*)p.in[I_XS];

    if (IN(PH_PRO)) { phase_prologue(p, lds, gw, NGW, wave, lane); phase_input_rows(xp, xs, XN, (float*)(ws + WS_CTL) + CW_SSQ, gw, NGW, lane); }
    SEAM(PH_PRO);

    run_layer<0>(p, lds, bar, lo, hi, tid, lane, wave, G, gw, NGW);
    run_layer<1>(p, lds, bar, lo, hi, tid, lane, wave, G, gw, NGW);
#undef IN
#undef SEAM
}

#ifndef MK_ONE_LAUNCH
#define MK_ONE_LAUNCH 1
#endif
extern "C" void kernel_launch(void* const* d_in, const int* in_sizes, int n_in, void* d_out, int out_size, void* d_ws, size_t ws_size, hipStream_t stream) {
    static int grid = 0;
    if (grid == 0) {
        if (n_in != N_IN || (size_t)out_size != O_END || ws_size < WS_END) { fprintf(stderr, "kernel_launch: unexpected problem: n_in %d out %d ws %zu\n", n_in, out_size, ws_size); grid = -1; return; }
        int dev = 0, cus = 0;
        if (hipGetDevice(&dev) != hipSuccess || hipDeviceGetAttribute(&cus, hipDeviceAttributeMultiprocessorCount, dev) != hipSuccess) { grid = -1; return; }
        if (hipFuncSetAttribute((const void*)mega, hipFuncAttributeMaxDynamicSharedMemorySize, LDS_BYTES) != hipSuccess) { fprintf(stderr, "kernel_launch: hipFuncSetAttribute failed\n"); grid = -1; return; }
        int per_cu = 0;
        if (hipOccupancyMaxActiveBlocksPerMultiprocessor(&per_cu, (const void*)mega, NTHR, LDS_BYTES) != hipSuccess || per_cu < 1) fprintf(stderr, "kernel_launch: occupancy query says %d\n", per_cu);
        (void)hipGetLastError();
        grid = cus;
    }
    if (grid < 0) return;
    if (hipMemsetAsync((char*)d_ws + WS_CTL, 0, CTL_ZERO_BYTES, stream) != hipSuccess) return;
    Params p{};
    for (int i = 0; i < N_IN; ++i) p.in[i] = d_in[i];
    p.out = (float*)d_out; p.ws = (unsigned char*)d_ws;
#if PROBE_MASK
    { int lo = 0;
      for (int ph = 0; ph < NPH; ++ph) if ((PROBE_MASK >> ph) & 1) {
          p.ph_lo = lo; p.ph_hi = ph + 1; hipLaunchKernelGGL(mega, dim3(grid), dim3(NTHR), LDS_BYTES, stream, p);
          (void)hipMemsetAsync((char*)d_ws + WS_CTL, 0, CW_SSQ * 4, stream);
          p.ph_lo = ph; p.ph_hi = ph + 1; p.mode = PROBE_MODE; hipLaunchKernelGGL(mega, dim3(grid), dim3(NTHR), LDS_BYTES, stream, p); p.mode = 0;
          (void)hipMemsetAsync((char*)d_ws + WS_CTL, 0, CW_SSQ * 4, stream);
          lo = ph + 1; }
      if (lo < NPH) { p.ph_lo = lo; p.ph_hi = NPH; hipLaunchKernelGGL(mega, dim3(grid), dim3(NTHR), LDS_BYTES, stream, p); } }
#elif MK_ONE_LAUNCH
    p.ph_lo = 0; p.ph_hi = NPH;
    hipLaunchKernelGGL(mega, dim3(grid), dim3(NTHR), LDS_BYTES, stream, p);
#else
    for (int ph = 0; ph < NPH; ++ph) { p.ph_lo = ph; p.ph_hi = ph + 1; hipLaunchKernelGGL(mega, dim3(grid), dim3(NTHR), LDS_BYTES, stream, p); }
#endif
}
```

```cpp
#include <hip/hip_runtime.h>
#include <cstdio>
#include <cstdint>

#define GAS __attribute__((address_space(1)))
#define LAS __attribute__((address_space(3)))
typedef unsigned short bf16;
typedef short bf16x8 __attribute__((ext_vector_type(8)));
typedef short bf16x4 __attribute__((ext_vector_type(4)));
typedef float f32x2 __attribute__((ext_vector_type(2)));
typedef float f32x4 __attribute__((ext_vector_type(4)));
typedef float f32x16 __attribute__((ext_vector_type(16)));
typedef unsigned u32x2 __attribute__((ext_vector_type(2)));
typedef unsigned u32x4 __attribute__((ext_vector_type(4)));
typedef __bf16 bf16v2 __attribute__((ext_vector_type(2)));
#define DI __device__ __forceinline__
DI unsigned pk2(float lo, float hi) { f32x2 v = {lo, hi}; return __builtin_bit_cast(unsigned, __builtin_convertvector(v, bf16v2)); }
DI bf16 f2bf(float f) { return (bf16)(pk2(f, 0.f) & 0xffffu); }
DI float bf2f(bf16 b) { return __builtin_bit_cast(float, ((unsigned)b) << 16); }
DI float bflo(unsigned w) { return __builtin_bit_cast(float, w << 16); }
DI float bfhi(unsigned w) { return __builtin_bit_cast(float, w & 0xffff0000u); }
DI float fexp2(float x) { return __builtin_amdgcn_exp2f(x); }
DI float flog2(float x) { return __builtin_amdgcn_logf(x); }
DI float frcp(float x) { return __builtin_amdgcn_rcpf(x); }
DI float frsq(float x) { return __builtin_amdgcn_rsqf(x); }
#define LOG2E 1.4426950408889634f
#define LN2 0.6931471805599453f
DI float fsigmoid(float x) { return frcp(1.0f + fexp2(-x * LOG2E)); }
DI float fsilu(float x) { return x * fsigmoid(x); }
DI float fsoftplus(float x) { return x > 20.f ? x : LN2 * flog2(1.0f + fexp2(x * LOG2E)); }
DI float fgelu_tanh(float x) { const float u = 0.7978845608028654f * (x + 0.044715f * x * x * x); return x * fsigmoid(2.0f * u); }
DI float fnegexpm1(float x) { const float pl = -x * (1.f + x * (0.5f + x * (0.16666667f + x * (0.041666668f + x * (0.0083333338f + x * 0.0013888889f))))); return x > -0.25f ? pl : 1.0f - fexp2(x * LOG2E); }
#define MFMA32(a, b, c) __builtin_amdgcn_mfma_f32_32x32x16_bf16((a), (b), (c), 0, 0, 0)
#define LDS_WAIT() asm volatile("s_waitcnt lgkmcnt(0)" ::: "memory")
#define VM_WAIT() asm volatile("s_waitcnt vmcnt(0)" ::: "memory")
DI float wave_sum(float v) {
#pragma unroll
    for (int o = 1; o < 64; o <<= 1) v += __shfl_xor(v, o);
    return v;
}

constexpr int DM = 1024, NB_P = 4, T_P = 4096, MP = NB_P * T_P  , NB_S = 128, T_S = 4, MS = NB_S * T_S  , MT = MP + MS  ;
constexpr int PAST = 2048, PAGE = 128, NPAGES = 16, NPOOL = 2560;
constexpr int SBH = 8, SBD = 64, SBW = 512, LRW = 512, DNH = 8, DND = 128, DNW = 1024, DFF = 2048;
constexpr int EVEN_IN = 2560, ODD_IN = 4112, ODD_PAD = 4352;
constexpr float EPS = 1e-6f;
namespace pg8 {
#define PG8_LAS __attribute__((address_space(3)))
typedef unsigned short bf16_t;
constexpr int BM = 256, BK = 64, HALF = 128, HTB = HALF * BK * 2  , STAGE_BYTES = 8 * HTB, NXCD = 8, WGM = 8;

__host__ __device__ __forceinline__ int lds_byte(int r, int c) { const int st = (r >> 4) * 2 + (c >> 5), rr = r & 15, cc = c & 31, ob = rr * 64 + cc * 2; return st * 1024 + (ob ^ (((ob >> 9) & 1) << 5)); }
__host__ __device__ __forceinline__ void stage_rc(int b, int& R, int& C) { const int st = b / 1024, sb = b % 1024, swz = sb ^ (((sb >> 9) & 1) << 5); R = (st >> 1) * 16 + swz / 64; C = (st & 1) * 32 + (swz % 64) / 2; }
__host__ __device__ __forceinline__ int perm32(int rho) { const int n = rho >> 4, i = rho & 15; return 8 * (i >> 2) + 4 * n + (i & 3); }

struct Unit { int pm, pn; };
struct Gemm { const bf16_t* A; const bf16_t* Bt; int M, N, K; };

struct StaticOrder {
    int nM, nN, nwg, G, c;
    __host__ __device__ void init(int M, int N, int G_, int c_) { nM = M / BM; nN = N / BM; nwg = nM * nN; G = G_; c = c_; }
    __host__ __device__ bool next(int i, Unit& u) const {
        const long L = (long)i * G + c; if (L >= nwg) return false;
        int wgid = (int)L; { const int q = nwg / NXCD, r = nwg % NXCD, xcd = wgid % NXCD, off = wgid / NXCD; wgid = (xcd < r ? xcd * (q + 1) : r * (q + 1) + (xcd - r) * q) + off; }
        const int nig = WGM * nN, gid = wgid / nig, fm = gid * WGM, gsz = (nM - fm) < WGM ? (nM - fm) : WGM;
        u.pm = fm + ((wgid % nig) % gsz); u.pn = (wgid % nig) / gsz; return true;
    }
    __device__ __forceinline__ void a_ready(const Unit&) const {}
    __device__ __forceinline__ void done(const Unit&) const {}
};


DI float row_rstd(const float* ssq, int row) { return frsq((float)((const unsigned*)ssq)[row] * (1.f / 1024.f) * (1.f / DM) + EPS); }
DI void ssq_add(float* ssq, int row, float s) { atomicAdd((unsigned*)ssq + row, (unsigned)(s * 1024.f + 0.5f)); }
struct PreNone {};
struct PreRs { unsigned raw[2][4]; DI float rs(int ai, int m) const { return frsq((float)raw[ai][m] * (1.f / 1024.f) * (1.f / DM) + EPS); } };
DI PreRs pre_rstd(const float* ssq, const Unit& u, int wr, int fr) { PreRs p;
#pragma unroll
    for (int ai = 0; ai < 2; ++ai)
#pragma unroll
        for (int m = 0; m < 4; ++m) p.raw[ai][m] = ((const unsigned*)ssq)[u.pm * BM + wr * 64 + fr + ai * HALF + m * 16];
    return p; }
struct EpiSwiglu {
    static constexpr bool PERM = true, AFTER_DRAIN = false;
    bf16_t* H; int ldc; const float* ssq;
    typedef PreRs Pre; DI Pre pre(const Unit& u, int wr, int fr) const { return pre_rstd(ssq, u, wr, fr); }
    __device__ __forceinline__ void operator()(const f32x4 (&acc)[2][2][4][2], const Unit& u, int wr, int wc, int fr, int fq, const Pre& P) const {
        const int row0 = u.pm * BM + wr * 64 + fr, col0 = u.pn * HALF + wc * 32 + 8 * fq;
#pragma unroll
        for (int ai = 0; ai < 2; ++ai)
#pragma unroll
            for (int m = 0; m < 4; ++m) {
                const int row = row0 + ai * HALF + m * 16; const float rs = P.rs(ai, m);
                bf16_t* rowp = H + (size_t)row * ldc + col0;
                const f32x4 g0 = acc[ai][0][m][0] * rs, g1 = acc[ai][0][m][1] * rs, u0 = acc[ai][1][m][0] * rs, u1 = acc[ai][1][m][1] * rs;
                u32x4 w;
                w.x = pk2(fsilu(g0[0]) * u0[0], fsilu(g0[1]) * u0[1]); w.y = pk2(fsilu(g0[2]) * u0[2], fsilu(g0[3]) * u0[3]);
                w.z = pk2(fsilu(g1[0]) * u1[0], fsilu(g1[1]) * u1[1]); w.w = pk2(fsilu(g1[2]) * u1[2], fsilu(g1[3]) * u1[3]);
                *(u32x4*)rowp = w;
            }
    }
};
template <bool BASE_F32, bool OUT_F32> struct EpiResT {
    static constexpr bool PERM = true, AFTER_DRAIN = false;
    const void* base; void* out; float* ssq; float alpha;
    typedef PreNone Pre; DI Pre pre(const Unit&, int, int) const { return Pre{}; }
    __device__ __forceinline__ void operator()(const f32x4 (&acc)[2][2][4][2], const Unit& u, int wr, int wc, int fr, int fq, const Pre&) const {
        const int row0 = u.pm * BM + wr * 64 + fr, col0 = u.pn * BM + wc * 32 + 8 * fq;
#pragma unroll
        for (int ai = 0; ai < 2; ++ai)
#pragma unroll
            for (int m = 0; m < 4; ++m) {
                const int row = row0 + ai * HALF + m * 16; const size_t off = (size_t)row * DM + col0; float s = 0.f;
#pragma unroll
                for (int bj = 0; bj < 2; ++bj) {
                    f32x4 b0, b1;
                    if (BASE_F32) { const float* bp = (const float*)base + off + bj * HALF; b0 = *(const f32x4*)bp; b1 = *(const f32x4*)(bp + 4); }
                    else { const u32x4 w = *(const u32x4*)((const bf16_t*)base + off + bj * HALF); b0 = (f32x4){bflo(w.x), bfhi(w.x), bflo(w.y), bfhi(w.y)}; b1 = (f32x4){bflo(w.z), bfhi(w.z), bflo(w.w), bfhi(w.w)}; }
                    const f32x4 o0 = b0 + acc[ai][bj][m][0] * alpha, o1 = b1 + acc[ai][bj][m][1] * alpha;
                    if (OUT_F32) { float* op = (float*)out + off + bj * HALF; *(f32x4*)op = o0; *(f32x4*)(op + 4) = o1; }
                    else { u32x4 w; w.x = pk2(o0[0], o0[1]); w.y = pk2(o0[2], o0[3]); w.z = pk2(o1[0], o1[1]); w.w = pk2(o1[2], o1[3]); *(u32x4*)((bf16_t*)out + off + bj * HALF) = w; }
                    s += ((o0[0] * o0[0] + o0[1] * o0[1]) + (o0[2] * o0[2] + o0[3] * o0[3])) + ((o1[0] * o1[0] + o1[1] * o1[1]) + (o1[2] * o1[2] + o1[3] * o1[3]));
                }
                if (ssq) { s += __shfl_xor(s, 16); s += __shfl_xor(s, 32); if (fq == 0) ssq_add(ssq, row, s); }
            }
    }
};
struct EpiProj {
    static constexpr bool PERM = true, AFTER_DRAIN = false;
    bf16_t* O; int ldc; const float* ssq;
    typedef PreRs Pre; DI Pre pre(const Unit& u, int wr, int fr) const { return pre_rstd(ssq, u, wr, fr); }
    __device__ __forceinline__ void operator()(const f32x4 (&acc)[2][2][4][2], const Unit& u, int wr, int wc, int fr, int fq, const Pre& P) const {
        const int row0 = u.pm * BM + wr * 64 + fr, col0 = u.pn * BM + wc * 32 + 8 * fq;
#pragma unroll
        for (int ai = 0; ai < 2; ++ai)
#pragma unroll
            for (int m = 0; m < 4; ++m) {
                const int row = row0 + ai * HALF + m * 16; const float rs = P.rs(ai, m);
                bf16_t* rowp = O + (size_t)row * ldc + col0;
#pragma unroll
                for (int bj = 0; bj < 2; ++bj) { const f32x4 v0 = acc[ai][bj][m][0] * rs, v1 = acc[ai][bj][m][1] * rs;
                    u32x4 w; w.x = pk2(v0[0], v0[1]); w.y = pk2(v0[2], v0[3]); w.z = pk2(v1[0], v1[1]); w.w = pk2(v1[2], v1[3]);
                    *(u32x4*)(rowp + bj * HALF) = w; }
            }
    }
};

template <class Epi, class Sched, bool ALIGN_EPI = false, bool SP2 = false>
__device__ __forceinline__ void gemm_phase(PG8_LAS unsigned char* lds, const Gemm g, const Sched& S, const Epi& E) {
    const int tid = threadIdx.x, wid = __builtin_amdgcn_readfirstlane(tid >> 6), lane = tid & 63, wr = wid >> 2, wc = wid & 3, fr = lane & 15, fq = lane >> 4;
    const int K = g.K, nt = K / BK;
    unsigned voffA[2], voffB[2];
#pragma unroll
    for (int i = 0; i < 2; ++i) { int R, C; stage_rc(tid * 16 + i * 8192, R, C); const int Rb = Epi::PERM ? ((R & ~31) + perm32(R & 31)) : R;
        voffA[i] = (unsigned)(R * K + C) * 2u; voffB[i] = (unsigned)(Rb * K + C) * 2u; }
    const size_t kstep = (size_t)(BK * 2);
    const size_t hstep = (size_t)HALF * K * 2;
    const size_t tstep = 2 * hstep;
    const unsigned ldsw = (unsigned)wid * 1024u;
    const int aoff = lds_byte(wr * 64 + fr, fq * 8), boff = lds_byte(wc * 32 + fr, fq * 8);
#define PG8_SA(b, h) (((b) * 2 + (h)) * HTB)
#define PG8_SB(b, h) ((4 + (b) * 2 + (h)) * HTB)
#define PG8_STAGE(bufoff, gbase, voff) do { _Pragma("unroll") for (int _i = 0; _i < 2; ++_i) \
        __builtin_amdgcn_global_load_lds((const unsigned*)((const char*)(gbase) + (voff)[_i]), (PG8_LAS unsigned*)(lds + (bufoff) + ldsw + _i * 8192), 16, 0, 0); } while (0)
#define PG8_LDA(dst, b, h) do { _Pragma("unroll") for (int m = 0; m < 4; ++m) _Pragma("unroll") for (int k = 0; k < 2; ++k) dst[m][k] = *(const PG8_LAS bf16x8*)(lds + PG8_SA(b, h) + aoff + m * 2048 + k * 1024); } while (0)
#define PG8_LDB(dst, b, h) do { _Pragma("unroll") for (int n = 0; n < 2; ++n) _Pragma("unroll") for (int k = 0; k < 2; ++k) dst[n][k] = *(const PG8_LAS bf16x8*)(lds + PG8_SB(b, h) + boff + n * 2048 + k * 1024); } while (0)
#define PG8_MMA(ai, bj, At, Bt) do { __builtin_amdgcn_s_setprio(1); _Pragma("unroll") for (int m = 0; m < 4; ++m) _Pragma("unroll") for (int n = 0; n < 2; ++n) _Pragma("unroll") for (int k = 0; k < 2; ++k) \
        acc[ai][bj][m][n] = __builtin_amdgcn_mfma_f32_16x16x32_bf16(Bt[n][k], At[m][k], acc[ai][bj][m][n], 0, 0, 0); __builtin_amdgcn_s_setprio(0); } while (0)
#define PG8_WAIT_V(n) asm volatile("s_waitcnt vmcnt(" #n ")" ::: "memory")
#define PG8_WAIT_L(n) asm volatile("s_waitcnt lgkmcnt(" #n ")" ::: "memory")
#define PG8_BAR __builtin_amdgcn_s_barrier()
#define PG8_SCHED __builtin_amdgcn_sched_barrier(0)
    Unit cur, nxt; int ui = 0;
    if (!S.next(0, cur)) return;
    f32x4 acc[2][2][4][2];
#pragma unroll
    for (int a = 0; a < 2; ++a)
#pragma unroll
        for (int b = 0; b < 2; ++b)
#pragma unroll
            for (int m = 0; m < 4; ++m)
#pragma unroll
                for (int n = 0; n < 2; ++n) acc[a][b][m][n] = (f32x4){0.f, 0.f, 0.f, 0.f};
    bf16x8 At[4][2], B0[2][2], B1[2][2];
    const char* cA = (const char*)g.A + (size_t)cur.pm * tstep; const char* cB = (const char*)g.Bt + (size_t)cur.pn * tstep;
    S.a_ready(cur);
    if constexpr (SP2) {
        PG8_STAGE(PG8_SB(0, 0), cB, voffB); PG8_STAGE(PG8_SB(0, 1), cB + hstep, voffB); PG8_STAGE(PG8_SA(0, 0), cA, voffA); PG8_STAGE(PG8_SA(0, 1), cA + hstep, voffA);
        if (wr == 1) PG8_BAR;
        PG8_WAIT_V(2); PG8_BAR;
        PG8_STAGE(PG8_SB(1, 0), cB + kstep, voffB); PG8_STAGE(PG8_SA(1, 0), cA + kstep, voffA); PG8_STAGE(PG8_SB(1, 1), cB + hstep + kstep, voffB);
        PG8_WAIT_V(6); PG8_BAR;
    } else {
        PG8_STAGE(PG8_SB(0, 0), cB, voffB); PG8_STAGE(PG8_SA(0, 0), cA, voffA); PG8_STAGE(PG8_SB(0, 1), cB + hstep, voffB); PG8_STAGE(PG8_SA(0, 1), cA + hstep, voffA);
        if (wr == 1) PG8_BAR;
        PG8_WAIT_V(4); PG8_BAR;
        PG8_STAGE(PG8_SB(1, 0), cB + kstep, voffB); PG8_STAGE(PG8_SA(1, 0), cA + kstep, voffA); PG8_STAGE(PG8_SB(1, 1), cB + hstep + kstep, voffB);
        PG8_WAIT_V(6); PG8_BAR;
    }
    for (;;) {
        const bool has_next = S.next(ui + 1, nxt);
        const char* nA = has_next ? (const char*)g.A + (size_t)nxt.pm * tstep : cA; const char* nB = has_next ? (const char*)g.Bt + (size_t)nxt.pn * tstep : cB;
        const typename Epi::Pre pre = E.pre(cur, wr, fr);
        for (int t = 0; t < nt; t += 2) {
            const bool last = (t == nt - 2);
            const char* a1 = cA + (size_t)(t + 1) * kstep;
            const char* a2 = last ? nA : cA + (size_t)(t + 2) * kstep; const char* b2 = last ? nB : cB + (size_t)(t + 2) * kstep;
            const char* a3 = a2 + kstep; const char* b3 = b2 + kstep;
            if (last && has_next) S.a_ready(nxt);
            if constexpr (SP2) {
            PG8_LDB(B0, 0, 0); PG8_LDB(B1, 0, 1); PG8_SCHED; PG8_LDA(At, 0, 0); PG8_STAGE(PG8_SA(1, 1), a1 + hstep, voffA);
            PG8_WAIT_V(8); PG8_WAIT_L(0); PG8_BAR; PG8_MMA(0, 0, At, B0); PG8_MMA(0, 1, At, B1); PG8_BAR; PG8_SCHED;
            PG8_LDA(At, 0, 1); PG8_STAGE(PG8_SB(0, 0), b2, voffB); PG8_STAGE(PG8_SB(0, 1), b2 + hstep, voffB); PG8_STAGE(PG8_SA(0, 0), a2, voffA);
            PG8_WAIT_V(8); PG8_WAIT_L(0); PG8_BAR; PG8_MMA(1, 0, At, B0); PG8_MMA(1, 1, At, B1); PG8_BAR; PG8_SCHED;
            PG8_LDB(B0, 1, 0); PG8_LDB(B1, 1, 1); PG8_SCHED; PG8_LDA(At, 1, 0); PG8_STAGE(PG8_SA(0, 1), a2 + hstep, voffA);
            PG8_WAIT_V(8); PG8_WAIT_L(0); PG8_BAR; PG8_MMA(0, 0, At, B0); PG8_MMA(0, 1, At, B1); PG8_BAR; PG8_SCHED;
            PG8_LDA(At, 1, 1); PG8_STAGE(PG8_SB(1, 0), b3, voffB); PG8_STAGE(PG8_SB(1, 1), b3 + hstep, voffB); PG8_STAGE(PG8_SA(1, 0), a3, voffA);
            PG8_WAIT_V(8); PG8_WAIT_L(0); PG8_BAR; PG8_MMA(1, 0, At, B0); PG8_MMA(1, 1, At, B1); PG8_BAR; PG8_SCHED;
            } else {
            PG8_LDB(B0, 0, 0); PG8_SCHED; PG8_LDA(At, 0, 0); PG8_STAGE(PG8_SA(1, 1), a1 + hstep, voffA);
            PG8_WAIT_L(8); PG8_BAR; PG8_WAIT_L(0); PG8_MMA(0, 0, At, B0); PG8_BAR; PG8_SCHED;
            PG8_LDB(B1, 0, 1); PG8_STAGE(PG8_SB(0, 0), b2, voffB);
            PG8_BAR; PG8_WAIT_L(0); PG8_MMA(0, 1, At, B1); PG8_BAR;
            PG8_LDA(At, 0, 1); PG8_STAGE(PG8_SA(0, 0), a2, voffA);
            PG8_BAR; PG8_WAIT_L(0); PG8_MMA(1, 0, At, B0); PG8_BAR; PG8_SCHED;
            PG8_STAGE(PG8_SB(0, 1), b2 + hstep, voffB);
            PG8_WAIT_V(6); PG8_BAR; PG8_MMA(1, 1, At, B1); PG8_BAR;
            PG8_LDB(B0, 1, 0); PG8_SCHED; PG8_LDA(At, 1, 0); PG8_STAGE(PG8_SA(0, 1), a2 + hstep, voffA);
            PG8_WAIT_L(8); PG8_BAR; PG8_WAIT_L(0); PG8_MMA(0, 0, At, B0); PG8_BAR; PG8_SCHED;
            PG8_LDB(B1, 1, 1); PG8_STAGE(PG8_SB(1, 0), b3, voffB);
            PG8_BAR; PG8_WAIT_L(0); PG8_MMA(0, 1, At, B1); PG8_BAR;
            PG8_LDA(At, 1, 1); PG8_STAGE(PG8_SA(1, 0), a3, voffA);
            PG8_BAR; PG8_WAIT_L(0); PG8_MMA(1, 0, At, B0); PG8_BAR; PG8_SCHED;
            PG8_STAGE(PG8_SB(1, 1), b3 + hstep, voffB);
            PG8_WAIT_V(6); PG8_BAR; PG8_MMA(1, 1, At, B1); PG8_BAR;
            }
        }
        if constexpr (ALIGN_EPI) { if (wr == 0) PG8_BAR; }
        if constexpr (!Epi::AFTER_DRAIN) { E(acc, cur, wr, wc, fr, fq, pre); S.done(cur); }
        if (!has_next) break;
#pragma unroll
        for (int a = 0; a < 2; ++a)
#pragma unroll
            for (int b = 0; b < 2; ++b)
#pragma unroll
                for (int m = 0; m < 4; ++m)
#pragma unroll
                    for (int n = 0; n < 2; ++n) acc[a][b][m][n] = (f32x4){0.f, 0.f, 0.f, 0.f};
        cur = nxt; cA = nA; cB = nB; ++ui;
        if constexpr (ALIGN_EPI) { if (wr == 1) PG8_BAR; }
    }
    PG8_WAIT_V(0);
    if constexpr (!ALIGN_EPI) { if (wr == 0) PG8_BAR; }
    PG8_BAR;
    if constexpr (Epi::AFTER_DRAIN) { E.fused(acc, cur, wr, wc, fr, fq, lds, wid, lane); S.done(cur); }
#undef PG8_SA
#undef PG8_SB
#undef PG8_STAGE
#undef PG8_LDA
#undef PG8_LDB
#undef PG8_MMA
#undef PG8_WAIT_V
#undef PG8_WAIT_L
#undef PG8_BAR
#undef PG8_SCHED
}
}
#define PG8_SP2 true
#define PG8_ALIGN true
#define XB_TMO      128
#define XB_XCNT(j)  (256  + 64 * (j))
#define XB_XSUB(j)  (1280 + 64 * (j))
#define XB_XGEN(j)  (2304 + 64 * (j))
#define XB_TOP      3328
#define XB_TOPGEN   3392
#define XCD_BAR_WORDS 3456
#define XB_SPIN_CAP (1u << 18)


__device__ __forceinline__ unsigned xb_ld(unsigned* p)              { return __hip_atomic_load(p, __ATOMIC_RELAXED, __HIP_MEMORY_SCOPE_AGENT); }
__device__ __forceinline__ unsigned xb_add(unsigned* p, unsigned v) { return __hip_atomic_fetch_add(p, v, __ATOMIC_RELAXED, __HIP_MEMORY_SCOPE_AGENT); }
__device__ __forceinline__ unsigned xb_xcc_id() { return (unsigned)__builtin_amdgcn_s_getreg((3 << 11) | 20) & 0xFu; }
#define XB_SPIN(cond, bar) do { unsigned _sp = 0; while (cond) { __builtin_amdgcn_s_sleep(1); \
    if ((++_sp & 255u) == 0u) { if (xb_ld(&(bar)[XB_TMO])) break; if (_sp > XB_SPIN_CAP) { atomicAdd(&(bar)[XB_TMO], 1u); break; } } } } while (0)

struct XcdBarrier {
    unsigned* bar; unsigned x;
    volatile LAS unsigned* st;
};

__device__ __forceinline__ XcdBarrier xcd_barrier_post(unsigned* bar, volatile LAS unsigned* st) {
    XcdBarrier b; b.bar = bar; b.x = xb_xcc_id(); b.st = st;
    if (threadIdx.x == 0) (void)xb_add(&bar[XB_XCNT(b.x)], 1u);
    return b;
}
__device__ __forceinline__ void xcd_barrier_complete(unsigned* bar, unsigned x, unsigned& nloc, unsigned& nx) {
    const unsigned G = gridDim.x * gridDim.y * gridDim.z;
    unsigned sum, cnt, mine, sp = 0u;
    for (;;) {
        sum = 0u; cnt = 0u; mine = 0u;
#pragma unroll
        for (unsigned j = 0; j < 16; ++j) { const unsigned c = xb_ld(&bar[XB_XCNT(j)]); sum += c; cnt += (c > 0u) ? 1u : 0u; mine = (j == x) ? c : mine; }
        if (sum == G) break;
        __builtin_amdgcn_s_sleep(1);
        if ((++sp & 255u) == 0u) { if (xb_ld(&bar[XB_TMO])) break; if (sp > XB_SPIN_CAP) { atomicAdd(&bar[XB_TMO], 1u); break; } }
    }
    nloc = mine > 0u ? mine : 1u; nx = cnt > 0u ? cnt : 1u;
}

__device__ __forceinline__ void xcd_barrier(const XcdBarrier& b) {
    asm volatile("s_waitcnt vmcnt(0)" ::: "memory");
    __syncthreads();
    if (threadIdx.x == 0) {
        unsigned* bar = b.bar;
        __builtin_amdgcn_s_waitcnt(0);
        unsigned nloc = b.st[0], nx = b.st[1];
        if (nloc == 0u) { xcd_barrier_complete(bar, b.x, nloc, nx); b.st[0] = nloc; b.st[1] = nx; }
        const unsigned old = xb_add(&bar[XB_XSUB(b.x)], 1u);
        const unsigned gen = old / nloc;
        if (old + 1u == (gen + 1u) * nloc) {
            __builtin_amdgcn_fence(__ATOMIC_RELEASE, "agent");
            asm volatile("s_waitcnt vmcnt(0)" ::: "memory");
            const unsigned og = xb_add(&bar[XB_TOP], 1u);
            const unsigned tg = og / nx;
            if (og + 1u == (tg + 1u) * nx) xb_add(&bar[XB_TOPGEN], 1u);
            else XB_SPIN(xb_ld(&bar[XB_TOPGEN]) == tg, bar);
            __builtin_amdgcn_fence(__ATOMIC_ACQUIRE, "agent");
            xb_add(&bar[XB_XGEN(b.x)], 1u);
            asm volatile("s_waitcnt vmcnt(0)" ::: "memory");
        } else {
            XB_SPIN(xb_ld(&bar[XB_XGEN(b.x)]) == gen, bar);
            __builtin_amdgcn_fence(__ATOMIC_ACQUIRE, "agent");
            asm volatile("s_waitcnt vmcnt(0)" ::: "memory");
        }
    }
    __syncthreads();
}

constexpr size_t MiB = 1u << 20;
constexpr size_t WS_CTL = 0, CTL_ZERO_BYTES = 1 * MiB;
constexpr size_t WS_WFIN = 1 * MiB;
constexpr size_t WS_WFOUT = 33 * MiB;
constexpr size_t WS_WINE = 49 * MiB;
constexpr size_t WS_WOUTE = 54 * MiB;
constexpr size_t WS_WINO = 56 * MiB;
constexpr size_t WS_WOUTO = 65 * MiB;
constexpr size_t WS_X = 68 * MiB;
constexpr size_t WS_XN = 134 * MiB;
constexpr size_t WS_H = 167 * MiB;
constexpr size_t WS_PROJ = 233 * MiB;
constexpr size_t WS_QB = 374 * MiB;
constexpr size_t WS_KB = 391 * MiB;
constexpr size_t WS_VT = 408 * MiB;
constexpr size_t WS_VS = 424 * MiB;
constexpr size_t WS_AO = 425 * MiB;
constexpr size_t WS_HL = 458 * MiB;
constexpr size_t WS_PP = 474 * MiB;
constexpr size_t WS_AGG = 490 * MiB;
constexpr size_t WS_UV = 491 * MiB, WS_WK = 523 * MiB, WS_QG = 555 * MiB, WS_KGT = 587 * MiB;
constexpr size_t WS_PM = 619 * MiB;
constexpr size_t WS_GL = 635 * MiB;
constexpr size_t WS_OR = 636 * MiB;
constexpr size_t WS_SPART = 668 * MiB;
constexpr size_t WS_END = 672 * MiB;
constexpr int CW_BAR = 4096;
constexpr int CW_SSQ = 65536;
constexpr int CW_SMPCNT = 32768;
constexpr int CW_QUEUE = 16384;

constexpr size_t O_YP = 0, O_YS = 16777216, O_KP = 17301504, O_VP = 25690112, O_LCP = 34078720, O_LHP = 34084864, O_DCP = 34086912, O_DSP = 34123776,
                 O_KS = 34648064, O_VS = 34910208, O_LCS = 35172352, O_LHS = 35368960, O_DCS = 35434496, O_DSS = 36614144, O_END = 53391360;

constexpr int RING_BYTES = 131072;
constexpr int LDSCTL_OFF = RING_BYTES;
constexpr int LDS_BYTES = 147456;

enum InIdx { I_XP = 0, I_XS, I_CK, I_CV, I_SLC, I_SLH, I_SDC, I_SDS, I_PT, I_NF1, I_WF1I, I_WF1O, I_NM, I_NF2, I_WF2I, I_WF2O,
             I_WINE, I_QG, I_KG, I_SBB, I_LCW, I_LCB, I_LWA, I_LBA, I_LWI, I_LBI, I_LAM, I_WOUTE, I_WINO, I_DCW, I_DAL, I_DDT, I_DOG, I_WOUTO, N_IN };
struct Params { const void* in[N_IN]; float* out; unsigned char* ws; int ph_lo, ph_hi, mode, pad; };
static_assert(sizeof(Params) == (N_IN + 2) * 8 + 16, "Params has no padding");

constexpr int NWAVES = 8, NTHR = 512;
constexpr int PH_PRO = 0, PH_L0 = 1, PH_PER_LAYER = 9, NPH = 1 + 2 * PH_PER_LAYER;
enum LayerPhase { LP_FIN1 = 0, LP_FOUT1, LP_PROJ, LP_MIXA, LP_MIXB, LP_MIXC, LP_OUT, LP_FIN2, LP_FOUT2 };

struct RowId { DI int operator()(int n) const { return n; } };
struct RowSwiglu { DI int operator()(int n) const { return n < DFF ? ((n >> 7) << 8) + (n & 127) : (((n - DFF) >> 7) << 8) + 128 + ((n - DFF) & 127); } };
template <class RM> DI void transpose_item(const float* W, int K, int N, bf16* WT, RM rm, LAS float* scrf, int item, int lane, const float* gain = nullptr) {
    LAS bf16* scr = (LAS bf16*)scrf;
    const int nblk = (N + 63) / 64, kb = item / nblk, nb = item % nblk, k0 = 64 * kb, n0 = 64 * nb;
    { const int kk = lane >> 4, n4 = 4 * (lane & 15); const bool ok = n0 + n4 < N;
      f32x4 v[16];
#pragma unroll
      for (int i = 0; i < 16; ++i) v[i] = ok ? *(const f32x4*)(W + (size_t)(k0 + 4 * i + kk) * N + n0 + n4) : (f32x4){0.f, 0.f, 0.f, 0.f};
      if (gain) {
#pragma unroll
          for (int i = 0; i < 16; ++i) v[i] = v[i] * gain[k0 + 4 * i + kk]; }
#pragma unroll
      for (int i = 0; i < 16; ++i) { u32x2 w; w.x = pk2(v[i][0], v[i][1]); w.y = pk2(v[i][2], v[i][3]); *(LAS u32x2*)(scr + (4 * i + kk) * 68 + n4) = w; } }
    LDS_WAIT(); asm volatile("" ::: "memory");
    const int c = lane & 7;
#pragma unroll
    for (int j = 0; j < 8; ++j) { const int nn = (lane >> 3) + 8 * j, n = n0 + nn; const LAS bf16* s = scr + (8 * c) * 68 + nn;
        u32x4 o;
#pragma unroll
        for (int q = 0; q < 4; ++q) o[q] = (unsigned)s[(2 * q) * 68] | ((unsigned)s[(2 * q + 1) * 68] << 16);
        if (n < N) *(u32x4*)(WT + (size_t)rm(n) * K + k0 + 8 * c) = o; }
    LDS_WAIT(); asm volatile("" ::: "memory");
}
constexpr int I_FIN = (DM / 64) * (2 * DFF / 64), I_FOUT = (DFF / 64) * (DM / 64), I_INE = (DM / 64) * (EVEN_IN / 64), I_SQ = (DM / 64) * (DM / 64), I_INO = (DM / 64) * ((ODD_IN + 63) / 64);
constexpr int IT_FIN = 0, IT_FOUT = 4 * I_FIN, IT_INE = IT_FOUT + 4 * I_FOUT, IT_OUTE = IT_INE + I_INE, IT_OUTO = IT_OUTE + I_SQ, IT_INO = IT_OUTO + I_SQ;
DI void convert_item(const Params& p, LAS float* scr, int it, int lane) {
    unsigned char* ws = p.ws;
    int r = it;
    if (r < 4 * I_FIN) { const int w = r / I_FIN, l = w >> 1, which = w & 1;
        transpose_item((const float*)p.in[which ? I_WF2I : I_WF1I] + (size_t)l * DM * 2 * DFF, DM, 2 * DFF, (bf16*)(ws + WS_WFIN) + (size_t)w * 2 * DFF * DM, RowSwiglu(), scr, r % I_FIN, lane, (const float*)p.in[which ? I_NF2 : I_NF1] + l * DM); return; }
    r -= 4 * I_FIN;
    if (r < 4 * I_FOUT) { const int w = r / I_FOUT, l = w >> 1, which = w & 1;
        transpose_item((const float*)p.in[which ? I_WF2O : I_WF1O] + (size_t)l * DFF * DM, DFF, DM, (bf16*)(ws + WS_WFOUT) + (size_t)w * DM * DFF, RowId(), scr, r % I_FOUT, lane); return; }
    r -= 4 * I_FOUT;
    if (r < I_INE) { transpose_item((const float*)p.in[I_WINE], DM, EVEN_IN, (bf16*)(ws + WS_WINE), RowId(), scr, r, lane, (const float*)p.in[I_NM]); return; }
    r -= I_INE;
    if (r < I_SQ) { transpose_item((const float*)p.in[I_WOUTE], DM, DM, (bf16*)(ws + WS_WOUTE), RowId(), scr, r, lane); return; }
    r -= I_SQ;
    if (r < I_SQ) { transpose_item((const float*)p.in[I_WOUTO], DM, DM, (bf16*)(ws + WS_WOUTO), RowId(), scr, r, lane); return; }
    r -= I_SQ;
    transpose_item((const float*)p.in[I_WINO], DM, ODD_IN, (bf16*)(ws + WS_WINO), RowId(), scr, r, lane, (const float*)p.in[I_NM] + DM);
}
constexpr int DEF_N = I_FIN + I_FOUT + I_SQ;
DI int defer_item(int v) { return v < I_FIN ? IT_FIN + 3 * I_FIN + v : v < I_FIN + I_FOUT ? IT_FOUT + 3 * I_FOUT + (v - I_FIN) : IT_OUTO + (v - I_FIN - I_FOUT); }
DI bool is_deferred(int it) { return (it >= IT_FIN + 1 * I_FIN && it < IT_FIN + 4 * I_FIN) || (it >= IT_FOUT + 1 * I_FOUT && it < IT_FOUT + 4 * I_FOUT) || (it >= IT_OUTE); }
constexpr int DEF3_A = I_FIN + I_FOUT + I_SQ, DEF3_N = DEF3_A + I_FIN + I_FOUT + I_INO;
DI int defer3_item(int v) { if (v < DEF3_A) return v < I_FIN ? IT_FIN + 1 * I_FIN + v : v < I_FIN + I_FOUT ? IT_FOUT + 1 * I_FOUT + (v - I_FIN) : IT_OUTE + (v - I_FIN - I_FOUT);
    v -= DEF3_A; return v < I_FIN ? IT_FIN + 2 * I_FIN + v : v < I_FIN + I_FOUT ? IT_FOUT + 2 * I_FOUT + (v - I_FIN) : IT_INO + (v - I_FIN - I_FOUT); }
DI void phase_prologue(const Params& p, LAS unsigned char* lds, int gw, int NGW, int wave, int lane) {
    LAS float* scr = (LAS float*)(lds + wave * 16384);
    constexpr int NITEMS = IT_INO + I_INO;
    for (int it = gw; it < NITEMS; it += NGW) if (!is_deferred(it)) convert_item(p, scr, it, lane);
    { u32x4* z = (u32x4*)((bf16*)(p.ws + WS_WINO) + (size_t)ODD_IN * DM); const int n16 = (ODD_PAD - ODD_IN) * DM * 2 / 16;
      for (int i = gw * 64 + lane; i < n16; i += NGW * 64) z[i] = (u32x4){0u, 0u, 0u, 0u}; }
}
DI void phase_input_rows(const float* src_p, const float* src_s, bf16* xb, float* ssq, int gw, int NGW, int lane) {
    for (int m = gw; m < MT; m += 2 * NGW) {
        const int m1 = m + NGW < MT ? m + NGW : m;
        const float* r0 = m < MP ? src_p + (size_t)m * DM : src_s + (size_t)(m - MP) * DM;
        const float* r1 = m1 < MP ? src_p + (size_t)m1 * DM : src_s + (size_t)(m1 - MP) * DM;
        const f32x4* x0 = (const f32x4*)r0 + lane; const f32x4* x1 = (const f32x4*)r1 + lane; f32x4 v[4], w[4]; float s = 0.f, t = 0.f;
#pragma unroll
        for (int j = 0; j < 4; ++j) { v[j] = x0[64 * j]; w[j] = x1[64 * j]; }
#pragma unroll
        for (int j = 0; j < 4; ++j) { s += (v[j].x * v[j].x + v[j].y * v[j].y) + (v[j].z * v[j].z + v[j].w * v[j].w); t += (w[j].x * w[j].x + w[j].y * w[j].y) + (w[j].z * w[j].z + w[j].w * w[j].w); }
        s = wave_sum(s); t = wave_sum(t);
        u32x2* o0 = (u32x2*)(xb + (size_t)m * DM) + lane; u32x2* o1 = (u32x2*)(xb + (size_t)m1 * DM) + lane;
#pragma unroll
        for (int j = 0; j < 4; ++j) { u32x2 a; a.x = pk2(v[j].x, v[j].y); a.y = pk2(v[j].z, v[j].w); o0[64 * j] = a; }
        if (m1 != m) {
#pragma unroll
            for (int j = 0; j < 4; ++j) { u32x2 a; a.x = pk2(w[j].x, w[j].y); a.y = pk2(w[j].z, w[j].w); o1[64 * j] = a; } }
        if (lane == 0) { ((unsigned*)ssq)[m] = (unsigned)(s * 1024.f + 0.5f); if (m1 != m) ((unsigned*)ssq)[m1] = (unsigned)(t * 1024.f + 0.5f); }
    }
}
constexpr int GS_LD = 72;
template <int ROWS> struct GsRegs { u32x4 a[ROWS / 64], b; };
template <int ROWS> DI void gs_load(GsRegs<ROWS>& R, const bf16* ap, const bf16* bp, int K, int kt) {
#pragma unroll
    for (int rep = 0; rep < ROWS / 64; ++rep) R.a[rep] = *(const u32x4*)(ap + (size_t)(64 * rep) * K + kt * 64);
    R.b = *(const u32x4*)(bp + kt * 64);
}
template <int ROWS> DI void gs_store(const GsRegs<ROWS>& R, LAS unsigned char* buf, int soff) {
#pragma unroll
    for (int rep = 0; rep < ROWS / 64; ++rep) *(LAS u32x4*)(buf + soff + rep * (64 * GS_LD * 2)) = R.a[rep];
    *(LAS u32x4*)(buf + ROWS * GS_LD * 2 + soff) = R.b;
}
template <int ROWS> DI void gs_compute(f32x16& acc0, f32x16& acc1, const LAS unsigned char* ab, int wave, int r, int h2) {
    const LAS unsigned char* bb = ab + ROWS * GS_LD * 2;
#pragma unroll
    for (int s = 0; s < 4; ++s) {
        const bf16x8 a = *(const LAS bf16x8*)(ab + ((32 * wave + r) * GS_LD + 16 * s + 8 * h2) * 2);
        const bf16x8 b0 = *(const LAS bf16x8*)(bb + (r * GS_LD + 16 * s + 8 * h2) * 2), b1 = *(const LAS bf16x8*)(bb + ((32 + r) * GS_LD + 16 * s + 8 * h2) * 2);
        acc0 = MFMA32(a, b0, acc0); acc1 = MFMA32(a, b1, acc1);
    }
}
template <int ROWS, class Epi> DI void gemm_small_unit(LAS unsigned char* lds, const bf16* A, const bf16* Bt, int K, int m0, int n0, int n1, const Epi& E, int tid_, int wave) {
    constexpr int BUF = (ROWS + 64) * GS_LD * 2;
    int tid = tid_; asm volatile("" : "+v"(tid));
    const int lane = tid & 63, r = lane & 31, h2 = lane >> 5;
    const int arow = tid >> 3, ck = tid & 7;
    const bf16* ap = A + (size_t)(m0 + arow) * K + ck * 8;
    const bf16* bp = Bt + (size_t)(arow < 32 ? n0 + arow : n1 + arow - 32) * K + ck * 8;
    const int soff = (arow * GS_LD + ck * 8) * 2;
    f32x16 acc0, acc1;
#pragma unroll
    for (int i = 0; i < 16; ++i) { acc0[i] = 0.f; acc1[i] = 0.f; }
    GsRegs<ROWS> R0, R1, R2, R3;
    gs_load<ROWS>(R0, ap, bp, K, 0); gs_load<ROWS>(R1, ap, bp, K, 1); gs_load<ROWS>(R2, ap, bp, K, 2); gs_load<ROWS>(R3, ap, bp, K, 3);
    gs_store<ROWS>(R0, lds, soff);
    __syncthreads();
    const int nkt = K >> 6;
#define GS_STEP(RF, RN, t) do { gs_load<ROWS>(RF, ap, bp, K, ((t) + 4 < nkt) ? (t) + 4 : nkt - 1); \
        if (wave < ROWS / 32) gs_compute<ROWS>(acc0, acc1, lds + ((t) & 1) * BUF, wave, r, h2); \
        gs_store<ROWS>(RN, lds + (((t) + 1) & 1) * BUF, soff); \
        __syncthreads(); } while (0)
#pragma unroll 1
    for (int kt = 0; kt < nkt; kt += 4) { GS_STEP(R0, R1, kt); GS_STEP(R1, R2, kt + 1); GS_STEP(R2, R3, kt + 2); GS_STEP(R3, R0, kt + 3); }
#undef GS_STEP
    if (wave < ROWS / 32) E(acc0, acc1, m0 + 32 * wave, n0, n1, r, h2);
}
struct SEpiSwiglu { bf16* H; int colbase; const float* ssq;
    DI void operator()(const f32x16& a0, const f32x16& a1, int row0, int, int, int r, int h2) const {
#pragma unroll
        for (int i = 0; i < 16; ++i) { const int row = row0 + (i & 3) + 8 * (i >> 2) + 4 * h2; const float rs = pg8::row_rstd(ssq, row); H[(size_t)row * DFF + colbase + r] = f2bf(fsilu(a0[i] * rs) * (a1[i] * rs)); } } };
template <bool BASE_F32, bool OUT_F32> struct SEpiResT { const void* base; void* out; float* ssq; float alpha;
    DI void operator()(const f32x16& a0, const f32x16& a1, int row0, int n0, int n1, int r, int h2) const {
#pragma unroll
        for (int i = 0; i < 16; ++i) { const int row = row0 + (i & 3) + 8 * (i >> 2) + 4 * h2; const size_t ol = (size_t)(row - MP) * DM, og = (size_t)row * DM;
            const float b0 = BASE_F32 ? ((const float*)base)[ol + n0 + r] : bf2f(((const bf16*)base)[og + n0 + r]), b1 = BASE_F32 ? ((const float*)base)[ol + n1 + r] : bf2f(((const bf16*)base)[og + n1 + r]);
            const float v0 = b0 + alpha * a0[i], v1 = b1 + alpha * a1[i];
            if (OUT_F32) { ((float*)out)[ol + n0 + r] = v0; ((float*)out)[ol + n1 + r] = v1; } else { ((bf16*)out)[og + n0 + r] = f2bf(v0); ((bf16*)out)[og + n1 + r] = f2bf(v1); }
            if (ssq) { float s = v0 * v0 + v1 * v1;
#pragma unroll
                for (int of = 1; of < 32; of <<= 1) s += __shfl_xor(s, of);
                if (r == 0) pg8::ssq_add(ssq, row, s); } } } };
struct SEpiProj { bf16* O; int ldc; const float* ssq;
    DI void operator()(const f32x16& a0, const f32x16& a1, int row0, int n0, int n1, int r, int h2) const {
#pragma unroll
        for (int i = 0; i < 16; ++i) { const int row = row0 + (i & 3) + 8 * (i >> 2) + 4 * h2; const float rs = pg8::row_rstd(ssq, row); const size_t o = (size_t)row * ldc; O[o + n0 + r] = f2bf(a0[i] * rs); O[o + n1 + r] = f2bf(a1[i] * rs); } } };
DI void qkv_row(const Params& p, const bf16* PROJ, int m, int lane, float* kout, float* vout, u32x4& vraw) {
    bf16* QB = (bf16*)(p.ws + WS_QB); bf16* KB = (bf16*)(p.ws + WS_KB);
    const bf16* pr = PROJ + (size_t)m * EVEN_IN;
    const u32x4 q8 = *(const u32x4*)(pr + 8 * lane), k8 = *(const u32x4*)(pr + SBW + 8 * lane), v8 = *(const u32x4*)(pr + 2 * SBW + 8 * lane);
    float q[8], k[8], v[8];
#pragma unroll
    for (int j = 0; j < 4; ++j) { q[2 * j] = bflo(q8[j]); q[2 * j + 1] = bfhi(q8[j]); k[2 * j] = bflo(k8[j]); k[2 * j + 1] = bfhi(k8[j]); v[2 * j] = bflo(v8[j]); v[2 * j + 1] = bfhi(v8[j]); }
    float sq = 0.f, sk = 0.f;
#pragma unroll
    for (int j = 0; j < 8; ++j) { sq += q[j] * q[j]; sk += k[j] * k[j]; }
#pragma unroll
    for (int o = 1; o < 8; o <<= 1) { sq += __shfl_xor(sq, o); sk += __shfl_xor(sk, o); }
    const float rq = frsq(sq * (1.f / SBD) + EPS) * (0.125f * LOG2E), rk = frsq(sk * (1.f / SBD) + EPS);
    const float* qg = (const float*)p.in[I_QG] + 8 * (lane & 7); const float* kg = (const float*)p.in[I_KG] + 8 * (lane & 7);
    const f32x4 qg0 = *(const f32x4*)qg, qg1 = *(const f32x4*)(qg + 4), kg0 = *(const f32x4*)kg, kg1 = *(const f32x4*)(kg + 4);
    float qn[8], kn[8];
#pragma unroll
    for (int j = 0; j < 4; ++j) { qn[j] = q[j] * rq * qg0[j]; qn[4 + j] = q[4 + j] * rq * qg1[j]; kn[j] = k[j] * rk * kg0[j]; kn[4 + j] = k[4 + j] * rk * kg1[j]; }
    u32x4 qo, ko;
#pragma unroll
    for (int j = 0; j < 4; ++j) { qo[j] = pk2(qn[2 * j], qn[2 * j + 1]); ko[j] = pk2(kn[2 * j], kn[2 * j + 1]); }
    *(u32x4*)(QB + (size_t)m * SBW + 8 * lane) = qo; *(u32x4*)(KB + (size_t)m * SBW + 8 * lane) = ko;
    *(f32x4*)(kout + 8 * lane) = (f32x4){kn[0], kn[1], kn[2], kn[3]}; *(f32x4*)(kout + 8 * lane + 4) = (f32x4){kn[4], kn[5], kn[6], kn[7]};
    *(f32x4*)(vout + 8 * lane) = (f32x4){v[0], v[1], v[2], v[3]}; *(f32x4*)(vout + 8 * lane + 4) = (f32x4){v[4], v[5], v[6], v[7]};
    vraw = v8;
}
DI void lru_ab(float r_pre, float i_pre, float xc, float sp_lam8, float& a, float& b) {
    const float rr = fsigmoid(r_pre), ii = fsigmoid(i_pre);
    const float log_a = -sp_lam8 * rr;
    a = fexp2(log_a * LOG2E);
    b = __builtin_amdgcn_sqrtf(fnegexpm1(2.0f * log_a)) * (ii * xc);
}
DI void phase_even_a(const Params& p, LAS unsigned char* lds, int tid, int lane_, int wave, int G) {
    unsigned char* ws = p.ws;
    const bf16* PROJ = (const bf16*)(ws + WS_PROJ);
    bf16* VT = (bf16*)(ws + WS_VT); bf16* VS = (bf16*)(ws + WS_VS); bf16* AO = (bf16*)(ws + WS_AO);
    bf16* HL = (bf16*)(ws + WS_HL); bf16* PP = (bf16*)(ws + WS_PP); float* AGG = (float*)(ws + WS_AGG);
    constexpr int VLD = SBW + 8;
    LAS bf16* vt = (LAS bf16*)lds;
    LAS float* xc = (LAS float*)lds;
    const int ch0 = tid, lane0 = lane_;
    const float* cw = (const float*)p.in[I_LCW];
    const float cw0 = cw[ch0], cw1 = cw[LRW + ch0], cw2 = cw[2 * LRW + ch0], cw3 = cw[3 * LRW + ch0], cb = ((const float*)p.in[I_LCB])[ch0];
    const float b_a = ((const float*)p.in[I_LBA])[ch0], b_i = ((const float*)p.in[I_LBI])[ch0];
    const float sp_lam8 = 8.0f * fsoftplus(-((const float*)p.in[I_LAM])[ch0]);
    f32x2 wa[32], wi[32];
    { const float* pa = (const float*)p.in[I_LWA] + (size_t)wave * 4096 + lane0; const float* pi = (const float*)p.in[I_LWI] + (size_t)wave * 4096 + lane0;
#pragma unroll
      for (int c = 0; c < 32; ++c) { wa[c].x = pa[(2 * c) * 64]; wa[c].y = pa[(2 * c + 1) * 64]; wi[c].x = pi[(2 * c) * 64]; wi[c].y = pi[(2 * c + 1) * 64]; } }
    for (int unit = blockIdx.x; unit < NB_P * 64 + NB_S; unit += G) {
        const bool smp = unit >= NB_P * 64;
        if (!smp) {
            const int b = unit >> 6, c = unit & 63, t0 = c * 64, m0 = b * T_P + t0;
            int tidv = tid; asm volatile("" : "+v"(tidv)); const int lane = tidv & 63, ch = tidv;
#pragma unroll 2
            for (int i = 0; i < 8; ++i) { const int tl = wave * 8 + i, m = m0 + tl; u32x4 vraw;
                qkv_row(p, PROJ, m, lane, p.out + O_KP + (size_t)m * SBW, p.out + O_VP + (size_t)m * SBW, vraw);
                *(LAS u32x4*)(vt + tl * VLD + 8 * lane) = vraw; }
            __syncthreads();
            { const int col = tidv; bf16* dst = VT + ((size_t)(b * SBH) * SBD + col) * T_P + t0;
#pragma unroll
              for (int j = 0; j < 8; ++j) { unsigned w[4];
#pragma unroll
                  for (int i = 0; i < 4; ++i) w[i] = (unsigned)vt[(8 * j + 2 * i) * VLD + col] | ((unsigned)vt[(8 * j + 2 * i + 1) * VLD + col] << 16);
                  *(u32x4*)(dst + 8 * j) = (u32x4){w[0], w[1], w[2], w[3]}; } }
            __syncthreads();
            float x0 = 0.f, x1 = 0.f, x2 = 0.f;
            if (c > 0) { x0 = bf2f(PROJ[(size_t)(m0 - 3) * EVEN_IN + 3 * SBW + ch]); x1 = bf2f(PROJ[(size_t)(m0 - 2) * EVEN_IN + 3 * SBW + ch]); x2 = bf2f(PROJ[(size_t)(m0 - 1) * EVEN_IN + 3 * SBW + ch]); }
#pragma unroll 1
            for (int tb = 0; tb < 64; tb += 16) {
                bf16 xr[16];
#pragma unroll
                for (int t = 0; t < 16; ++t) xr[t] = PROJ[(size_t)(m0 + tb + t) * EVEN_IN + 3 * SBW + ch];
#pragma unroll
                for (int t = 0; t < 16; ++t) { const float x3 = bf2f(xr[t]); xc[(tb + t) * LRW + ch] = cb + cw0 * x0 + cw1 * x1 + cw2 * x2 + cw3 * x3; x0 = x1; x1 = x2; x2 = x3; } }
            if (c == 63) { float* o = p.out + O_LCP + (size_t)b * 3 * LRW + ch; o[0] = x0; o[LRW] = x1; o[2 * LRW] = x2; }
            __syncthreads();
            float h = 0.f, P = 1.f;
#pragma unroll 1
            for (int t = 0; t < 64; ++t) {
                const LAS f32x4* xr4 = (const LAS f32x4*)(xc + t * LRW + wave * 64);
                f32x2 ra = {b_a, 0.f}, rb = {0.f, 0.f}, ia = {b_i, 0.f}, ib = {0.f, 0.f};
#pragma unroll
                for (int c4 = 0; c4 < 16; ++c4) { const f32x4 x = xr4[c4];
                    const f32x2 xl = {x[0], x[1]}, xh = {x[2], x[3]};
                    ra = __builtin_elementwise_fma(xl, wa[2 * c4], ra); rb = __builtin_elementwise_fma(xh, wa[2 * c4 + 1], rb);
                    ia = __builtin_elementwise_fma(xl, wi[2 * c4], ia); ib = __builtin_elementwise_fma(xh, wi[2 * c4 + 1], ib);
                    if ((c4 & 3) == 3) asm volatile("" ::: "memory"); }
                float a, bb; lru_ab((ra.x + ra.y) + (rb.x + rb.y), (ia.x + ia.y) + (ib.x + ib.y), xc[t * LRW + ch], sp_lam8, a, bb);
                h = a * h + bb; P *= a;
                HL[(size_t)(m0 + t) * LRW + ch] = f2bf(h); PP[(size_t)(m0 + t) * LRW + ch] = f2bf(P);
            }
            AGG[((size_t)(b * 64 + c) * 2 + 0) * LRW + ch] = P; AGG[((size_t)(b * 64 + c) * 2 + 1) * LRW + ch] = h;
            __syncthreads();
        } else {
            const int s = unit - NB_P * 64, m0 = MP + 4 * s;
            int chs = tid; asm volatile("" : "+v"(chs)); const int lane = chs & 63;
            if (wave < 4) { const int m = m0 + wave; u32x4 vraw;
                qkv_row(p, PROJ, m, lane, p.out + O_KS + (size_t)(4 * s + wave) * SBW, p.out + O_VS + (size_t)(4 * s + wave) * SBW, vraw);
                *(u32x4*)(VS + (size_t)(4 * s + wave) * SBW + 8 * lane) = vraw; }
            const float* st = (const float*)p.in[I_SLC] + (size_t)s * 3 * LRW + chs;
            float xp[7]; xp[0] = st[0]; xp[1] = st[LRW]; xp[2] = st[2 * LRW];
#pragma unroll
            for (int t = 0; t < 4; ++t) xp[3 + t] = bf2f(PROJ[(size_t)(m0 + t) * EVEN_IN + 3 * SBW + chs]);
#pragma unroll
            for (int t = 0; t < 4; ++t) xc[t * LRW + chs] = cb + cw0 * xp[t] + cw1 * xp[t + 1] + cw2 * xp[t + 2] + cw3 * xp[t + 3];
            { float* o = p.out + O_LCS + (size_t)s * 3 * LRW + chs; o[0] = xp[4]; o[LRW] = xp[5]; o[2 * LRW] = xp[6]; }
            __syncthreads();
            float h = ((const float*)p.in[I_SLH])[(size_t)s * LRW + chs];
#pragma unroll 1
            for (int t = 0; t < 4; ++t) {
                const LAS f32x4* xr4 = (const LAS f32x4*)(xc + t * LRW + wave * 64);
                f32x2 ra = {b_a, 0.f}, rb = {0.f, 0.f}, ia = {b_i, 0.f}, ib = {0.f, 0.f};
#pragma unroll
                for (int c4 = 0; c4 < 16; ++c4) { const f32x4 x = xr4[c4];
                    const f32x2 xl = {x[0], x[1]}, xh = {x[2], x[3]};
                    ra = __builtin_elementwise_fma(xl, wa[2 * c4], ra); rb = __builtin_elementwise_fma(xh, wa[2 * c4 + 1], rb);
                    ia = __builtin_elementwise_fma(xl, wi[2 * c4], ia); ib = __builtin_elementwise_fma(xh, wi[2 * c4 + 1], ib);
                    if ((c4 & 3) == 3) asm volatile("" ::: "memory"); }
                float a, bb; lru_ab((ra.x + ra.y) + (rb.x + rb.y), (ia.x + ia.y) + (ib.x + ib.y), xc[t * LRW + chs], sp_lam8, a, bb);
                h = a * h + bb;
                const float xg = bf2f(PROJ[(size_t)(m0 + t) * EVEN_IN + 4 * SBW + chs]);
                AO[(size_t)(m0 + t) * DM + SBW + chs] = f2bf(h * fgelu_tanh(xg));
            }
            (p.out + O_LHS)[(size_t)s * LRW + chs] = h;
            __syncthreads();
        }
    }
}
DI unsigned queue_next(unsigned* head, volatile LAS unsigned* slot, int tid) {
    if (tid == 0) *slot = __hip_atomic_fetch_add(head, 1u, __ATOMIC_RELAXED, __HIP_MEMORY_SCOPE_AGENT);
    __syncthreads();
    const unsigned u = __builtin_amdgcn_readfirstlane(*slot);
    __syncthreads();
    return u;
}
template <int CTRL> DI float dppf(float x) { return __builtin_bit_cast(float, __builtin_amdgcn_mov_dpp(__builtin_bit_cast(int, x), CTRL, 0xf, 0xf, true)); }
struct SmpAcc { float carry; f32x4 acc[4]; };
struct SmpKV { f32x4 k[4], v[4]; };
DI void smp_key(SmpAcc& A, const f32x4 (&q)[4], const f32x4 K4, const f32x4 V4, float bias2, int c, bool masked) {
    const f32x2 Kl = __builtin_shufflevector(K4, K4, 0, 1), Kh = __builtin_shufflevector(K4, K4, 2, 3);
    f32x2 t0 = Kl * __builtin_shufflevector(q[0], q[0], 0, 1), t1 = Kl * __builtin_shufflevector(q[1], q[1], 0, 1), t2 = Kl * __builtin_shufflevector(q[2], q[2], 0, 1), t3 = Kl * __builtin_shufflevector(q[3], q[3], 0, 1);
    t0 = __builtin_elementwise_fma(Kh, __builtin_shufflevector(q[0], q[0], 2, 3), t0); t1 = __builtin_elementwise_fma(Kh, __builtin_shufflevector(q[1], q[1], 2, 3), t1);
    t2 = __builtin_elementwise_fma(Kh, __builtin_shufflevector(q[2], q[2], 2, 3), t2); t3 = __builtin_elementwise_fma(Kh, __builtin_shufflevector(q[3], q[3], 2, 3), t3);
    const float z0 = t0.x + t0.y, z1 = t1.x + t1.y, z2 = t2.x + t2.y, z3 = t3.x + t3.y;
    const bool b0 = c & 1, b1 = c & 2;
    const float y0 = (b0 ? z2 : z0) + dppf<0xB1>(b0 ? z0 : z2), y1 = (b0 ? z3 : z1) + dppf<0xB1>(b0 ? z1 : z3);
    float x = (b1 ? y1 : y0) + dppf<0x4E>(b1 ? y0 : y1);
    x += dppf<0x124>(x); x += dppf<0x128>(x);
    const float zz = fminf(x + bias2, 80.f), e = fexp2(zz); float kp = frcp(1.0f + e), sg = e * kp;
    if (masked) { kp = 1.f; sg = 0.f; }
    const float w = sg * A.carry;
    A.carry *= kp;
    const float w0 = dppf<0x00>(w), w1 = dppf<0xAA>(w), w2 = dppf<0x55>(w), w3 = dppf<0xFF>(w);
    A.acc[0] += V4 * w0; A.acc[1] += V4 * w1; A.acc[2] += V4 * w2; A.acc[3] += V4 * w3;
}
DI void smp_load(SmpKV& R, const float* ck, const float* cv, int phys, int pos0, int hg, int lane) {
    const size_t base = ((size_t)phys * PAGE + pos0) * SBW + hg * 256 + lane * 4;
#pragma unroll
    for (int u = 0; u < 4; ++u) { R.k[u] = __builtin_nontemporal_load((const f32x4*)(ck + base + (size_t)u * SBW)); R.v[u] = __builtin_nontemporal_load((const f32x4*)(cv + base + (size_t)u * SBW)); }
}
DI void attn_sample_unit(const Params& p, LAS unsigned char* lds, int lane_, int wave, int s, int half) {
    unsigned char* ws = p.ws;
    const bf16* QB = (const bf16*)(ws + WS_QB); const bf16* KB = (const bf16*)(ws + WS_KB); const bf16* VS = (const bf16*)(ws + WS_VS); bf16* AO = (bf16*)(ws + WS_AO);
    int lane = lane_; asm volatile("" : "+v"(lane));
    const int hg = wave & 1, seg = wave >> 1, hh = lane >> 4, c = lane & 15, h = 4 * hg + hh, qme = 2 * (c & 1) + ((c >> 1) & 1);
    const float bias2 = ((const float*)p.in[I_SBB])[h] * LOG2E;
    f32x4 q[4];
#pragma unroll
    for (int i = 0; i < 4; ++i) { const u32x2 w = *(const u32x2*)(QB + (size_t)(MP + 4 * s + i) * SBW + h * SBD + 4 * c); q[i] = (f32x4){bflo(w.x), bfhi(w.x), bflo(w.y), bfhi(w.y)}; }
    SmpAcc A; A.carry = 1.f;
#pragma unroll
    for (int i = 0; i < 4; ++i) A.acc[i] = (f32x4){0.f, 0.f, 0.f, 0.f};
    if (half && seg == 0) {
#pragma unroll
        for (int n = 3; n >= 0; --n) { const u32x2 kw = *(const u32x2*)(KB + (size_t)(MP + 4 * s + n) * SBW + h * SBD + 4 * c), vw = *(const u32x2*)(VS + (size_t)(4 * s + n) * SBW + h * SBD + 4 * c);
            smp_key(A, q, (f32x4){bflo(kw.x), bfhi(kw.x), bflo(kw.y), bfhi(kw.y)}, (f32x4){bflo(vw.x), bfhi(vw.x), bflo(vw.y), bfhi(vw.y)}, bias2, c, n >= qme); } }
    const float* ck = (const float*)p.in[I_CK]; const float* cv = (const float*)p.in[I_CV];
    typedef const __attribute__((address_space(4))) int* cint_p;
    cint_p pt = (cint_p)(unsigned long long)p.in[I_PT] + s * NPAGES + half * 8 + 6 - 2 * seg;
    SmpKV R0, R1, R2, R3;
#define SMP_LOAD(R, sidx) do { const int sn_ = (sidx) < 64 ? (sidx) : 63; const int ph_ = __builtin_amdgcn_readfirstlane(pt[1 - (sn_ >> 5)]); smp_load(R, ck, cv, ph_, 124 - 4 * (sn_ & 31), hg, lane); __builtin_amdgcn_sched_barrier(0); } while (0)
#define SMP_COMP(R) do { _Pragma("unroll") for (int u = 3; u >= 0; --u) smp_key(A, q, R.k[u], R.v[u], bias2, c, false); } while (0)
    SMP_LOAD(R0, 0); SMP_LOAD(R1, 1); SMP_LOAD(R2, 2);
#pragma unroll 1
    for (int st = 0; st < 64; st += 4) {
        SMP_LOAD(R3, st + 3); SMP_COMP(R0);
        SMP_LOAD(R0, st + 4); SMP_COMP(R1);
        SMP_LOAD(R1, st + 5); SMP_COMP(R2);
        SMP_LOAD(R2, st + 6); SMP_COMP(R3);
    }
#undef SMP_LOAD
#undef SMP_COMP
    const float P[4] = {dppf<0x00>(A.carry), dppf<0xAA>(A.carry), dppf<0x55>(A.carry), dppf<0xFF>(A.carry)};
    LAS float* xo = (LAS float*)lds;
    LAS float* xp = (LAS float*)(lds + 32768);
#pragma unroll
    for (int i = 0; i < 4; ++i) *(LAS f32x4*)(xo + ((wave * 4 + i) * 64 + lane) * 4) = A.acc[i];
    *(LAS f32x4*)(xp + (wave * 64 + lane) * 4) = (f32x4){P[0], P[1], P[2], P[3]};
    __syncthreads();
    if (seg == 0) {
        f32x4 o[4]; f32x4 pt_ = {1.f, 1.f, 1.f, 1.f};
#pragma unroll
        for (int i = 0; i < 4; ++i) o[i] = (f32x4){0.f, 0.f, 0.f, 0.f};
#pragma unroll
        for (int sg_ = 3; sg_ >= 0; --sg_) { const int wv = 2 * sg_ + hg; const f32x4 ps = *(const LAS f32x4*)(xp + (wv * 64 + lane) * 4);
#pragma unroll
            for (int i = 0; i < 4; ++i) o[i] = *(const LAS f32x4*)(xo + ((wv * 4 + i) * 64 + lane) * 4) + o[i] * ps[i];
            pt_ = pt_ * ps; }
        float* rec = (float*)(ws + WS_SPART) + (size_t)((s * 2 + hg) * 2 + half) * 1280;
#pragma unroll
        for (int i = 0; i < 4; ++i) *(f32x4*)(rec + (i * 64 + lane) * 4) = o[i];
        *(f32x4*)(rec + 1024 + lane * 4) = pt_;
        asm volatile("s_waitcnt vmcnt(0)" ::: "memory");
        __threadfence();
        asm volatile("s_waitcnt vmcnt(0)" ::: "memory");
        unsigned old = 0;
        if (lane == 0) old = __hip_atomic_fetch_add((unsigned*)(ws + WS_CTL) + CW_SMPCNT + s * 2 + hg, 1u, __ATOMIC_RELAXED, __HIP_MEMORY_SCOPE_AGENT);
        old = __builtin_amdgcn_readfirstlane(old);
        if (old == 1u) {
            __threadfence();
            asm volatile("s_waitcnt vmcnt(0)" ::: "memory");
            const float* orec = (const float*)(ws + WS_SPART) + (size_t)((s * 2 + hg) * 2 + (half ^ 1)) * 1280;
            const f32x4 Po = *(const f32x4*)(orec + 1024 + lane * 4);
#pragma unroll
            for (int i = 0; i < 4; ++i) { const f32x4 oo = *(const f32x4*)(orec + (i * 64 + lane) * 4);
                const f32x4 r = half ? o[i] + oo * pt_[i] : oo + o[i] * Po[i];
                u32x2 w; w.x = pk2(r[0], r[1]); w.y = pk2(r[2], r[3]); *(u32x2*)(AO + (size_t)(MP + 4 * s + i) * DM + h * SBD + 4 * c) = w; }
        }
    }
    __syncthreads();
}
DI void lru_fix_unit(const Params& p, int tid, int b, int c) {
    unsigned char* ws = p.ws;
    const bf16* PROJ = (const bf16*)(ws + WS_PROJ); const bf16* HL = (const bf16*)(ws + WS_HL); const bf16* PP = (const bf16*)(ws + WS_PP); const float* AGG = (const float*)(ws + WS_AGG); bf16* AO = (bf16*)(ws + WS_AO);
    int ch = tid; asm volatile("" : "+v"(ch));
    float carry = 0.f;
#pragma unroll 1
    for (int c0 = 0; c0 < c; c0 += 16) { float P[16], hh[16];
#pragma unroll
        for (int j = 0; j < 16; ++j) { const int cc = c0 + j < c ? c0 + j : c - 1; P[j] = AGG[((size_t)(b * 64 + cc) * 2 + 0) * LRW + ch]; hh[j] = AGG[((size_t)(b * 64 + cc) * 2 + 1) * LRW + ch]; }
#pragma unroll
        for (int j = 0; j < 16; ++j) if (c0 + j < c) carry = P[j] * carry + hh[j]; }
    const int m0 = b * T_P + c * 64; float hlast = 0.f;
#pragma unroll 1
    for (int t0 = 0; t0 < 64; t0 += 16) { bf16 hl[16], pp[16], xg[16];
#pragma unroll
        for (int j = 0; j < 16; ++j) { const size_t m = m0 + t0 + j; hl[j] = HL[m * LRW + ch]; pp[j] = PP[m * LRW + ch]; xg[j] = PROJ[m * EVEN_IN + 4 * SBW + ch]; }
#pragma unroll
        for (int j = 0; j < 16; ++j) { const size_t m = m0 + t0 + j; const float hv = bf2f(hl[j]) + bf2f(pp[j]) * carry; hlast = hv; AO[m * DM + SBW + ch] = f2bf(hv * fgelu_tanh(bf2f(xg[j]))); } }
    if (c == 63) (p.out + O_LHP)[(size_t)b * LRW + ch] = hlast;
}
DI void prompt_tile(const LAS unsigned char* kc, const LAS unsigned char* vc, const bf16x8 (&qf)[4], f32x16 (&accO)[2], float& carry, float bias2, int key0, int Q0, int r, int h2) {
    constexpr int KLD = 72, VLD = 68;
    if (key0 < Q0 + 31) {
        f32x16 sk[2];
#pragma unroll
        for (int kb = 0; kb < 2; ++kb) {
#pragma unroll
            for (int i = 0; i < 16; ++i) sk[kb][i] = bias2;
#pragma unroll
            for (int s = 0; s < 4; ++s) { const bf16x8 a = *(const LAS bf16x8*)(kc + (32 * kb + r) * (KLD * 2) + (16 * s + 8 * h2) * 2); sk[kb] = MFMA32(a, qf[s], sk[kb]); }
        }
        const bool need_mask = key0 + 63 >= Q0;
        f32x2 kp[2][8];
#pragma unroll
        for (int kb = 0; kb < 2; ++kb)
#pragma unroll
            for (int pq = 0; pq < 8; ++pq) {
                f32x2 e2; e2.x = fexp2(sk[kb][2 * pq]); e2.y = fexp2(sk[kb][2 * pq + 1]);
                const f32x2 d2 = e2 + 1.0f;
                f32x2 k2; k2.x = frcp(d2.x); k2.y = frcp(d2.y);
                kp[kb][pq] = k2;
            }
        if (need_mask) {
            asm volatile("" ::: "memory");
            const int lim = Q0 + r - key0 - 4 * h2;
#pragma unroll
            for (int kb = 0; kb < 2; ++kb)
#pragma unroll
                for (int pq = 0; pq < 8; ++pq) { const int ko = 32 * kb + ((2 * pq) & 3) + 8 * ((2 * pq) >> 2); if (ko >= lim) kp[kb][pq].x = 1.f; if (ko + 1 >= lim) kp[kb][pq].y = 1.f; }
        }
        float R[2][4], Rp[2][4];
#pragma unroll
        for (int kb = 0; kb < 2; ++kb)
#pragma unroll
            for (int q = 0; q < 4; ++q) { const f32x2 pr = kp[kb][2 * q] * kp[kb][2 * q + 1]; R[kb][q] = pr.x * pr.y; Rp[kb][q] = __shfl_xor(R[kb][q], 32); }
        float c = carry;
#pragma unroll
        for (int kb = 1; kb >= 0; --kb)
#pragma unroll
            for (int q = 3; q >= 0; --q) {
                const float E3 = c * (h2 ? 1.0f : Rp[kb][q]);
                c *= R[kb][q] * Rp[kb][q];
                const f32x2 ka = kp[kb][2 * q], kc = kp[kb][2 * q + 1];
                const float E2 = E3 * kc.y, E1 = E2 * kc.x, E0 = E1 * ka.y;
                const f32x2 w01 = (1.0f - ka) * (f32x2){E0, E1}, w23 = (1.0f - kc) * (f32x2){E2, E3};
                sk[kb][4 * q] = w01.x; sk[kb][4 * q + 1] = w01.y; sk[kb][4 * q + 2] = w23.x; sk[kb][4 * q + 3] = w23.y;
            }
        carry = c;
#pragma unroll
        for (int kb = 0; kb < 2; ++kb)
#pragma unroll
            for (int s = 0; s < 2; ++s) {
                u32x4 wp;
#pragma unroll
                for (int j = 0; j < 4; ++j) wp[j] = pk2(sk[kb][8 * s + 2 * j], sk[kb][8 * s + 2 * j + 1]);
                const bf16x8 wf = __builtin_bit_cast(bf16x8, wp);
#pragma unroll
                for (int db = 0; db < 2; ++db) {
                    const LAS unsigned char* va = vc + (32 * db + r) * (VLD * 2) + (32 * kb + 16 * s + 4 * h2) * 2;
                    const u32x2 lo = *(const LAS u32x2*)va, hi = *(const LAS u32x2*)(va + 16);
                    const bf16x8 vf = __builtin_bit_cast(bf16x8, (u32x4){lo.x, lo.y, hi.x, hi.y});
                    accO[db] = MFMA32(vf, wf, accO[db]);
                }
            }
    }
}
DI void sample_finish(const Params& p, LAS float* xo, LAS float* xp, const SmpAcc& A, int s, int half, int wave, int hg, int seg, int lane, int h, int c) {
    unsigned char* ws = p.ws; bf16* AO = (bf16*)(ws + WS_AO);
    const float P[4] = {dppf<0x00>(A.carry), dppf<0xAA>(A.carry), dppf<0x55>(A.carry), dppf<0xFF>(A.carry)};
#pragma unroll
    for (int i = 0; i < 4; ++i) *(LAS f32x4*)(xo + ((wave * 4 + i) * 64 + lane) * 4) = A.acc[i];
    *(LAS f32x4*)(xp + (wave * 64 + lane) * 4) = (f32x4){P[0], P[1], P[2], P[3]};
    __syncthreads();
    if (seg == 0) {
        f32x4 o[4]; f32x4 pt_ = {1.f, 1.f, 1.f, 1.f};
#pragma unroll
        for (int i = 0; i < 4; ++i) o[i] = (f32x4){0.f, 0.f, 0.f, 0.f};
#pragma unroll
        for (int sg_ = 3; sg_ >= 0; --sg_) { const int wv = 2 * sg_ + hg; const f32x4 ps = *(const LAS f32x4*)(xp + (wv * 64 + lane) * 4);
#pragma unroll
            for (int i = 0; i < 4; ++i) o[i] = *(const LAS f32x4*)(xo + ((wv * 4 + i) * 64 + lane) * 4) + o[i] * ps[i];
            pt_ = pt_ * ps; }
        float* rec = (float*)(ws + WS_SPART) + (size_t)((s * 2 + hg) * 2 + half) * 1280;
#pragma unroll
        for (int i = 0; i < 4; ++i) *(f32x4*)(rec + (i * 64 + lane) * 4) = o[i];
        *(f32x4*)(rec + 1024 + lane * 4) = pt_;
        asm volatile("s_waitcnt vmcnt(0)" ::: "memory");
        __threadfence();
        asm volatile("s_waitcnt vmcnt(0)" ::: "memory");
        unsigned old = 0;
        if (lane == 0) old = __hip_atomic_fetch_add((unsigned*)(ws + WS_CTL) + CW_SMPCNT + s * 2 + hg, 1u, __ATOMIC_RELAXED, __HIP_MEMORY_SCOPE_AGENT);
        old = __builtin_amdgcn_readfirstlane(old);
        if (old == 1u) {
            __threadfence();
            asm volatile("s_waitcnt vmcnt(0)" ::: "memory");
            const float* orec = (const float*)(ws + WS_SPART) + (size_t)((s * 2 + hg) * 2 + (half ^ 1)) * 1280;
            const f32x4 Po = *(const f32x4*)(orec + 1024 + lane * 4);
#pragma unroll
            for (int i = 0; i < 4; ++i) { const f32x4 oo = *(const f32x4*)(orec + (i * 64 + lane) * 4);
                const f32x4 rr = half ? o[i] + oo * pt_[i] : oo + o[i] * Po[i];
                u32x2 w; w.x = pk2(rr[0], rr[1]); w.y = pk2(rr[2], rr[3]); *(u32x2*)(AO + (size_t)(MP + 4 * s + i) * DM + h * SBD + 4 * c) = w; }
        }
    }
}
DI void phase_even_b(const Params& p, LAS unsigned char* lds, int tid_, int lane_, int wave, int G, int qsel = 0) {
    unsigned char* ws = p.ws;
    unsigned* headP = (unsigned*)(ws + WS_CTL) + CW_QUEUE + 64 * qsel; unsigned* headS = headP + 32;
    volatile LAS unsigned* slot = (volatile LAS unsigned*)(lds + LDSCTL_OFF + 128);
    const bf16* QB = (const bf16*)(ws + WS_QB); const bf16* KB = (const bf16*)(ws + WS_KB); const bf16* VT = (const bf16*)(ws + WS_VT); const bf16* VS = (const bf16*)(ws + WS_VS); bf16* AO = (bf16*)(ws + WS_AO);
    const float* ck = (const float*)p.in[I_CK]; const float* cv = (const float*)p.in[I_CV];
    typedef const __attribute__((address_space(4))) int* cint_p;
    constexpr unsigned N_ATT = NB_P * SBH * 16, N_FIX = NB_P * 64, N_PQ = N_ATT + N_FIX, N_SQ = 2 * NB_S;
    constexpr int KLD = 72, VLD = 68, KBUF = 64 * KLD * 2, VBUF = 64 * VLD * 2;
    LAS unsigned char* kl = lds; LAS unsigned char* vl = lds + 2 * KBUF;
    LAS float* xo = (LAS float*)(lds + 36864); LAS float* xp = (LAS float*)(lds + 36864 + 32768);
    int tid = tid_; asm volatile("" : "+v"(tid));
    const int lane = tid & 63, r = lane & 31, h2 = lane >> 5;
    bool pAct = false, pEmpty = (p.mode == 1); int pb = 0, ph = 0, Q0 = 0, kt = 0, cur = 0;
    bf16x8 qf[4]; f32x16 accO[2]; float pcarry = 1.f, pbias2 = 0.f; u32x4 kr0, vr0, kr1, vr1;
    const int srow = tid >> 3, sch = tid & 7, kdst = srow * (KLD * 2) + sch * 16, vdst = srow * (VLD * 2) + sch * 16;
    const bf16* ksrc = KB; const bf16* vsrc = VT;
    bool sAct = false, sEmpty = (p.mode == 2); int ss = 0, shalf = 0, st = 0;
    const int hg = wave & 1, seg = wave >> 1, hh = lane >> 4, c = lane & 15, sh = 4 * hg + hh, qme = 2 * (c & 1) + ((c >> 1) & 1);
    const float sbias2 = ((const float*)p.in[I_SBB])[sh] * LOG2E;
    LAS f32x4* sq = (LAS f32x4*)(lds + 36864 + 40960) + wave * 256 + lane;
    SmpAcc A; SmpKV R0, R1; cint_p spt = (cint_p)(unsigned long long)p.in[I_PT];
#pragma unroll
    for (int i = 0; i < 4; ++i) { qf[i] = (bf16x8){0, 0, 0, 0, 0, 0, 0, 0}; A.acc[i] = (f32x4){0.f, 0.f, 0.f, 0.f}; }
    A.carry = 1.f;
#pragma unroll
    for (int i = 0; i < 16; ++i) { accO[0][i] = 0.f; accO[1][i] = 0.f; }
    kr0 = (u32x4){0u, 0u, 0u, 0u}; vr0 = kr0; kr1 = kr0; vr1 = kr0;
#pragma unroll
    for (int u = 0; u < 4; ++u) { R0.k[u] = (f32x4){0.f, 0.f, 0.f, 0.f}; R0.v[u] = R0.k[u]; R1.k[u] = R0.k[u]; R1.v[u] = R0.k[u]; }
#define SMP_LOAD(R, sidx) do { const int sn_ = (sidx) < 64 ? (sidx) : 63; const int ph_ = __builtin_amdgcn_readfirstlane(spt[1 - (sn_ >> 5)]); smp_load(R, ck, cv, ph_, 124 - 4 * (sn_ & 31), hg, lane); __builtin_amdgcn_sched_barrier(0); } while (0)
#define EB_ITER(SA, SB, PKA, PVA, PKB, PVB) { \
    bool fresh = false; \
    if (!pAct && !pEmpty) { \
        for (;;) { const unsigned u = queue_next(headP, slot, tid); \
            if (u >= N_PQ) { pEmpty = true; break; } \
            if (u >= N_ATT) { lru_fix_unit(p, tid, (int)((u - N_ATT) >> 6), (int)((u - N_ATT) & 63)); continue; } \
            const int qb = 15 - (int)(u >> 5), bh = (int)(u & 31); pb = bh >> 3; ph = bh & 7; Q0 = qb * 256 + wave * 32; kt = 4 * qb + 3; cur = 0; pcarry = 1.f; \
            pbias2 = ((const float*)p.in[I_SBB])[ph] * LOG2E; \
            { const bf16* qp = QB + (size_t)(pb * T_P + Q0 + r) * SBW + ph * SBD + 8 * h2; _Pragma("unroll") for (int s_ = 0; s_ < 4; ++s_) qf[s_] = *(const bf16x8*)(qp + 16 * s_); } \
            _Pragma("unroll") for (int i = 0; i < 16; ++i) { accO[0][i] = 0.f; accO[1][i] = 0.f; } \
            ksrc = KB + (size_t)(pb * T_P + srow) * SBW + ph * SBD + sch * 8; vsrc = VT + ((size_t)(pb * SBH + ph) * SBD + srow) * T_P + sch * 8; \
            PKA = *(const u32x4*)(ksrc + (size_t)(64 * kt) * SBW); PVA = *(const u32x4*)(vsrc + 64 * kt); \
            { const int k1 = kt > 0 ? kt - 1 : 0; PKB = *(const u32x4*)(ksrc + (size_t)(64 * k1) * SBW); PVB = *(const u32x4*)(vsrc + 64 * k1); } \
            *(LAS u32x4*)(kl + kdst) = PKA; *(LAS u32x2*)(vl + vdst) = (u32x2){PVA.x, PVA.y}; *(LAS u32x2*)(vl + vdst + 8) = (u32x2){PVA.z, PVA.w}; \
            pAct = true; fresh = true; break; } } \
    if (!sAct && !sEmpty) { const unsigned u = queue_next(headS, slot, tid); \
        if (u >= N_SQ) sEmpty = true; \
        else { ss = (int)(u >> 1); shalf = (int)(u & 1); st = 0; sAct = true; A.carry = 1.f; \
            f32x4 q[4]; \
            _Pragma("unroll") for (int i = 0; i < 4; ++i) { A.acc[i] = (f32x4){0.f, 0.f, 0.f, 0.f}; const u32x2 w = *(const u32x2*)(QB + (size_t)(MP + 4 * ss + i) * SBW + sh * SBD + 4 * c); q[i] = (f32x4){bflo(w.x), bfhi(w.x), bflo(w.y), bfhi(w.y)}; sq[64 * i] = q[i]; } \
            spt = (cint_p)(unsigned long long)p.in[I_PT] + ss * NPAGES + shalf * 8 + 6 - 2 * seg; \
            SMP_LOAD(SA, 0); SMP_LOAD(SB, 1); \
            if (shalf && seg == 0) { _Pragma("unroll") for (int n = 3; n >= 0; --n) { const u32x2 kw = *(const u32x2*)(KB + (size_t)(MP + 4 * ss + n) * SBW + sh * SBD + 4 * c), vw = *(const u32x2*)(VS + (size_t)(4 * ss + n) * SBW + sh * SBD + 4 * c); \
                smp_key(A, q, (f32x4){bflo(kw.x), bfhi(kw.x), bflo(kw.y), bfhi(kw.y)}, (f32x4){bflo(vw.x), bfhi(vw.x), bflo(vw.y), bfhi(vw.y)}, sbias2, c, n >= qme); } } } } \
    if (!pAct && !sAct) break; \
    if (fresh) __syncthreads(); \
      \
    { const int k2 = kt > 1 ? kt - 2 : 0; PKA = *(const u32x4*)(ksrc + (size_t)(64 * k2) * SBW); PVA = *(const u32x4*)(vsrc + 64 * k2); __builtin_amdgcn_sched_barrier(0); } \
    if (pAct) { \
        prompt_tile(kl + cur * KBUF, vl + cur * VBUF, qf, accO, pcarry, pbias2, 64 * kt, Q0, r, h2); \
        if (kt > 0) { LAS unsigned char* kn = kl + (cur ^ 1) * KBUF; LAS unsigned char* vn = vl + (cur ^ 1) * VBUF; \
            *(LAS u32x4*)(kn + kdst) = PKB; *(LAS u32x2*)(vn + vdst) = (u32x2){PVB.x, PVB.y}; *(LAS u32x2*)(vn + vdst + 8) = (u32x2){PVB.z, PVB.w}; } } \
    if (sAct) { f32x4 q[4]; _Pragma("unroll") for (int i = 0; i < 4; ++i) q[i] = sq[64 * i]; \
        _Pragma("unroll") for (int u = 3; u >= 0; --u) smp_key(A, q, SA.k[u], SA.v[u], sbias2, c, false); } \
    SMP_LOAD(SA, st + 2); \
    __syncthreads(); \
    if (pAct) { cur ^= 1; if (--kt < 0) { pAct = false; \
            bf16* orow = AO + (size_t)(pb * T_P + Q0 + r) * DM + ph * SBD; \
            _Pragma("unroll") for (int db = 0; db < 2; ++db) _Pragma("unroll") for (int g = 0; g < 4; ++g) { u32x2 w; w.x = pk2(accO[db][4 * g], accO[db][4 * g + 1]); w.y = pk2(accO[db][4 * g + 2], accO[db][4 * g + 3]); \
                *(u32x2*)(orow + 32 * db + 8 * g + 4 * h2) = w; } } } \
    if (sAct && ++st == 64) { sAct = false; sample_finish(p, xo, xp, A, ss, shalf, wave, hg, seg, lane, sh, c); } }
    for (;;) { EB_ITER(R0, R1, kr0, vr0, kr1, vr1) EB_ITER(R1, R0, kr1, vr1, kr0, vr0) }
#undef EB_ITER
#undef SMP_LOAD
    if (p.mode == 0) { unsigned* headC = headP + 16; LAS float* scr = (LAS float*)(lds + wave * 16384);
      for (;;) { const unsigned bt = queue_next(headC, slot, tid); if (bt * 8 >= (unsigned)DEF3_N) break;
          const int v = (int)bt * 8 + wave; if (v < DEF3_N) convert_item(p, scr, defer3_item(v), lane); } }
}
constexpr int OA_QL = 0, OA_KL = 17408, OA_VL = 34816, OA_KBT = 52224, OA_VBT = 70656, OA_AL = 89088, OA_TL = 106496, OA_G = 115712, OA_BETA = 115968, OA_GRAW = 116224;
constexpr int QLD = 136, TLD = 72, ALD = 68;
constexpr int OA_RAW = OA_KBT, RAWLD = 384, OA_CW = 116480;
DI void oa_dma(const bf16* PROJ, const bf16* zeros, LAS unsigned char* rawb, int unit, int tid, int wave) {
    const int h = unit & 7, c = (unit >> 3) & 63, b = unit >> 9, m0 = b * T_P + c * 64;
#pragma unroll
    for (int rep = 0; rep < 7; ++rep) { const int id = tid + 512 * rep, row = id / 48, sg = id - row * 48, tn = sg >> 4, ck = sg & 15;
        const bool valid = id < 67 * 48 && !(c == 0 && row < 3);
        const bf16* src = valid ? PROJ + (size_t)(m0 - 3 + row) * ODD_PAD + tn * DNW + h * DND + ck * 8 : zeros + (tid & 63) * 8;
        __builtin_amdgcn_global_load_lds((const unsigned*)src, (LAS unsigned*)(rawb + (512 * rep + 64 * wave) * 16), 16, 0, 0); }
}
DI void oa_conv8(const LAS bf16* raw, const LAS float* cwl, int tl, int tn, int ch0, float (&y)[8]) {
    float acc[8];
#pragma unroll
    for (int j = 0; j < 8; ++j) acc[j] = 0.f;
#pragma unroll
    for (int i = 0; i < 4; ++i) {
        const u32x4 x = *(const LAS u32x4*)(raw + (tl + i) * RAWLD + tn * DND + ch0);
        const f32x4 w0 = *(const LAS f32x4*)(cwl + (tn * 4 + i) * DND + ch0), w1 = *(const LAS f32x4*)(cwl + (tn * 4 + i) * DND + ch0 + 4);
        acc[0] += w0[0] * bflo(x.x); acc[1] += w0[1] * bfhi(x.x); acc[2] += w0[2] * bflo(x.y); acc[3] += w0[3] * bfhi(x.y);
        acc[4] += w1[0] * bflo(x.z); acc[5] += w1[1] * bfhi(x.z); acc[6] += w1[2] * bflo(x.w); acc[7] += w1[3] * bfhi(x.w);
    }
#pragma unroll
    for (int j = 0; j < 8; ++j) y[j] = fsilu(acc[j]);
}
DI int perm16c(int k) { return (k & ~12) | ((k & 4) << 1) | ((k & 8) >> 1); }
DI void dn_conv8(const bf16* PROJ, const float* cw, int m, int t_in_seq, int chan, float (&y)[8]) {
    float acc[8];
#pragma unroll
    for (int j = 0; j < 8; ++j) acc[j] = 0.f;
#pragma unroll
    for (int i = 0; i < 4; ++i) {
        if (t_in_seq - 3 + i >= 0) {
            const u32x4 x = *(const u32x4*)(PROJ + (size_t)(m - 3 + i) * ODD_PAD + chan);
            const f32x4 w0 = *(const f32x4*)(cw + i * 3 * DNW + chan), w1 = *(const f32x4*)(cw + i * 3 * DNW + chan + 4);
            acc[0] += w0[0] * bflo(x.x); acc[1] += w0[1] * bfhi(x.x); acc[2] += w0[2] * bflo(x.y); acc[3] += w0[3] * bfhi(x.y);
            acc[4] += w1[0] * bflo(x.z); acc[5] += w1[1] * bfhi(x.z); acc[6] += w1[2] * bflo(x.w); acc[7] += w1[3] * bfhi(x.w);
        }
    }
#pragma unroll
    for (int j = 0; j < 8; ++j) y[j] = fsilu(acc[j]);
}
constexpr int OB2_QL = 0, OB2_KL = 17408, OB2_AL = 34816, OB2_KGT = 52224, OB2_KBT = 70656, OB2_VBT = 89088, OB2_TL = 107520  , OB2_CW = 124928, OB2_GB = 132096  , OB2_LOG = 140288;
DI void phase_odd_a(const Params& p, LAS unsigned char* lds, int tid, int lane_, int wave, int G) {
    unsigned char* ws = p.ws;
    const bf16* PROJ = (const bf16*)(ws + WS_PROJ);
    bf16* UV = (bf16*)(ws + WS_UV); bf16* WK = (bf16*)(ws + WS_WK); bf16* QG = (bf16*)(ws + WS_QG); bf16* KGT = (bf16*)(ws + WS_KGT); bf16* PM = (bf16*)(ws + WS_PM); float* GL = (float*)(ws + WS_GL);
    const float* cw = (const float*)p.in[I_DCW];
    LAS bf16* Ql = (LAS bf16*)(lds + OB2_QL); LAS bf16* Kl = (LAS bf16*)(lds + OB2_KL); LAS float* Al = (LAS float*)(lds + OB2_AL);
    LAS bf16* KgTl = (LAS bf16*)(lds + OB2_KGT); LAS bf16* KbT = (LAS bf16*)(lds + OB2_KBT); LAS bf16* VbT = (LAS bf16*)(lds + OB2_VBT); LAS bf16* Tl = (LAS bf16*)(lds + OB2_TL);
    LAS float* Gw = (LAS float*)(lds + OB2_GB) + wave * 256;
    LAS bf16* Vl = (LAS bf16*)(lds + OB2_TL);
    LAS float* cwl = (LAS float*)(lds + OB2_CW); LAS unsigned* lograw = (LAS unsigned*)(lds + OB2_LOG);
    LAS bf16* raw = (LAS bf16*)(lds + OB2_QL);
    LAS bf16* TT = (LAS bf16*)(lds + OB2_LOG + 512);
    int curh = -1;
    const bf16* zeros = (const bf16*)(ws + WS_WINO) + (size_t)ODD_IN * DM;
    const float negA_all = 0.f; (void)negA_all;
    for (int unit = (int)blockIdx.x - G; unit < NB_P * 64 * DNH; unit += G) {
        int tidv = tid; asm volatile("" : "+v"(tidv));
        const int lane = tidv & 63, r = lane & 31, h2 = lane >> 5, tl = tidv >> 3, part = tidv & 7;
        const bool real = unit >= 0, more = unit + G < NB_P * 64 * DNH;
        const int h = unit & 7, c = (unit >> 3) & 63, b = unit >> 9;
        if (real) {
            const int t0 = c * 64, m0 = b * T_P + t0, m = m0 + tl;
            if (h != curh) { curh = h;
#pragma unroll
                for (int rep = 0; rep < 3; ++rep) { const int id = tidv + 512 * rep, tn = id >> 9, i = (id >> 7) & 3, d = id & 127; cwl[id] = cw[i * 3 * DNW + tn * DNW + h * DND + d]; }
                __syncthreads(); }
            { const float bl = bf2f((bf16)lograw[2 * lane]), al = bf2f((bf16)lograw[2 * lane + 1]);
              float x = -__expf(((const float*)p.in[I_DAL])[h]) * fsoftplus(al + ((const float*)p.in[I_DDT])[h]);
#pragma unroll
              for (int o = 1; o < 64; o <<= 1) { const float y = __shfl_up(x, o); if (lane >= o) x += y; }
              const float be = fsigmoid(bl), glast = __shfl(x, 63);
              Gw[lane] = x; Gw[64 + lane] = be; Gw[128 + lane] = be * __expf(x); Gw[192 + lane] = __expf(glast - x); }
            float qv[16], kv[16], vv[16];
            { float y[8];
              oa_conv8(raw, cwl, tl, 0, part * 16, y);
#pragma unroll
              for (int j = 0; j < 8; ++j) qv[j] = y[j];
              oa_conv8(raw, cwl, tl, 0, part * 16 + 8, y);
#pragma unroll
              for (int j = 0; j < 8; ++j) qv[8 + j] = y[j];
              oa_conv8(raw, cwl, tl, 1, part * 16, y);
#pragma unroll
              for (int j = 0; j < 8; ++j) kv[j] = y[j];
              oa_conv8(raw, cwl, tl, 1, part * 16 + 8, y);
#pragma unroll
              for (int j = 0; j < 8; ++j) kv[8 + j] = y[j];
              oa_conv8(raw, cwl, tl, 2, part * 16, y);
#pragma unroll
              for (int j = 0; j < 8; ++j) vv[j] = y[j];
              oa_conv8(raw, cwl, tl, 2, part * 16 + 8, y);
#pragma unroll
              for (int j = 0; j < 8; ++j) vv[8 + j] = y[j]; }
            float sq = 0.f, sk = 0.f;
#pragma unroll
            for (int j = 0; j < 16; ++j) { sq += qv[j] * qv[j]; sk += kv[j] * kv[j]; }
#pragma unroll
            for (int o = 1; o < 8; o <<= 1) { sq += __shfl_xor(sq, o); sk += __shfl_xor(sk, o); }
            const float rq = frsq(sq + EPS) * 0.08838834764831845f, rk = frsq(sk + EPS);
#pragma unroll
            for (int j = 0; j < 16; ++j) { qv[j] *= rq; kv[j] *= rk; }
            if (c == 63 && tl >= 61) {
                float* o = p.out + O_DCP + (size_t)(b * 3 + (tl - 61)) * 3 * DNW;
#pragma unroll
                for (int tn = 0; tn < 3; ++tn)
#pragma unroll
                    for (int j = 0; j < 16; ++j) { const int chan = tn * DNW + h * DND + part * 16 + j; o[chan] = bf2f(PROJ[(size_t)m * ODD_PAD + chan]); }
            }
            const float Gt = Gw[tl], Glast = Gw[63], bt = Gw[64 + tl];
            __syncthreads();
            { u32x4 w0, w1;
#pragma unroll
              for (int j = 0; j < 4; ++j) { w0[j] = pk2(qv[2 * j], qv[2 * j + 1]); w1[j] = pk2(qv[8 + 2 * j], qv[8 + 2 * j + 1]); }
              *(LAS u32x4*)(Ql + tl * QLD + part * 16) = w0; *(LAS u32x4*)(Ql + tl * QLD + part * 16 + 8) = w1;
#pragma unroll
              for (int j = 0; j < 4; ++j) { w0[j] = pk2(kv[2 * j], kv[2 * j + 1]); w1[j] = pk2(kv[8 + 2 * j], kv[8 + 2 * j + 1]); }
              *(LAS u32x4*)(Kl + tl * QLD + part * 16) = w0; *(LAS u32x4*)(Kl + tl * QLD + part * 16 + 8) = w1;
#pragma unroll
              for (int j = 0; j < 4; ++j) { w0[j] = pk2(vv[2 * j], vv[2 * j + 1]); w1[j] = pk2(vv[8 + 2 * j], vv[8 + 2 * j + 1]); }
              *(LAS u32x4*)(Vl + tl * QLD + part * 16) = w0; *(LAS u32x4*)(Vl + tl * QLD + part * 16 + 8) = w1; }
            { const float eg = __expf(Gt);
              u32x4 w0, w1;
              w0[0] = pk2(qv[0] * eg, qv[1] * eg); w0[1] = pk2(qv[2] * eg, qv[3] * eg); w0[2] = pk2(qv[8] * eg, qv[9] * eg); w0[3] = pk2(qv[10] * eg, qv[11] * eg);
              w1[0] = pk2(qv[4] * eg, qv[5] * eg); w1[1] = pk2(qv[6] * eg, qv[7] * eg); w1[2] = pk2(qv[12] * eg, qv[13] * eg); w1[3] = pk2(qv[14] * eg, qv[15] * eg);
              bf16* qg = QG + (size_t)unit * 8192 + tl * DND + part * 16; *(u32x4*)qg = w0; *(u32x4*)(qg + 8) = w1; }
            if (tidv == 0) GL[unit] = __expf(Glast);
            __syncthreads();
            { const int d = tidv & 127, q16 = tidv >> 7;
              float kq[16], vq[16];
#pragma unroll
              for (int i = 0; i < 16; ++i) { kq[i] = bf2f(Kl[(16 * q16 + i) * QLD + d]); vq[i] = bf2f(Vl[(16 * q16 + i) * QLD + d]); }
              float skk[16], sbt[16], sek[16];
#pragma unroll
              for (int i4 = 0; i4 < 4; ++i4) { const f32x4 a = *(const LAS f32x4*)(Gw + 128 + 16 * q16 + 4 * i4), bq = *(const LAS f32x4*)(Gw + 64 + 16 * q16 + 4 * i4), e4 = *(const LAS f32x4*)(Gw + 192 + 16 * q16 + 4 * i4);
#pragma unroll
                  for (int j = 0; j < 4; ++j) { skk[4 * i4 + j] = a[j]; sbt[4 * i4 + j] = bq[j]; sek[4 * i4 + j] = e4[j]; } }
              u32x4 w0, w1;
#pragma unroll
              for (int j = 0; j < 4; ++j) { w0[j] = pk2(kq[2 * j] * skk[2 * j], kq[2 * j + 1] * skk[2 * j + 1]); w1[j] = pk2(kq[8 + 2 * j] * skk[8 + 2 * j], kq[9 + 2 * j] * skk[9 + 2 * j]); }
              *(LAS u32x4*)(KbT + d * TLD + 16 * q16) = w0; *(LAS u32x4*)(KbT + d * TLD + 16 * q16 + 8) = w1;
#pragma unroll
              for (int j = 0; j < 4; ++j) { w0[j] = pk2(vq[2 * j] * sbt[2 * j], vq[2 * j + 1] * sbt[2 * j + 1]); w1[j] = pk2(vq[8 + 2 * j] * sbt[8 + 2 * j], vq[9 + 2 * j] * sbt[9 + 2 * j]); }
              *(LAS u32x4*)(VbT + d * TLD + 16 * q16) = w0; *(LAS u32x4*)(VbT + d * TLD + 16 * q16 + 8) = w1;
              w0[0] = pk2(kq[0] * sek[0], kq[1] * sek[1]); w0[1] = pk2(kq[2] * sek[2], kq[3] * sek[3]); w0[2] = pk2(kq[8] * sek[8], kq[9] * sek[9]); w0[3] = pk2(kq[10] * sek[10], kq[11] * sek[11]);
              w1[0] = pk2(kq[4] * sek[4], kq[5] * sek[5]); w1[1] = pk2(kq[6] * sek[6], kq[7] * sek[7]); w1[2] = pk2(kq[12] * sek[12], kq[13] * sek[13]); w1[3] = pk2(kq[14] * sek[14], kq[15] * sek[15]);
              *(LAS u32x4*)(KgTl + d * TLD + 16 * q16) = w0; *(LAS u32x4*)(KgTl + d * TLD + 16 * q16 + 8) = w1; }
            { const int ti = (wave >> 1) & 1, tj = wave & 1; const bool isP = wave >= 4;
              const LAS bf16* Asrc = isP ? Ql : Kl;
              f32x16 acc;
#pragma unroll
              for (int i = 0; i < 16; ++i) acc[i] = 0.f;
#pragma unroll
              for (int s = 0; s < 8; ++s) { const bf16x8 a = *(const LAS bf16x8*)(Asrc + (32 * ti + r) * QLD + 16 * s + 8 * h2), bb = *(const LAS bf16x8*)(Kl + (32 * tj + r) * QLD + 16 * s + 8 * h2); acc = MFMA32(a, bb, acc); }
              const int j = 32 * tj + r; const float Gj = Gw[j];
#pragma unroll
              for (int i = 0; i < 16; ++i) { const int row = 32 * ti + (i & 3) + 8 * (i >> 2) + 4 * h2; const float Gi = Gw[row];
                  if (isP) { const float v = row >= j ? acc[i] * __expf(Gi - Gj) : 0.f; PM[(size_t)unit * 4096 + row * 64 + perm16c(j)] = f2bf(v); }
                  else { const float v = row > j ? acc[i] * __expf(Gi - Gj) * Gw[64 + row] : 0.f; Al[row * ALD + j] = v; } } }
            __syncthreads();
            if (wave < 2) {
                const int j = lane & 31, kh = lane >> 5, o = 32 * wave;
                f32x2 R[8];
#pragma unroll
                for (int m = 0; m < 8; ++m) R[m] = (f32x2){0.f, 0.f};
                const LAS float* abase = Al + o * ALD + o + 2 * kh;
#pragma unroll
                for (int i = 0; i < 32; ++i) {
                    f32x2 acc = {0.f, 0.f};
#pragma unroll
                    for (int m = 0; m < (i + 3) / 4; ++m) acc = __builtin_elementwise_fma(*(const LAS f32x2*)(abase + i * ALD + 4 * m), R[m], acc);
                    const float part = acc.x + acc.y;
                    const auto sw = __builtin_amdgcn_permlane32_swap(__float_as_uint(part), __float_as_uint(part), false, false);
                    const float t = ((j == i) ? 1.f : 0.f) - (__uint_as_float(sw[0]) + __uint_as_float(sw[1]));
                    if (kh == ((i >> 1) & 1)) { if (i & 1) R[i >> 2].y = t; else R[i >> 2].x = t; }
                    if (kh == 0) Tl[(o + i) * TLD + o + j] = f2bf(t);
                }
                if (wave == 0) {
#pragma unroll
                    for (int m = 0; m < 8; ++m) *(LAS unsigned*)(TT + j * 40 + 4 * m + 2 * kh) = pk2(R[m].x, R[m].y); }
            } else if (wave == 2) {
                const u32x4 z = {0u, 0u, 0u, 0u};
                *(LAS u32x4*)(Tl + (lane >> 1) * TLD + 32 + (lane & 1) * 16) = z; *(LAS u32x4*)(Tl + (lane >> 1) * TLD + 32 + (lane & 1) * 16 + 8) = z;
            } else {
#pragma unroll
                for (int rep = 0; rep < 4; ++rep) { const int id = (tidv - 192) + 320 * rep;
                    if (id < 1024) { const int row = id >> 3, chk = id & 7; *(u32x4*)(KGT + (size_t)unit * 8192 + row * 64 + chk * 8) = *(const LAS u32x4*)(KgTl + row * TLD + chk * 8); } }
            }
            __syncthreads();
            if (wave == 0) {
                f32x16 X;
#pragma unroll
                for (int i = 0; i < 16; ++i) X[i] = 0.f;
#pragma unroll
                for (int s2 = 0; s2 < 2; ++s2) { const LAS float* ap = Al + (32 + r) * ALD + 16 * s2 + 8 * h2; const f32x4 a0 = *(const LAS f32x4*)ap, a1 = *(const LAS f32x4*)(ap + 4);
                    u32x4 aw; aw[0] = pk2(a0[0], a0[1]); aw[1] = pk2(a0[2], a0[3]); aw[2] = pk2(a1[0], a1[1]); aw[3] = pk2(a1[2], a1[3]);
                    const bf16x8 bfr = *(const LAS bf16x8*)(TT + r * 40 + 16 * s2 + 8 * h2);
                    X = MFMA32(__builtin_bit_cast(bf16x8, aw), bfr, X); }
                f32x16 Y;
#pragma unroll
                for (int i = 0; i < 16; ++i) Y[i] = 0.f;
#pragma unroll
                for (int s2 = 0; s2 < 2; ++s2) { u32x4 xw;
#pragma unroll
                    for (int q = 0; q < 4; ++q) xw[q] = pk2(X[8 * s2 + 2 * q], X[8 * s2 + 2 * q + 1]);
                    const LAS bf16* tp = Tl + (32 + r) * TLD + 32 + 16 * s2 + 4 * h2; const u32x2 lo = *(const LAS u32x2*)tp, hi = *(const LAS u32x2*)(tp + 8);
                    Y = MFMA32(__builtin_bit_cast(bf16x8, (u32x4){lo.x, lo.y, hi.x, hi.y}), __builtin_bit_cast(bf16x8, xw), Y); }
#pragma unroll
                for (int i = 0; i < 16; ++i) Tl[(32 + (i & 3) + 8 * (i >> 2) + 4 * h2) * TLD + r] = f2bf(-Y[i]);
            }
            __syncthreads();
        }
        if (more) {
            oa_dma(PROJ, zeros, lds + OB2_QL, unit + G, tidv, wave);
            if (part == 0) { const int un = unit + G; const bf16* pr = PROJ + (size_t)((un >> 9) * T_P + ((un >> 3) & 63) * 64 + tl) * ODD_PAD + 4 * DNW + (un & 7); lograw[2 * tl] = pr[0]; lograw[2 * tl + 1] = pr[DNH]; } }
        if (real) {
#pragma unroll
            for (int rep = 0; rep < 2; ++rep) {
                const int id = wave + 8 * rep, which = id >> 3, ti = (id >> 2) & 1, tj = id & 3;
                const LAS bf16* Bsrc = which ? KbT : VbT;
                f32x16 acc;
#pragma unroll
                for (int i = 0; i < 16; ++i) acc[i] = 0.f;
#pragma unroll
                for (int s = 0; s < 4; ++s) { const bf16x8 a = *(const LAS bf16x8*)(Tl + (32 * ti + r) * TLD + 16 * s + 8 * h2), bb = *(const LAS bf16x8*)(Bsrc + (32 * tj + r) * TLD + 16 * s + 8 * h2); acc = MFMA32(a, bb, acc); }
                if (which) { bf16* dst = WK + (size_t)unit * 8192; const int colp = perm16c(32 * tj + r);
#pragma unroll
                    for (int i = 0; i < 16; ++i) { const int row = 32 * ti + (i & 3) + 8 * (i >> 2) + 4 * h2; dst[row * DND + colp] = f2bf(acc[i]); } }
                else { u32x4 w0, w1;
#pragma unroll
                    for (int j = 0; j < 4; ++j) { w0[j] = pk2(acc[2 * j], acc[2 * j + 1]); w1[j] = pk2(acc[8 + 2 * j], acc[8 + 2 * j + 1]); }
                    bf16* dst = UV + (size_t)unit * 8192 + (size_t)(((tj * 2 + ti) * 64) + lane) * 16; *(u32x4*)dst = w0; *(u32x4*)(dst + 8) = w1; }
            }
        }
        asm volatile("s_waitcnt vmcnt(0)" ::: "memory");
        __syncthreads();
    }
}
constexpr int OB_WK = 0, OB_QG = 17408, OB_KGT = 34816, OB_PM = 53248, OB_BUF = 62464;
DI bf16x8 pack8(const f32x16& x, int s) {
    u32x4 w;
#pragma unroll
    for (int j = 0; j < 4; ++j) w[j] = pk2(x[8 * s + 2 * j], x[8 * s + 2 * j + 1]);
    return __builtin_bit_cast(bf16x8, w);
}
#define CH_BARRIER() do { asm volatile("s_waitcnt lgkmcnt(0)" ::: "memory"); __builtin_amdgcn_s_barrier(); asm volatile("" ::: "memory"); } while (0)
struct ChainRegs { u32x4 wk[4], qg[4], kg[4], pm[2]; };
DI void chain_load(ChainRegs& R, const bf16* WK, const bf16* QG, const bf16* KGT, const bf16* PM, size_t u, int lt) {
#pragma unroll
    for (int rep = 0; rep < 4; ++rep) { const int id = lt + 256 * rep;
        R.wk[rep] = *(const u32x4*)(WK + u * 8192 + id * 8); R.qg[rep] = *(const u32x4*)(QG + u * 8192 + id * 8); R.kg[rep] = *(const u32x4*)(KGT + u * 8192 + id * 8); }
#pragma unroll
    for (int rep = 0; rep < 2; ++rep) R.pm[rep] = *(const u32x4*)(PM + u * 4096 + (lt + 256 * rep) * 8);
}
DI void chain_store(const ChainRegs& R, LAS unsigned char* buf, int lt) {
#pragma unroll
    for (int rep = 0; rep < 4; ++rep) { const int id = lt + 256 * rep;
        *(LAS u32x4*)(buf + OB_WK + ((id >> 4) * QLD + (id & 15) * 8) * 2) = R.wk[rep]; *(LAS u32x4*)(buf + OB_QG + ((id >> 4) * QLD + (id & 15) * 8) * 2) = R.qg[rep];
        *(LAS u32x4*)(buf + OB_KGT + ((id >> 3) * TLD + (id & 7) * 8) * 2) = R.kg[rep]; }
#pragma unroll
    for (int rep = 0; rep < 2; ++rep) { const int id = lt + 256 * rep; *(LAS u32x4*)(buf + OB_PM + ((id >> 3) * TLD + (id & 7) * 8) * 2) = R.pm[rep]; }
}
DI void chain_step(f32x16 (&Sacc)[4], u32x4 (&uv)[4], const LAS unsigned char* buf, float gl, const bf16* uv_next, bf16* oraw, int r, int h2) {
    const LAS bf16* WKl = (const LAS bf16*)(buf + OB_WK) + r * QLD + 8 * h2; const LAS bf16* QGl = (const LAS bf16*)(buf + OB_QG) + r * QLD + 8 * h2;
    const LAS bf16* KGTl = (const LAS bf16*)(buf + OB_KGT) + r * TLD + 8 * h2; const LAS bf16* PMl = (const LAS bf16*)(buf + OB_PM) + r * TLD + 8 * h2;
#define FR(base, ld, rowblk, kk) (*(const LAS bf16x8*)((base) + (32 * (rowblk)) * (ld) + 16 * (kk)))
    f32x16 U[2], accO[2];
#pragma unroll
    for (int ti = 0; ti < 2; ++ti)
#pragma unroll
        for (int i = 0; i < 16; ++i) { U[ti][i] = 0.f; accO[ti][i] = 0.f; }
    bf16x8 fw[2][2], fq[2][2];
    fw[0][0] = FR(WKl, QLD, 0, 0); fw[0][1] = FR(WKl, QLD, 1, 0); fq[0][0] = FR(QGl, QLD, 0, 0); fq[0][1] = FR(QGl, QLD, 1, 0);
#pragma unroll
    for (int kk = 0; kk < 8; ++kk) { const int cb = kk & 1, nb = cb ^ 1;
        if (kk < 7) { fw[nb][0] = FR(WKl, QLD, 0, kk + 1); fw[nb][1] = FR(WKl, QLD, 1, kk + 1); fq[nb][0] = FR(QGl, QLD, 0, kk + 1); fq[nb][1] = FR(QGl, QLD, 1, kk + 1); }
        const bf16x8 sf = pack8(Sacc[kk >> 1], kk & 1);
        __builtin_amdgcn_sched_barrier(0);
        U[0] = MFMA32(fw[cb][0], sf, U[0]); U[1] = MFMA32(fw[cb][1], sf, U[1]); accO[0] = MFMA32(fq[cb][0], sf, accO[0]); accO[1] = MFMA32(fq[cb][1], sf, accO[1]);
        __builtin_amdgcn_sched_barrier(0); }
    bf16x8 fk[2][4];
#pragma unroll
    for (int d = 0; d < 2; ++d)
#pragma unroll
        for (int k2 = 0; k2 < 4; ++k2) fk[d][k2] = FR(KGTl, TLD, d, k2);
    __builtin_amdgcn_sched_barrier(0);
#pragma unroll
    for (int ti = 0; ti < 2; ++ti)
#pragma unroll
        for (int j = 0; j < 8; ++j) { const unsigned w = uv[2 * ti + (j >> 2)][j & 3]; U[ti][2 * j] = bflo(w) - U[ti][2 * j]; U[ti][2 * j + 1] = bfhi(w) - U[ti][2 * j + 1]; }
    if (uv_next) {
#pragma unroll
        for (int q = 0; q < 4; ++q) uv[q] = *(const u32x4*)(uv_next + (size_t)((q >> 1) * 64) * 16 + (q & 1) * 8); }
    bf16x8 Uf[4];
#pragma unroll
    for (int k2 = 0; k2 < 4; ++k2) Uf[k2] = pack8(U[k2 >> 1], k2 & 1);
    bf16x8 fp[4];
#pragma unroll
    for (int k2 = 0; k2 < 4; ++k2) fp[k2] = FR(PMl, TLD, 0, k2);
    __builtin_amdgcn_sched_barrier(0);
#pragma unroll
    for (int d = 0; d < 2; ++d) {
#pragma unroll
        for (int i = 0; i < 16; ++i) Sacc[d][i] *= gl;
#pragma unroll
        for (int k2 = 0; k2 < 4; ++k2) Sacc[d] = MFMA32(fk[d][k2], Uf[k2], Sacc[d]); }
#pragma unroll
    for (int d = 0; d < 2; ++d)
#pragma unroll
        for (int k2 = 0; k2 < 4; ++k2) fk[d][k2] = FR(KGTl, TLD, 2 + d, k2);
    __builtin_amdgcn_sched_barrier(0);
#pragma unroll
    for (int k2 = 0; k2 < 4; ++k2) accO[0] = MFMA32(fp[k2], Uf[k2], accO[0]);
#pragma unroll
    for (int k2 = 0; k2 < 4; ++k2) fp[k2] = FR(PMl, TLD, 1, k2);
    __builtin_amdgcn_sched_barrier(0);
#pragma unroll
    for (int d = 0; d < 2; ++d) {
#pragma unroll
        for (int i = 0; i < 16; ++i) Sacc[2 + d][i] *= gl;
#pragma unroll
        for (int k2 = 0; k2 < 4; ++k2) Sacc[2 + d] = MFMA32(fk[d][k2], Uf[k2], Sacc[2 + d]); }
#pragma unroll
    for (int k2 = 0; k2 < 4; ++k2) accO[1] = MFMA32(fp[k2], Uf[k2], accO[1]);
#pragma unroll
    for (int ti = 0; ti < 2; ++ti) { u32x4 w0, w1;
#pragma unroll
        for (int j = 0; j < 4; ++j) { w0[j] = pk2(accO[ti][2 * j], accO[ti][2 * j + 1]); w1[j] = pk2(accO[ti][8 + 2 * j], accO[ti][8 + 2 * j + 1]); }
        *(u32x4*)(oraw + (size_t)(ti * 64) * 16) = w0; *(u32x4*)(oraw + (size_t)(ti * 64) * 16 + 8) = w1; }
#undef FR
}
DI void dn_chain_unit(const Params& p, LAS unsigned char* lds, int tid_, int wave, int b, int h, int half) {
    unsigned char* ws = p.ws;
    const bf16* UV = (const bf16*)(ws + WS_UV); const bf16* WK = (const bf16*)(ws + WS_WK); const bf16* QG = (const bf16*)(ws + WS_QG); const bf16* KGT = (const bf16*)(ws + WS_KGT); const bf16* PM = (const bf16*)(ws + WS_PM);
    const float* GL = (const float*)(ws + WS_GL); bf16* OR = (bf16*)(ws + WS_OR);
    int tid = tid_; asm volatile("" : "+v"(tid));
    const size_t ub = (size_t)(b * 64) * 8 + h;
    if (wave >= 4) {
        const int lt = tid - 256;
        ChainRegs R0, R1, R2;
#define CH_CHUNK(i) (ub + 8 * ((i) < 64 ? (i) : 63))
#define CH_LSTEP(n_, RL, RS) do { chain_load(RL, WK, QG, KGT, PM, CH_CHUNK((n_) + 3), lt); chain_store(RS, lds + (((n_) + 1) & 1) * OB_BUF, lt); CH_BARRIER(); } while (0)
        chain_load(R0, WK, QG, KGT, PM, CH_CHUNK(0), lt); chain_load(R1, WK, QG, KGT, PM, CH_CHUNK(1), lt); chain_load(R2, WK, QG, KGT, PM, CH_CHUNK(2), lt);
        chain_store(R0, lds, lt);
        CH_BARRIER();
#pragma unroll 1
        for (int n = 0; n < 63; n += 3) { CH_LSTEP(n, R0, R1); CH_LSTEP(n + 1, R1, R2); CH_LSTEP(n + 2, R2, R0); }
        CH_LSTEP(63, R0, R1);
#undef CH_LSTEP
#undef CH_CHUNK
    } else if (wave >= 2) {
        for (int n = 0; n < 65; ++n) CH_BARRIER();
    } else {
        const int lane = tid & 63, r = lane & 31, h2 = lane >> 5, w = 2 * half + wave;
        f32x16 Sacc[4];
#pragma unroll
        for (int d = 0; d < 4; ++d)
#pragma unroll
            for (int i = 0; i < 16; ++i) Sacc[d][i] = 0.f;
        const size_t lofs = (size_t)((w * 2) * 64 + lane) * 16;
        u32x4 uv[4];
#pragma unroll
        for (int q = 0; q < 4; ++q) uv[q] = *(const u32x4*)(UV + ub * 8192 + lofs + (size_t)((q >> 1) * 64) * 16 + (q & 1) * 8);
        float gl = GL[ub];
        CH_BARRIER();
#pragma unroll 1
        for (int n = 0; n < 64; n += 2) {
            const float gl1 = GL[ub + 8 * (n + 1)];
            chain_step(Sacc, uv, lds, gl, UV + (ub + 8 * (n + 1)) * 8192 + lofs, OR + (ub + 8 * n) * 8192 + lofs, r, h2);
            CH_BARRIER();
            gl = (n + 2 < 64) ? GL[ub + 8 * (n + 2)] : 0.f;
            chain_step(Sacc, uv, lds + OB_BUF, gl1, (n + 2 < 64) ? UV + (ub + 8 * (n + 2)) * 8192 + lofs : (const bf16*)nullptr, OR + (ub + 8 * (n + 1)) * 8192 + lofs, r, h2);
            CH_BARRIER();
        }
        float* so = p.out + O_DSP + (size_t)((b * DNH + h) * DND) * DND;
#pragma unroll
        for (int d = 0; d < 4; ++d)
#pragma unroll
            for (int i = 0; i < 16; ++i) so[(size_t)(32 * d + (i & 3) + 8 * (i >> 2) + 4 * h2) * DND + 32 * w + r] = Sacc[d][i];
    }
    __syncthreads();
}
DI void dn_sample_unit(const Params& p, LAS unsigned char* lds, int tid_, int wave, int s, int h) {
    unsigned char* ws = p.ws;
    const bf16* PROJ = (const bf16*)(ws + WS_PROJ); bf16* AO = (bf16*)(ws + WS_AO);
    LAS float* qkvl = (LAS float*)lds;
    LAS float* red = (LAS float*)(lds + 6144);
    LAS float* red2 = (LAS float*)(lds + 8192);
    LAS float* ol = (LAS float*)(lds + 10240);
    int tid = tid_; asm volatile("" : "+v"(tid));
    const int lane = tid & 63;
    const float* cw = (const float*)p.in[I_DCW];
    if (tid < 384) {
        const int chan = (tid >> 7) * DNW + h * DND + (tid & 127);
        float xp[7];
#pragma unroll
        for (int i = 0; i < 3; ++i) xp[i] = ((const float*)p.in[I_SDC])[(size_t)(s * 3 + i) * 3 * DNW + chan];
#pragma unroll
        for (int t = 0; t < 4; ++t) xp[3 + t] = bf2f(PROJ[(size_t)(MP + 4 * s + t) * ODD_PAD + chan]);
        const float w0 = cw[chan], w1 = cw[3 * DNW + chan], w2 = cw[2 * 3 * DNW + chan], w3 = cw[3 * 3 * DNW + chan];
#pragma unroll
        for (int t = 0; t < 4; ++t) qkvl[t * 384 + tid] = fsilu(w0 * xp[t] + w1 * xp[t + 1] + w2 * xp[t + 2] + w3 * xp[t + 3]);
#pragma unroll
        for (int i = 0; i < 3; ++i) (p.out + O_DCS)[(size_t)(s * 3 + i) * 3 * DNW + chan] = xp[4 + i];
    }
    __syncthreads();
    { const int t = wave >> 1, tn = wave & 1; LAS float* v = qkvl + t * 384 + tn * 128;
      const float a = v[lane], bq = v[lane + 64]; const float sc = frsq(wave_sum(a * a + bq * bq) + EPS) * (tn == 0 ? 0.08838834764831845f : 1.0f);
      v[lane] = a * sc; v[lane + 64] = bq * sc; }
    __syncthreads();
    const int e = tid & 127, qd = tid >> 7;
    float S[32];
    const float* s0 = (const float*)p.in[I_SDS] + ((size_t)(s * DNH + h) * DND + 32 * qd) * DND + e;
#pragma unroll
    for (int j = 0; j < 32; ++j) S[j] = s0[(size_t)j * DND];
    const float negA = -__expf(((const float*)p.in[I_DAL])[h]), dtb = ((const float*)p.in[I_DDT])[h];
#pragma unroll 1
    for (int t = 0; t < 4; ++t) {
        const size_t m = MP + 4 * s + t;
        const float beta = fsigmoid(bf2f(PROJ[m * ODD_PAD + 4 * DNW + h])), dec = __expf(negA * fsoftplus(bf2f(PROJ[m * ODD_PAD + 4 * DNW + DNH + h]) + dtb));
        const LAS float* qt = qkvl + t * 384 + 32 * qd; const LAS float* kt = qt + 128;
        float part = 0.f;
#pragma unroll
        for (int j = 0; j < 32; ++j) { S[j] *= dec; part += kt[j] * S[j]; }
        red[qd * 128 + e] = part;
        __syncthreads();
        const float kS = (red[e] + red[128 + e]) + (red[256 + e] + red[384 + e]);
        const float u = beta * (qkvl[t * 384 + 256 + e] - kS);
        float part2 = 0.f;
#pragma unroll
        for (int j = 0; j < 32; ++j) { S[j] += kt[j] * u; part2 += qt[j] * S[j]; }
        red2[qd * 128 + e] = part2;
        __syncthreads();
        if (qd == 0) ol[t * 128 + e] = (red2[e] + red2[128 + e]) + (red2[256 + e] + red2[384 + e]);
    }
    __syncthreads();
    if (wave < 4) { const int t = wave; const float a = ol[t * 128 + lane], bq = ol[t * 128 + lane + 64];
        const float rn = frsq(wave_sum(a * a + bq * bq) * (1.f / DND) + EPS);
        const size_t m = MP + 4 * s + t; const float* og = (const float*)p.in[I_DOG];
        const float z0 = bf2f(PROJ[m * ODD_PAD + 3 * DNW + h * DND + lane]), z1 = bf2f(PROJ[m * ODD_PAD + 3 * DNW + h * DND + lane + 64]);
        AO[m * DM + h * DND + lane] = f2bf(a * rn * og[lane] * fsilu(z0)); AO[m * DM + h * DND + lane + 64] = f2bf(bq * rn * og[lane + 64] * fsilu(z1)); }
    float* so = p.out + O_DSS + ((size_t)(s * DNH + h) * DND + 32 * qd) * DND + e;
#pragma unroll
    for (int j = 0; j < 32; ++j) so[(size_t)j * DND] = S[j];
    __syncthreads();
}
DI void phase_odd_b(const Params& p, LAS unsigned char* lds, int tid, int lane, int wave, int G, int qsel = 1) {
    unsigned* head = (unsigned*)(p.ws + WS_CTL) + CW_QUEUE + 64 * qsel;
    volatile LAS unsigned* slot = (volatile LAS unsigned*)(lds + LDSCTL_OFF + 128);
    constexpr unsigned N_CH = 2 * NB_P * DNH, N_SMP = NB_S * DNH, N_ALL = N_CH + N_SMP;
    for (;;) {
        unsigned u = queue_next(head, slot, tid);
        if (u >= N_ALL) break;
        const int mode = p.mode;
        if (u < N_CH) { if (mode != 2) dn_chain_unit(p, lds, tid, wave, (int)(u >> 4), (int)((u >> 1) & 7), (int)(u & 1)); continue; }
        u -= N_CH;
        if (mode != 1) dn_sample_unit(p, lds, tid, wave, (int)(u >> 3), (int)(u & 7));
    }
    { unsigned* headC = head + 32; LAS float* scr = (LAS float*)(lds + wave * 16384);
      for (;;) { const unsigned bt = queue_next(headC, slot, tid); if (bt * 8 >= (unsigned)DEF_N) break;
          const int v = (int)bt * 8 + wave; if (v < DEF_N) convert_item(p, scr, defer_item(v), lane & 63); } }
}

DI void phase_odd_c(const Params& p, LAS unsigned char* lds, int tid_, int wave, int G) {
    unsigned char* ws = p.ws;
    const bf16* PROJ = (const bf16*)(ws + WS_PROJ); const bf16* OR = (const bf16*)(ws + WS_OR); bf16* AO = (bf16*)(ws + WS_AO);
    LAS bf16* Ot = (LAS bf16*)lds;
    int tid = tid_; asm volatile("" : "+v"(tid));
    const int tl = tid >> 3, part = tid & 7;
    const float* og = (const float*)p.in[I_DOG] + part * 16;
    const f32x4 g0 = *(const f32x4*)og, g1 = *(const f32x4*)(og + 4), g2 = *(const f32x4*)(og + 8), g3 = *(const f32x4*)(og + 12);
    const float gg[16] = {g0[0], g0[1], g0[2], g0[3], g1[0], g1[1], g1[2], g1[3], g2[0], g2[1], g2[2], g2[3], g3[0], g3[1], g3[2], g3[3]};
    constexpr int NU = NB_P * 64 * DNH;
    u32x4 orn[2], zn[2];
    { const int u0 = (int)blockIdx.x < NU ? (int)blockIdx.x : 0; const int h = u0 & 7, c = (u0 >> 3) & 63, b = u0 >> 9; const size_t m = (size_t)(b * T_P + c * 64 + tl);
#pragma unroll
      for (int rep = 0; rep < 2; ++rep) orn[rep] = *(const u32x4*)(OR + (size_t)u0 * 8192 + (size_t)(tid + 512 * rep) * 8);
      zn[0] = *(const u32x4*)(PROJ + m * ODD_PAD + 3 * DNW + h * DND + part * 16); zn[1] = *(const u32x4*)(PROJ + m * ODD_PAD + 3 * DNW + h * DND + part * 16 + 8); }
    for (int unit = blockIdx.x; unit < NU; unit += G) {
        const int h = unit & 7, c = (unit >> 3) & 63, b = unit >> 9, m0 = b * T_P + c * 64;
        const u32x4 z0 = zn[0], z1 = zn[1];
#pragma unroll
        for (int rep = 0; rep < 2; ++rep) { const int q = tid + 512 * rep;
            const int half = q & 1, lane = (q >> 1) & 63, ti = (q >> 7) & 1, w = q >> 8, r = lane & 31, h2 = lane >> 5;
            const u32x4 v = orn[rep];
#pragma unroll
            for (int j = 0; j < 8; ++j) { const int i = 8 * half + j, tok = 32 * ti + (i & 3) + 8 * (i >> 2) + 4 * h2;
                Ot[tok * QLD + 32 * w + r] = (bf16)((j & 1) ? (v[j >> 1] >> 16) : (v[j >> 1] & 0xffffu)); } }
        { const int un = unit + G < NU ? unit + G : unit; const int hn = un & 7, cn = (un >> 3) & 63, bn = un >> 9; const size_t mn = (size_t)(bn * T_P + cn * 64 + tl);
#pragma unroll
          for (int rep = 0; rep < 2; ++rep) orn[rep] = *(const u32x4*)(OR + (size_t)un * 8192 + (size_t)(tid + 512 * rep) * 8);
          zn[0] = *(const u32x4*)(PROJ + mn * ODD_PAD + 3 * DNW + hn * DND + part * 16); zn[1] = *(const u32x4*)(PROJ + mn * ODD_PAD + 3 * DNW + hn * DND + part * 16 + 8); }
        const size_t m = m0 + tl;
        __syncthreads();
        const u32x4 o0 = *(const LAS u32x4*)(Ot + tl * QLD + part * 16), o1 = *(const LAS u32x4*)(Ot + tl * QLD + part * 16 + 8);
        float o[16], z[16];
#pragma unroll
        for (int j = 0; j < 4; ++j) { o[2 * j] = bflo(o0[j]); o[2 * j + 1] = bfhi(o0[j]); o[8 + 2 * j] = bflo(o1[j]); o[8 + 2 * j + 1] = bfhi(o1[j]);
            z[2 * j] = bflo(z0[j]); z[2 * j + 1] = bfhi(z0[j]); z[8 + 2 * j] = bflo(z1[j]); z[8 + 2 * j + 1] = bfhi(z1[j]); }
        float ss = 0.f;
#pragma unroll
        for (int j = 0; j < 16; ++j) ss += o[j] * o[j];
#pragma unroll
        for (int of = 1; of < 8; of <<= 1) ss += __shfl_xor(ss, of);
        const float rn = frsq(ss * (1.f / DND) + EPS);
        u32x4 w0, w1;
#pragma unroll
        for (int j = 0; j < 4; ++j) { w0[j] = pk2(o[2 * j] * rn * gg[2 * j] * fsilu(z[2 * j]), o[2 * j + 1] * rn * gg[2 * j + 1] * fsilu(z[2 * j + 1]));
            w1[j] = pk2(o[8 + 2 * j] * rn * gg[8 + 2 * j] * fsilu(z[8 + 2 * j]), o[8 + 2 * j + 1] * rn * gg[8 + 2 * j + 1] * fsilu(z[8 + 2 * j + 1])); }
        bf16* dst = AO + m * DM + h * DND + part * 16; *(u32x4*)dst = w0; *(u32x4*)(dst + 8) = w1;
        __syncthreads();
    }
}
DI void small_swiglu(LAS unsigned char* lds, const bf16* XB, const bf16* Wt, bf16* HB, const float* ssq, int tid, int wave, int G) {
    for (int su = G - 1 - (int)blockIdx.x; su < 4 * (DFF / 32); su += G) { const int rt = su & 3, j = su >> 2, n0 = ((32 * j) >> 7) * 256 + ((32 * j) & 127);
        gemm_small_unit<128>(lds, XB, Wt, DM, MP + 128 * rt, n0, n0 + 128, SEpiSwiglu{HB, 32 * j, ssq}, tid, wave); }
}
template <bool BASE_F32, bool OUT_F32> DI void small_res(LAS unsigned char* lds, const bf16* A, const bf16* Wt, int K, const void* base, void* out, float alpha, float* ssq, int tid, int wave, int G) {
    for (int su = G - 1 - (int)blockIdx.x; su < 8 * (DM / 64); su += G) { const int rt = su & 7, j = su >> 3;
        gemm_small_unit<64>(lds, A, Wt, K, MP + 64 * rt, 64 * j, 64 * j + 32, SEpiResT<BASE_F32, OUT_F32>{base, out, ssq, alpha}, tid, wave); }
}
DI void small_proj_e(LAS unsigned char* lds, const bf16* XB, const bf16* Wt, bf16* PROJ, const float* ssq, int tid, int wave, int G) {
    if ((int)blockIdx.x < G / 2) return;
    for (int su = G - 1 - (int)blockIdx.x; su < 4 * (EVEN_IN / 64); su += G / 2) { const int rt = su & 3, j = su >> 2;
        gemm_small_unit<128>(lds, XB, Wt, DM, MP + 128 * rt, 64 * j, 64 * j + 32, SEpiProj{PROJ, EVEN_IN, ssq}, tid, wave); }
}
DI void small_proj(LAS unsigned char* lds, const bf16* XB, const bf16* Wt, bf16* PROJ, int ldc, int ngrp, int with_logits, const float* ssq, int tid, int wave, int G) {
    const int nsmp = 2 * ngrp, nall = nsmp + (with_logits ? MP / 256 : 0);
    for (int su = G - 1 - (int)blockIdx.x; su < nall; su += G) {
        int m0, j; if (su < nsmp) { m0 = MP + 256 * (su & 1); j = su >> 1; } else { m0 = 256 * (su - nsmp); j = ngrp - 1; }
        gemm_small_unit<256>(lds, XB, Wt, DM, m0, 64 * j, 64 * j + 32, SEpiProj{PROJ, ldc, ssq}, tid, wave); }
}
#ifndef PROBE_MASK
#define PROBE_MASK 0
#endif
#ifndef PROBE_MODE
#define PROBE_MODE 0
#endif
#define IN(k) (lo <= (k) && (k) < hi)
#define SEAM(k) do { if (IN(k) && IN((k) + 1)) xcd_barrier(bar); } while (0)
template <int l> DI void run_layer(const Params& p, LAS unsigned char* lds, const XcdBarrier& bar, int lo, int hi, int tid, int lane, int wave, int G, int gw, int NGW) {
    unsigned char* ws = p.ws;
    float* X = (float*)(ws + WS_X); bf16* XB = (bf16*)(ws + WS_XN); bf16* HB = (bf16*)(ws + WS_H); bf16* PROJ = (bf16*)(ws + WS_PROJ); bf16* AO = (bf16*)(ws + WS_AO);
    float* Xs = X + (size_t)MP * DM;
    float* SSQ = (float*)(ws + WS_CTL) + CW_SSQ;
    const float* xp = (const float*)p.in[I_XP]; const float* xs = (const float*)p.in[I_XS];
    const int pb = PH_L0 + l * PH_PER_LAYER;
    if (IN(pb + LP_FIN1)) {
        const bf16* Wt = (const bf16*)(ws + WS_WFIN) + (size_t)(l * 2) * 2 * DFF * DM; const float* sq = SSQ + (size_t)(3 * l + 0) * MT;
        pg8::Gemm g{XB, Wt, MP, 2 * DFF, DM}; pg8::StaticOrder S; S.init(MP, 2 * DFF, G, (int)blockIdx.x);
        pg8::EpiSwiglu E{HB, DFF, sq};
        pg8::gemm_phase<pg8::EpiSwiglu, pg8::StaticOrder, PG8_ALIGN, PG8_SP2>(lds, g, S, E);
        small_swiglu(lds, XB, Wt, HB, sq, tid, wave, G);
    }
    SEAM(pb + LP_FIN1);
    if (IN(pb + LP_FOUT1)) {
        const bf16* Wt = (const bf16*)(ws + WS_WFOUT) + (size_t)(l * 2) * DM * DFF; float* sq = SSQ + (size_t)(3 * l + 1) * MT;
        pg8::Gemm g{HB, Wt, MP, DM, DFF}; pg8::StaticOrder S; S.init(MP, DM, G, (int)blockIdx.x);
        if (l == 0) { pg8::EpiResT<true, false> E{xp, XB, sq, 0.5f}; pg8::gemm_phase<pg8::EpiResT<true, false>, pg8::StaticOrder, PG8_ALIGN, PG8_SP2>(lds, g, S, E);
            small_res<true, false>(lds, HB, Wt, DFF, xs, XB, 0.5f, sq, tid, wave, G); }
        else { pg8::EpiResT<false, false> E{XB, XB, sq, 0.5f}; pg8::gemm_phase<pg8::EpiResT<false, false>, pg8::StaticOrder, PG8_ALIGN, PG8_SP2>(lds, g, S, E);
            small_res<false, false>(lds, HB, Wt, DFF, XB, XB, 0.5f, sq, tid, wave, G); }
    }
    SEAM(pb + LP_FOUT1);
    if (IN(pb + LP_PROJ)) {
        const float* sq = SSQ + (size_t)(3 * l + 1) * MT;
        if (l == 0) {
            pg8::Gemm g{XB, (const bf16*)(ws + WS_WINE), MP, EVEN_IN, DM}; pg8::StaticOrder S; S.init(MP, EVEN_IN, G, (int)blockIdx.x);
            pg8::EpiProj E{PROJ, EVEN_IN, sq};
            pg8::gemm_phase<pg8::EpiProj, pg8::StaticOrder, PG8_ALIGN, PG8_SP2>(lds, g, S, E);
            small_proj_e(lds, XB, (const bf16*)(ws + WS_WINE), PROJ, sq, tid, wave, G);
        } else {
            pg8::Gemm g{XB, (const bf16*)(ws + WS_WINO), MP, 4 * DNW, DM}; pg8::StaticOrder S; S.init(MP, 4 * DNW, G, (int)blockIdx.x);
            pg8::EpiProj E{PROJ, ODD_PAD, sq};
            pg8::gemm_phase<pg8::EpiProj, pg8::StaticOrder, PG8_ALIGN, PG8_SP2>(lds, g, S, E);
            small_proj(lds, XB, (const bf16*)(ws + WS_WINO), PROJ, ODD_PAD, 4 * DNW / 64 + 1, 1, sq, tid, wave, G);
        }
    }
    SEAM(pb + LP_PROJ);
    if (IN(pb + LP_MIXA)) { if (l == 0) phase_even_a(p, lds, tid, lane, wave, G); else phase_odd_a(p, lds, tid, lane, wave, G); }
    SEAM(pb + LP_MIXA);
    if (IN(pb + LP_MIXB)) { if (l == 0) phase_even_b(p, lds, tid, lane, wave, G); else phase_odd_b(p, lds, tid, lane, wave, G); }
    SEAM(pb + LP_MIXB);
    if (l == 1) { if (IN(pb + LP_MIXC)) phase_odd_c(p, lds, tid, wave, G); SEAM(pb + LP_MIXC); }
    if (IN(pb + LP_OUT)) {
        const bf16* Wt = (const bf16*)(ws + (l == 0 ? WS_WOUTE : WS_WOUTO)); float* sq = SSQ + (size_t)(3 * l + 2) * MT;
        pg8::Gemm g{AO, Wt, MP, DM, DM}; pg8::StaticOrder S; S.init(MP, DM, G, (int)blockIdx.x);
        pg8::EpiResT<false, false> E{XB, XB, sq, 1.0f};
        pg8::gemm_phase<pg8::EpiResT<false, false>, pg8::StaticOrder, PG8_ALIGN, PG8_SP2>(lds, g, S, E);
        small_res<false, false>(lds, AO, Wt, DM, XB, XB, 1.0f, sq, tid, wave, G);
    }
    SEAM(pb + LP_OUT);
    if (IN(pb + LP_FIN2)) {
        const bf16* Wt = (const bf16*)(ws + WS_WFIN) + (size_t)(l * 2 + 1) * 2 * DFF * DM; const float* sq = SSQ + (size_t)(3 * l + 2) * MT;
        pg8::Gemm g{XB, Wt, MP, 2 * DFF, DM}; pg8::StaticOrder S; S.init(MP, 2 * DFF, G, (int)blockIdx.x);
        pg8::EpiSwiglu E{HB, DFF, sq};
        pg8::gemm_phase<pg8::EpiSwiglu, pg8::StaticOrder, PG8_ALIGN, PG8_SP2>(lds, g, S, E);
        small_swiglu(lds, XB, Wt, HB, sq, tid, wave, G);
    }
    SEAM(pb + LP_FIN2);
    if (IN(pb + LP_FOUT2)) {
        const bf16* Wt = (const bf16*)(ws + WS_WFOUT) + (size_t)(l * 2 + 1) * DM * DFF; float* sq = l == 0 ? SSQ + (size_t)3 * MT : (float*)nullptr;
        pg8::Gemm g{HB, Wt, MP, DM, DFF}; pg8::StaticOrder S; S.init(MP, DM, G, (int)blockIdx.x);
        if (l == 0) { pg8::EpiResT<false, false> E{XB, XB, sq, 0.5f}; pg8::gemm_phase<pg8::EpiResT<false, false>, pg8::StaticOrder, PG8_ALIGN, PG8_SP2>(lds, g, S, E);
            small_res<false, false>(lds, HB, Wt, DFF, XB, XB, 0.5f, sq, tid, wave, G); }
        else { pg8::EpiResT<false, true> E{XB, p.out + O_YP, sq, 0.5f}; pg8::gemm_phase<pg8::EpiResT<false, true>, pg8::StaticOrder, PG8_ALIGN, PG8_SP2>(lds, g, S, E);
            small_res<false, true>(lds, HB, Wt, DFF, XB, p.out + O_YS, 0.5f, sq, tid, wave, G); }
    }
    SEAM(pb + LP_FOUT2);
}
__global__ void __launch_bounds__(NTHR, 2) mega(Params p) {
    extern __shared__ __attribute__((aligned(16))) unsigned char lds_raw[];
    LAS unsigned char* lds = (LAS unsigned char*)lds_raw;
    const int tid = threadIdx.x, lane = tid & 63, wave = __builtin_amdgcn_readfirstlane(tid >> 6);
    const int G = gridDim.x, gw = blockIdx.x * NWAVES + wave, NGW = G * NWAVES;
    unsigned char* ws = p.ws;
    unsigned* ctl = (unsigned*)(ws + WS_CTL);
    for (int u = tid; u < (LDS_BYTES - LDSCTL_OFF) / 4; u += NTHR) ((LAS unsigned*)(lds + LDSCTL_OFF))[u] = 0u;
    __syncthreads();
    const int lo = p.ph_lo, hi = p.ph_hi;
    XcdBarrier bar; bar.bar = ctl + CW_BAR; bar.x = 0; bar.st = nullptr;
    if (hi - lo > 1) bar = xcd_barrier_post(ctl + CW_BAR, (volatile LAS unsigned*)(lds + LDSCTL_OFF + 64));

    float* X = (float*)(ws + WS_X); bf16* XN = (bf16*)(ws + WS_XN); bf16* HB = (bf16*)(ws + WS_H); bf16* PROJ = (bf16*)(ws + WS_PROJ); bf16* AO = (bf16*)(ws + WS_AO);
    const float* xp = (const float*)p.in[I_XP]; const float* xs = (const float*)p.in[I_XS];

    if (IN(PH_PRO)) { phase_prologue(p, lds, gw, NGW, wave, lane); phase_input_rows(xp, xs, XN, (float*)(ws + WS_CTL) + CW_SSQ, gw, NGW, lane); }
    SEAM(PH_PRO);

    run_layer<0>(p, lds, bar, lo, hi, tid, lane, wave, G, gw, NGW);
    run_layer<1>(p, lds, bar, lo, hi, tid, lane, wave, G, gw, NGW);
#undef IN
#undef SEAM
}

#ifndef MK_ONE_LAUNCH
#define MK_ONE_LAUNCH 1
#endif
extern "C" void kernel_launch(void* const* d_in, const int* in_sizes, int n_in, void* d_out, int out_size, void* d_ws, size_t ws_size, hipStream_t stream) {
    static int grid = 0;
    if (grid == 0) {
        if (n_in != N_IN || (size_t)out_size != O_END || ws_size < WS_END) { fprintf(stderr, "kernel_launch: unexpected problem: n_in %d out %d ws %zu\n", n_in, out_size, ws_size); grid = -1; return; }
        int dev = 0, cus = 0;
        if (hipGetDevice(&dev) != hipSuccess || hipDeviceGetAttribute(&cus, hipDeviceAttributeMultiprocessorCount, dev) != hipSuccess) { grid = -1; return; }
        if (hipFuncSetAttribute((const void*)mega, hipFuncAttributeMaxDynamicSharedMemorySize, LDS_BYTES) != hipSuccess) { fprintf(stderr, "kernel_launch: hipFuncSetAttribute failed\n"); grid = -1; return; }
        int per_cu = 0;
        if (hipOccupancyMaxActiveBlocksPerMultiprocessor(&per_cu, (const void*)mega, NTHR, LDS_BYTES) != hipSuccess || per_cu < 1) fprintf(stderr, "kernel_launch: occupancy query says %d\n", per_cu);
        (void)hipGetLastError();
        grid = cus;
    }
    if (grid < 0) return;
    if (hipMemsetAsync((char*)d_ws + WS_CTL, 0, CTL_ZERO_BYTES, stream) != hipSuccess) return;
    Params p{};
    for (int i = 0; i < N_IN; ++i) p.in[i] = d_in[i];
    p.out = (float*)d_out; p.ws = (unsigned char*)d_ws;
#if PROBE_MASK
    { int lo = 0;
      for (int ph = 0; ph < NPH; ++ph) if ((PROBE_MASK >> ph) & 1) {
          p.ph_lo = lo; p.ph_hi = ph + 1; hipLaunchKernelGGL(mega, dim3(grid), dim3(NTHR), LDS_BYTES, stream, p);
          (void)hipMemsetAsync((char*)d_ws + WS_CTL, 0, CW_SSQ * 4, stream);
          p.ph_lo = ph; p.ph_hi = ph + 1; p.mode = PROBE_MODE; hipLaunchKernelGGL(mega, dim3(grid), dim3(NTHR), LDS_BYTES, stream, p); p.mode = 0;
          (void)hipMemsetAsync((char*)d_ws + WS_CTL, 0, CW_SSQ * 4, stream);
          lo = ph + 1; }
      if (lo < NPH) { p.ph_lo = lo; p.ph_hi = NPH; hipLaunchKernelGGL(mega, dim3(grid), dim3(NTHR), LDS_BYTES, stream, p); } }
#elif MK_ONE_LAUNCH
    p.ph_lo = 0; p.ph_hi = NPH;
    hipLaunchKernelGGL(mega, dim3(grid), dim3(NTHR), LDS_BYTES, stream, p);
#else
    for (int ph = 0; ph < NPH; ++ph) { p.ph_lo = ph; p.ph_hi = ph + 1; hipLaunchKernelGGL(mega, dim3(grid), dim3(NTHR), LDS_BYTES, stream, p); }
#endif
}
```

```cpp
#include <hip/hip_runtime.h>
#include <cstdio>
#include <cstdint>

#define GAS __attribute__((address_space(1)))
#define LAS __attribute__((address_space(3)))
typedef unsigned short bf16;
typedef short bf16x8 __attribute__((ext_vector_type(8)));
typedef short bf16x4 __attribute__((ext_vector_type(4)));
typedef float f32x2 __attribute__((ext_vector_type(2)));
typedef float f32x4 __attribute__((ext_vector_type(4)));
typedef float f32x16 __attribute__((ext_vector_type(16)));
typedef unsigned u32x2 __attribute__((ext_vector_type(2)));
typedef unsigned u32x4 __attribute__((ext_vector_type(4)));
typedef __bf16 bf16v2 __attribute__((ext_vector_type(2)));
#define DI __device__ __forceinline__
DI unsigned pk2(float lo, float hi) { f32x2 v = {lo, hi}; return __builtin_bit_cast(unsigned, __builtin_convertvector(v, bf16v2)); }
DI bf16 f2bf(float f) { return (bf16)(pk2(f, 0.f) & 0xffffu); }
DI float bf2f(bf16 b) { return __builtin_bit_cast(float, ((unsigned)b) << 16); }
DI float bflo(unsigned w) { return __builtin_bit_cast(float, w << 16); }
DI float bfhi(unsigned w) { return __builtin_bit_cast(float, w & 0xffff0000u); }
DI float fexp2(float x) { return __builtin_amdgcn_exp2f(x); }
DI float flog2(float x) { return __builtin_amdgcn_logf(x); }
DI float frcp(float x) { return __builtin_amdgcn_rcpf(x); }
DI float frsq(float x) { return __builtin_amdgcn_rsqf(x); }
#define LOG2E 1.4426950408889634f
#define LN2 0.6931471805599453f
DI float fsigmoid(float x) { return frcp(1.0f + fexp2(-x * LOG2E)); }
DI float fsilu(float x) { return x * fsigmoid(x); }
DI float fsoftplus(float x) { return x > 20.f ? x : LN2 * flog2(1.0f + fexp2(x * LOG2E)); }
DI float fgelu_tanh(float x) { const float u = 0.7978845608028654f * (x + 0.044715f * x * x * x); return x * fsigmoid(2.0f * u); }
DI float fnegexpm1(float x) { const float pl = -x * (1.f + x * (0.5f + x * (0.16666667f + x * (0.041666668f + x * (0.0083333338f + x * 0.0013888889f))))); return x > -0.25f ? pl : 1.0f - fexp2(x * LOG2E); }
#define MFMA32(a, b, c) __builtin_amdgcn_mfma_f32_32x32x16_bf16((a), (b), (c), 0, 0, 0)
#define LDS_WAIT() asm volatile("s_waitcnt lgkmcnt(0)" ::: "memory")
#define VM_WAIT() asm volatile("s_waitcnt vmcnt(0)" ::: "memory")
DI float wave_sum(float v) {
#pragma unroll
    for (int o = 1; o < 64; o <<= 1) v += __shfl_xor(v, o);
    return v;
}

constexpr int DM = 1024, NB_P = 4, T_P = 4096, MP = NB_P * T_P  , NB_S = 128, T_S = 4, MS = NB_S * T_S  , MT = MP + MS  ;
constexpr int PAST = 2048, PAGE = 128, NPAGES = 16, NPOOL = 2560;
constexpr int SBH = 8, SBD = 64, SBW = 512, LRW = 512, DNH = 8, DND = 128, DNW = 1024, DFF = 2048;
constexpr int EVEN_IN = 2560, ODD_IN = 4112, ODD_PAD = 4352;
constexpr float EPS = 1e-6f;
namespace pg8 {
#define PG8_LAS __attribute__((address_space(3)))
typedef unsigned short bf16_t;
constexpr int BM = 256, BK = 64, HALF = 128, HTB = HALF * BK * 2  , STAGE_BYTES = 8 * HTB, NXCD = 8, WGM = 8;

__host__ __device__ __forceinline__ int lds_byte(int r, int c) { const int st = (r >> 4) * 2 + (c >> 5), rr = r & 15, cc = c & 31, ob = rr * 64 + cc * 2; return st * 1024 + (ob ^ (((ob >> 9) & 1) << 5)); }
__host__ __device__ __forceinline__ void stage_rc(int b, int& R, int& C) { const int st = b / 1024, sb = b % 1024, swz = sb ^ (((sb >> 9) & 1) << 5); R = (st >> 1) * 16 + swz / 64; C = (st & 1) * 32 + (swz % 64) / 2; }
__host__ __device__ __forceinline__ int perm32(int rho) { const int n = rho >> 4, i = rho & 15; return 8 * (i >> 2) + 4 * n + (i & 3); }

struct Unit { int pm, pn; };
struct Gemm { const bf16_t* A; const bf16_t* Bt; int M, N, K; };

struct StaticOrder {
    int nM, nN, nwg, G, c;
    __host__ __device__ void init(int M, int N, int G_, int c_) { nM = M / BM; nN = N / BM; nwg = nM * nN; G = G_; c = c_; }
    __host__ __device__ bool next(int i, Unit& u) const {
        const long L = (long)i * G + c; if (L >= nwg) return false;
        int wgid = (int)L; { const int q = nwg / NXCD, r = nwg % NXCD, xcd = wgid % NXCD, off = wgid / NXCD; wgid = (xcd < r ? xcd * (q + 1) : r * (q + 1) + (xcd - r) * q) + off; }
        const int nig = WGM * nN, gid = wgid / nig, fm = gid * WGM, gsz = (nM - fm) < WGM ? (nM - fm) : WGM;
        u.pm = fm + ((wgid % nig) % gsz); u.pn = (wgid % nig) / gsz; return true;
    }
    __device__ __forceinline__ void a_ready(const Unit&) const {}
    __device__ __forceinline__ void done(const Unit&) const {}
};


DI float row_rstd(const float* ssq, int row) { return frsq((float)((const unsigned*)ssq)[row] * (1.f / 1024.f) * (1.f / DM) + EPS); }
DI void ssq_add(float* ssq, int row, float s) { atomicAdd((unsigned*)ssq + row, (unsigned)(s * 1024.f + 0.5f)); }
struct PreNone {};
struct PreRs { unsigned raw[2][4]; DI float rs(int ai, int m) const { return frsq((float)raw[ai][m] * (1.f / 1024.f) * (1.f / DM) + EPS); } };
DI PreRs pre_rstd(const float* ssq, const Unit& u, int wr, int fr) { PreRs p;
#pragma unroll
    for (int ai = 0; ai < 2; ++ai)
#pragma unroll
        for (int m = 0; m < 4; ++m) p.raw[ai][m] = ((const unsigned*)ssq)[u.pm * BM + wr * 64 + fr + ai * HALF + m * 16];
    return p; }
struct EpiSwiglu {
    static constexpr bool PERM = true, AFTER_DRAIN = false;
    bf16_t* H; int ldc; const float* ssq;
    typedef PreRs Pre; DI Pre pre(const Unit& u, int wr, int fr) const { return pre_rstd(ssq, u, wr, fr); }
    __device__ __forceinline__ void operator()(const f32x4 (&acc)[2][2][4][2], const Unit& u, int wr, int wc, int fr, int fq, const Pre& P) const {
        const int row0 = u.pm * BM + wr * 64 + fr, col0 = u.pn * HALF + wc * 32 + 8 * fq;
#pragma unroll
        for (int ai = 0; ai < 2; ++ai)
#pragma unroll
            for (int m = 0; m < 4; ++m) {
                const int row = row0 + ai * HALF + m * 16; const float rs = P.rs(ai, m);
                bf16_t* rowp = H + (size_t)row * ldc + col0;
                const f32x4 g0 = acc[ai][0][m][0] * rs, g1 = acc[ai][0][m][1] * rs, u0 = acc[ai][1][m][0] * rs, u1 = acc[ai][1][m][1] * rs;
                u32x4 w;
                w.x = pk2(fsilu(g0[0]) * u0[0], fsilu(g0[1]) * u0[1]); w.y = pk2(fsilu(g0[2]) * u0[2], fsilu(g0[3]) * u0[3]);
                w.z = pk2(fsilu(g1[0]) * u1[0], fsilu(g1[1]) * u1[1]); w.w = pk2(fsilu(g1[2]) * u1[2], fsilu(g1[3]) * u1[3]);
                *(u32x4*)rowp = w;
            }
    }
};
template <bool BASE_F32, bool OUT_F32> struct EpiResT {
    static constexpr bool PERM = true, AFTER_DRAIN = false;
    const void* base; void* out; float* ssq; float alpha;
    typedef PreNone Pre; DI Pre pre(const Unit&, int, int) const { return Pre{}; }
    __device__ __forceinline__ void operator()(const f32x4 (&acc)[2][2][4][2], const Unit& u, int wr, int wc, int fr, int fq, const Pre&) const {
        const int row0 = u.pm * BM + wr * 64 + fr, col0 = u.pn * BM + wc * 32 + 8 * fq;
#pragma unroll
        for (int ai = 0; ai < 2; ++ai)
#pragma unroll
            for (int m = 0; m < 4; ++m) {
                const int row = row0 + ai * HALF + m * 16; const size_t off = (size_t)row * DM + col0; float s = 0.f;
#pragma unroll
                for (int bj = 0; bj < 2; ++bj) {
                    f32x4 b0, b1;
                    if (BASE_F32) { const float* bp = (const float*)base + off + bj * HALF; b0 = *(const f32x4*)bp; b1 = *(const f32x4*)(bp + 4); }
                    else { const u32x4 w = *(const u32x4*)((const bf16_t*)base + off + bj * HALF); b0 = (f32x4){bflo(w.x), bfhi(w.x), bflo(w.y), bfhi(w.y)}; b1 = (f32x4){bflo(w.z), bfhi(w.z), bflo(w.w), bfhi(w.w)}; }
                    const f32x4 o0 = b0 + acc[ai][bj][m][0] * alpha, o1 = b1 + acc[ai][bj][m][1] * alpha;
                    if (OUT_F32) { float* op = (float*)out + off + bj * HALF; *(f32x4*)op = o0; *(f32x4*)(op + 4) = o1; }
                    else { u32x4 w; w.x = pk2(o0[0], o0[1]); w.y = pk2(o0[2], o0[3]); w.z = pk2(o1[0], o1[1]); w.w = pk2(o1[2], o1[3]); *(u32x4*)((bf16_t*)out + off + bj * HALF) = w; }
                    s += ((o0[0] * o0[0] + o0[1] * o0[1]) + (o0[2] * o0[2] + o0[3] * o0[3])) + ((o1[0] * o1[0] + o1[1] * o1[1]) + (o1[2] * o1[2] + o1[3] * o1[3]));
                }
                if (ssq) { s += __shfl_xor(s, 16); s += __shfl_xor(s, 32); if (fq == 0) ssq_add(ssq, row, s); }
            }
    }
};
struct EpiProj {
    static constexpr bool PERM = true, AFTER_DRAIN = false;
    bf16_t* O; int ldc; const float* ssq;
    typedef PreRs Pre; DI Pre pre(const Unit& u, int wr, int fr) const { return pre_rstd(ssq, u, wr, fr); }
    __device__ __forceinline__ void operator()(const f32x4 (&acc)[2][2][4][2], const Unit& u, int wr, int wc, int fr, int fq, const Pre& P) const {
        const int row0 = u.pm * BM + wr * 64 + fr, col0 = u.pn * BM + wc * 32 + 8 * fq;
#pragma unroll
        for (int ai = 0; ai < 2; ++ai)
#pragma unroll
            for (int m = 0; m < 4; ++m) {
                const int row = row0 + ai * HALF + m * 16; const float rs = P.rs(ai, m);
                bf16_t* rowp = O + (size_t)row * ldc + col0;
#pragma unroll
                for (int bj = 0; bj < 2; ++bj) { const f32x4 v0 = acc[ai][bj][m][0] * rs, v1 = acc[ai][bj][m][1] * rs;
                    u32x4 w; w.x = pk2(v0[0], v0[1]); w.y = pk2(v0[2], v0[3]); w.z = pk2(v1[0], v1[1]); w.w = pk2(v1[2], v1[3]);
                    *(u32x4*)(rowp + bj * HALF) = w; }
            }
    }
};

template <class Epi, class Sched, bool ALIGN_EPI = false, bool SP2 = false>
__device__ __forceinline__ void gemm_phase(PG8_LAS unsigned char* lds, const Gemm g, const Sched& S, const Epi& E) {
    const int tid = threadIdx.x, wid = __builtin_amdgcn_readfirstlane(tid >> 6), lane = tid & 63, wr = wid >> 2, wc = wid & 3, fr = lane & 15, fq = lane >> 4;
    const int K = g.K, nt = K / BK;
    unsigned voffA[2], voffB[2];
#pragma unroll
    for (int i = 0; i < 2; ++i) { int R, C; stage_rc(tid * 16 + i * 8192, R, C); const int Rb = Epi::PERM ? ((R & ~31) + perm32(R & 31)) : R;
        voffA[i] = (unsigned)(R * K + C) * 2u; voffB[i] = (unsigned)(Rb * K + C) * 2u; }
    const size_t kstep = (size_t)(BK * 2);
    const size_t hstep = (size_t)HALF * K * 2;
    const size_t tstep = 2 * hstep;
    const unsigned ldsw = (unsigned)wid * 1024u;
    const int aoff = lds_byte(wr * 64 + fr, fq * 8), boff = lds_byte(wc * 32 + fr, fq * 8);
#define PG8_SA(b, h) (((b) * 2 + (h)) * HTB)
#define PG8_SB(b, h) ((4 + (b) * 2 + (h)) * HTB)
#define PG8_STAGE(bufoff, gbase, voff) do { _Pragma("unroll") for (int _i = 0; _i < 2; ++_i) \
        __builtin_amdgcn_global_load_lds((const unsigned*)((const char*)(gbase) + (voff)[_i]), (PG8_LAS unsigned*)(lds + (bufoff) + ldsw + _i * 8192), 16, 0, 0); } while (0)
#define PG8_LDA(dst, b, h) do { _Pragma("unroll") for (int m = 0; m < 4; ++m) _Pragma("unroll") for (int k = 0; k < 2; ++k) dst[m][k] = *(const PG8_LAS bf16x8*)(lds + PG8_SA(b, h) + aoff + m * 2048 + k * 1024); } while (0)
#define PG8_LDB(dst, b, h) do { _Pragma("unroll") for (int n = 0; n < 2; ++n) _Pragma("unroll") for (int k = 0; k < 2; ++k) dst[n][k] = *(const PG8_LAS bf16x8*)(lds + PG8_SB(b, h) + boff + n * 2048 + k * 1024); } while (0)
#define PG8_MMA(ai, bj, At, Bt) do { __builtin_amdgcn_s_setprio(1); _Pragma("unroll") for (int m = 0; m < 4; ++m) _Pragma("unroll") for (int n = 0; n < 2; ++n) _Pragma("unroll") for (int k = 0; k < 2; ++k) \
        acc[ai][bj][m][n] = __builtin_amdgcn_mfma_f32_16x16x32_bf16(Bt[n][k], At[m][k], acc[ai][bj][m][n], 0, 0, 0); __builtin_amdgcn_s_setprio(0); } while (0)
#define PG8_WAIT_V(n) asm volatile("s_waitcnt vmcnt(" #n ")" ::: "memory")
#define PG8_WAIT_L(n) asm volatile("s_waitcnt lgkmcnt(" #n ")" ::: "memory")
#define PG8_BAR __builtin_amdgcn_s_barrier()
#define PG8_SCHED __builtin_amdgcn_sched_barrier(0)
    Unit cur, nxt; int ui = 0;
    if (!S.next(0, cur)) return;
    f32x4 acc[2][2][4][2];
#pragma unroll
    for (int a = 0; a < 2; ++a)
#pragma unroll
        for (int b = 0; b < 2; ++b)
#pragma unroll
            for (int m = 0; m < 4; ++m)
#pragma unroll
                for (int n = 0; n < 2; ++n) acc[a][b][m][n] = (f32x4){0.f, 0.f, 0.f, 0.f};
    bf16x8 At[4][2], B0[2][2], B1[2][2];
    const char* cA = (const char*)g.A + (size_t)cur.pm * tstep; const char* cB = (const char*)g.Bt + (size_t)cur.pn * tstep;
    S.a_ready(cur);
    if constexpr (SP2) {
        PG8_STAGE(PG8_SB(0, 0), cB, voffB); PG8_STAGE(PG8_SB(0, 1), cB + hstep, voffB); PG8_STAGE(PG8_SA(0, 0), cA, voffA); PG8_STAGE(PG8_SA(0, 1), cA + hstep, voffA);
        if (wr == 1) PG8_BAR;
        PG8_WAIT_V(2); PG8_BAR;
        PG8_STAGE(PG8_SB(1, 0), cB + kstep, voffB); PG8_STAGE(PG8_SA(1, 0), cA + kstep, voffA); PG8_STAGE(PG8_SB(1, 1), cB + hstep + kstep, voffB);
        PG8_WAIT_V(6); PG8_BAR;
    } else {
        PG8_STAGE(PG8_SB(0, 0), cB, voffB); PG8_STAGE(PG8_SA(0, 0), cA, voffA); PG8_STAGE(PG8_SB(0, 1), cB + hstep, voffB); PG8_STAGE(PG8_SA(0, 1), cA + hstep, voffA);
        if (wr == 1) PG8_BAR;
        PG8_WAIT_V(4); PG8_BAR;
        PG8_STAGE(PG8_SB(1, 0), cB + kstep, voffB); PG8_STAGE(PG8_SA(1, 0), cA + kstep, voffA); PG8_STAGE(PG8_SB(1, 1), cB + hstep + kstep, voffB);
        PG8_WAIT_V(6); PG8_BAR;
    }
    for (;;) {
        const bool has_next = S.next(ui + 1, nxt);
        const char* nA = has_next ? (const char*)g.A + (size_t)nxt.pm * tstep : cA; const char* nB = has_next ? (const char*)g.Bt + (size_t)nxt.pn * tstep : cB;
        const typename Epi::Pre pre = E.pre(cur, wr, fr);
        for (int t = 0; t < nt; t += 2) {
            const bool last = (t == nt - 2);
            const char* a1 = cA + (size_t)(t + 1) * kstep;
            const char* a2 = last ? nA : cA + (size_t)(t + 2) * kstep; const char* b2 = last ? nB : cB + (size_t)(t + 2) * kstep;
            const char* a3 = a2 + kstep; const char* b3 = b2 + kstep;
            if (last && has_next) S.a_ready(nxt);
            if constexpr (SP2) {
            PG8_LDB(B0, 0, 0); PG8_LDB(B1, 0, 1); PG8_SCHED; PG8_LDA(At, 0, 0); PG8_STAGE(PG8_SA(1, 1), a1 + hstep, voffA);
            PG8_WAIT_V(8); PG8_WAIT_L(0); PG8_BAR; PG8_MMA(0, 0, At, B0); PG8_MMA(0, 1, At, B1); PG8_BAR; PG8_SCHED;
            PG8_LDA(At, 0, 1); PG8_STAGE(PG8_SB(0, 0), b2, voffB); PG8_STAGE(PG8_SB(0, 1), b2 + hstep, voffB); PG8_STAGE(PG8_SA(0, 0), a2, voffA);
            PG8_WAIT_V(8); PG8_WAIT_L(0); PG8_BAR; PG8_MMA(1, 0, At, B0); PG8_MMA(1, 1, At, B1); PG8_BAR; PG8_SCHED;
            PG8_LDB(B0, 1, 0); PG8_LDB(B1, 1, 1); PG8_SCHED; PG8_LDA(At, 1, 0); PG8_STAGE(PG8_SA(0, 1), a2 + hstep, voffA);
            PG8_WAIT_V(8); PG8_WAIT_L(0); PG8_BAR; PG8_MMA(0, 0, At, B0); PG8_MMA(0, 1, At, B1); PG8_BAR; PG8_SCHED;
            PG8_LDA(At, 1, 1); PG8_STAGE(PG8_SB(1, 0), b3, voffB); PG8_STAGE(PG8_SB(1, 1), b3 + hstep, voffB); PG8_STAGE(PG8_SA(1, 0), a3, voffA);
            PG8_WAIT_V(8); PG8_WAIT_L(0); PG8_BAR; PG8_MMA(1, 0, At, B0); PG8_MMA(1, 1, At, B1); PG8_BAR; PG8_SCHED;
            } else {
            PG8_LDB(B0, 0, 0); PG8_SCHED; PG8_LDA(At, 0, 0); PG8_STAGE(PG8_SA(1, 1), a1 + hstep, voffA);
            PG8_WAIT_L(8); PG8_BAR; PG8_WAIT_L(0); PG8_MMA(0, 0, At, B0); PG8_BAR; PG8_SCHED;
            PG8_LDB(B1, 0, 1); PG8_STAGE(PG8_SB(0, 0), b2, voffB);
            PG8_BAR; PG8_WAIT_L(0); PG8_MMA(0, 1, At, B1); PG8_BAR;
            PG8_LDA(At, 0, 1); PG8_STAGE(PG8_SA(0, 0), a2, voffA);
            PG8_BAR; PG8_WAIT_L(0); PG8_MMA(1, 0, At, B0); PG8_BAR; PG8_SCHED;
            PG8_STAGE(PG8_SB(0, 1), b2 + hstep, voffB);
            PG8_WAIT_V(6); PG8_BAR; PG8_MMA(1, 1, At, B1); PG8_BAR;
            PG8_LDB(B0, 1, 0); PG8_SCHED; PG8_LDA(At, 1, 0); PG8_STAGE(PG8_SA(0, 1), a2 + hstep, voffA);
            PG8_WAIT_L(8); PG8_BAR; PG8_WAIT_L(0); PG8_MMA(0, 0, At, B0); PG8_BAR; PG8_SCHED;
            PG8_LDB(B1, 1, 1); PG8_STAGE(PG8_SB(1, 0), b3, voffB);
            PG8_BAR; PG8_WAIT_L(0); PG8_MMA(0, 1, At, B1); PG8_BAR;
            PG8_LDA(At, 1, 1); PG8_STAGE(PG8_SA(1, 0), a3, voffA);
            PG8_BAR; PG8_WAIT_L(0); PG8_MMA(1, 0, At, B0); PG8_BAR; PG8_SCHED;
            PG8_STAGE(PG8_SB(1, 1), b3 + hstep, voffB);
            PG8_WAIT_V(6); PG8_BAR; PG8_MMA(1, 1, At, B1); PG8_BAR;
            }
        }
        if constexpr (ALIGN_EPI) { if (wr == 0) PG8_BAR; }
        if constexpr (!Epi::AFTER_DRAIN) { E(acc, cur, wr, wc, fr, fq, pre); S.done(cur); }
        if (!has_next) break;
#pragma unroll
        for (int a = 0; a < 2; ++a)
#pragma unroll
            for (int b = 0; b < 2; ++b)
#pragma unroll
                for (int m = 0; m < 4; ++m)
#pragma unroll
                    for (int n = 0; n < 2; ++n) acc[a][b][m][n] = (f32x4){0.f, 0.f, 0.f, 0.f};
        cur = nxt; cA = nA; cB = nB; ++ui;
        if constexpr (ALIGN_EPI) { if (wr == 1) PG8_BAR; }
    }
    PG8_WAIT_V(0);
    if constexpr (!ALIGN_EPI) { if (wr == 0) PG8_BAR; }
    PG8_BAR;
    if constexpr (Epi::AFTER_DRAIN) { E.fused(acc, cur, wr, wc, fr, fq, lds, wid, lane); S.done(cur); }
#undef PG8_SA
#undef PG8_SB
#undef PG8_STAGE
#undef PG8_LDA
#undef PG8_LDB
#undef PG8_MMA
#undef PG8_WAIT_V
#undef PG8_WAIT_L
#undef PG8_BAR
#undef PG8_SCHED
}
}
#define PG8_SP2 true
#define PG8_ALIGN true
#define XB_TMO      128
#define XB_XCNT(j)  (256  + 64 * (j))
#define XB_XSUB(j)  (1280 + 64 * (j))
#define XB_XGEN(j)  (2304 + 64 * (j))
#define XB_TOP      3328
#define XB_TOPGEN   3392
#define XCD_BAR_WORDS 3456
#define XB_SPIN_CAP (1u << 18)


__device__ __forceinline__ unsigned xb_ld(unsigned* p)              { return __hip_atomic_load(p, __ATOMIC_RELAXED, __HIP_MEMORY_SCOPE_AGENT); }
__device__ __forceinline__ unsigned xb_add(unsigned* p, unsigned v) { return __hip_atomic_fetch_add(p, v, __ATOMIC_RELAXED, __HIP_MEMORY_SCOPE_AGENT); }
__device__ __forceinline__ unsigned xb_xcc_id() { return (unsigned)__builtin_amdgcn_s_getreg((3 << 11) | 20) & 0xFu; }
#define XB_SPIN(cond, bar) do { unsigned _sp = 0; while (cond) { __builtin_amdgcn_s_sleep(1); \
    if ((++_sp & 255u) == 0u) { if (xb_ld(&(bar)[XB_TMO])) break; if (_sp > XB_SPIN_CAP) { atomicAdd(&(bar)[XB_TMO], 1u); break; } } } } while (0)

struct XcdBarrier {
    unsigned* bar; unsigned x;
    volatile LAS unsigned* st;
};

__device__ __forceinline__ XcdBarrier xcd_barrier_post(unsigned* bar, volatile LAS unsigned* st) {
    XcdBarrier b; b.bar = bar; b.x = xb_xcc_id(); b.st = st;
    if (threadIdx.x == 0) (void)xb_add(&bar[XB_XCNT(b.x)], 1u);
    return b;
}
__device__ __forceinline__ void xcd_barrier_complete(unsigned* bar, unsigned x, unsigned& nloc, unsigned& nx) {
    const unsigned G = gridDim.x * gridDim.y * gridDim.z;
    unsigned sum, cnt, mine, sp = 0u;
    for (;;) {
        sum = 0u; cnt = 0u; mine = 0u;
#pragma unroll
        for (unsigned j = 0; j < 16; ++j) { const unsigned c = xb_ld(&bar[XB_XCNT(j)]); sum += c; cnt += (c > 0u) ? 1u : 0u; mine = (j == x) ? c : mine; }
        if (sum == G) break;
        __builtin_amdgcn_s_sleep(1);
        if ((++sp & 255u) == 0u) { if (xb_ld(&bar[XB_TMO])) break; if (sp > XB_SPIN_CAP) { atomicAdd(&bar[XB_TMO], 1u); break; } }
    }
    nloc = mine > 0u ? mine : 1u; nx = cnt > 0u ? cnt : 1u;
}

__device__ __forceinline__ void xcd_barrier(const XcdBarrier& b) {
    asm volatile("s_waitcnt vmcnt(0)" ::: "memory");
    __syncthreads();
    if (threadIdx.x == 0) {
        unsigned* bar = b.bar;
        __builtin_amdgcn_s_waitcnt(0);
        unsigned nloc = b.st[0], nx = b.st[1];
        if (nloc == 0u) { xcd_barrier_complete(bar, b.x, nloc, nx); b.st[0] = nloc; b.st[1] = nx; }
        const unsigned old = xb_add(&bar[XB_XSUB(b.x)], 1u);
        const unsigned gen = old / nloc;
        if (old + 1u == (gen + 1u) * nloc) {
            __builtin_amdgcn_fence(__ATOMIC_RELEASE, "agent");
            asm volatile("s_waitcnt vmcnt(0)" ::: "memory");
            const unsigned og = xb_add(&bar[XB_TOP], 1u);
            const unsigned tg = og / nx;
            if (og + 1u == (tg + 1u) * nx) xb_add(&bar[XB_TOPGEN], 1u);
            else XB_SPIN(xb_ld(&bar[XB_TOPGEN]) == tg, bar);
            __builtin_amdgcn_fence(__ATOMIC_ACQUIRE, "agent");
            xb_add(&bar[XB_XGEN(b.x)], 1u);
            asm volatile("s_waitcnt vmcnt(0)" ::: "memory");
        } else {
            XB_SPIN(xb_ld(&bar[XB_XGEN(b.x)]) == gen, bar);
            __builtin_amdgcn_fence(__ATOMIC_ACQUIRE, "agent");
            asm volatile("s_waitcnt vmcnt(0)" ::: "memory");
        }
    }
    __syncthreads();
}

constexpr size_t MiB = 1u << 20;
constexpr size_t WS_CTL = 0, CTL_ZERO_BYTES = 1 * MiB;
constexpr size_t WS_WFIN = 1 * MiB;
constexpr size_t WS_WFOUT = 33 * MiB;
constexpr size_t WS_WINE = 49 * MiB;
constexpr size_t WS_WOUTE = 54 * MiB;
constexpr size_t WS_WINO = 56 * MiB;
constexpr size_t WS_WOUTO = 65 * MiB;
constexpr size_t WS_X = 68 * MiB;
constexpr size_t WS_XN = 134 * MiB;
constexpr size_t WS_H = 167 * MiB;
constexpr size_t WS_PROJ = 233 * MiB;
constexpr size_t WS_QB = 374 * MiB;
constexpr size_t WS_KB = 391 * MiB;
constexpr size_t WS_VT = 408 * MiB;
constexpr size_t WS_VS = 424 * MiB;
constexpr size_t WS_AO = 425 * MiB;
constexpr size_t WS_HL = 458 * MiB;
constexpr size_t WS_PP = 474 * MiB;
constexpr size_t WS_AGG = 490 * MiB;
constexpr size_t WS_UV = 491 * MiB, WS_WK = 523 * MiB, WS_QG = 555 * MiB, WS_KGT = 587 * MiB;
constexpr size_t WS_PM = 619 * MiB;
constexpr size_t WS_GL = 635 * MiB;
constexpr size_t WS_OR = 636 * MiB;
constexpr size_t WS_SPART = 668 * MiB;
constexpr size_t WS_END = 672 * MiB;
constexpr int CW_BAR = 4096;
constexpr int CW_SSQ = 65536;
constexpr int CW_SMPCNT = 32768;
constexpr int CW_QUEUE = 16384;

constexpr size_t O_YP = 0, O_YS = 16777216, O_KP = 17301504, O_VP = 25690112, O_LCP = 34078720, O_LHP = 34084864, O_DCP = 34086912, O_DSP = 34123776,
                 O_KS = 34648064, O_VS = 34910208, O_LCS = 35172352, O_LHS = 35368960, O_DCS = 35434496, O_DSS = 36614144, O_END = 53391360;

constexpr int RING_BYTES = 131072;
constexpr int LDSCTL_OFF = RING_BYTES;
constexpr int LDS_BYTES = 147456;

enum InIdx { I_XP = 0, I_XS, I_CK, I_CV, I_SLC, I_SLH, I_SDC, I_SDS, I_PT, I_NF1, I_WF1I, I_WF1O, I_NM, I_NF2, I_WF2I, I_WF2O,
             I_WINE, I_QG, I_KG, I_SBB, I_LCW, I_LCB, I_LWA, I_LBA, I_LWI, I_LBI, I_LAM, I_WOUTE, I_WINO, I_DCW, I_DAL, I_DDT, I_DOG, I_WOUTO, N_IN };
struct Params { const void* in[N_IN]; float* out; unsigned char* ws; int ph_lo, ph_hi, mode, pad; };
static_assert(sizeof(Params) == (N_IN + 2) * 8 + 16, "Params has no padding");

constexpr int NWAVES = 8, NTHR = 512;
constexpr int PH_PRO = 0, PH_L0 = 1, PH_PER_LAYER = 9, NPH = 1 + 2 * PH_PER_LAYER;
enum LayerPhase { LP_FIN1 = 0, LP_FOUT1, LP_PROJ, LP_MIXA, LP_MIXB, LP_MIXC, LP_OUT, LP_FIN2, LP_FOUT2 };

struct RowId { DI int operator()(int n) const { return n; } };
struct RowSwiglu { DI int operator()(int n) const { return n < DFF ? ((n >> 7) << 8) + (n & 127) : (((n - DFF) >> 7) << 8) + 128 + ((n - DFF) & 127); } };
template <class RM> DI void transpose_item(const float* W, int K, int N, bf16* WT, RM rm, LAS float* scrf, int item, int lane, const float* gain = nullptr) {
    LAS bf16* scr = (LAS bf16*)scrf;
    const int nblk = (N + 63) / 64, kb = item / nblk, nb = item % nblk, k0 = 64 * kb, n0 = 64 * nb;
    { const int kk = lane >> 4, n4 = 4 * (lane & 15); const bool ok = n0 + n4 < N;
      f32x4 v[16];
#pragma unroll
      for (int i = 0; i < 16; ++i) v[i] = ok ? *(const f32x4*)(W + (size_t)(k0 + 4 * i + kk) * N + n0 + n4) : (f32x4){0.f, 0.f, 0.f, 0.f};
      if (gain) {
#pragma unroll
          for (int i = 0; i < 16; ++i) v[i] = v[i] * gain[k0 + 4 * i + kk]; }
#pragma unroll
      for (int i = 0; i < 16; ++i) { u32x2 w; w.x = pk2(v[i][0], v[i][1]); w.y = pk2(v[i][2], v[i][3]); *(LAS u32x2*)(scr + (4 * i + kk) * 68 + n4) = w; } }
    LDS_WAIT(); asm volatile("" ::: "memory");
    const int c = lane & 7;
#pragma unroll
    for (int j = 0; j < 8; ++j) { const int nn = (lane >> 3) + 8 * j, n = n0 + nn; const LAS bf16* s = scr + (8 * c) * 68 + nn;
        u32x4 o;
#pragma unroll
        for (int q = 0; q < 4; ++q) o[q] = (unsigned)s[(2 * q) * 68] | ((unsigned)s[(2 * q + 1) * 68] << 16);
        if (n < N) *(u32x4*)(WT + (size_t)rm(n) * K + k0 + 8 * c) = o; }
    LDS_WAIT(); asm volatile("" ::: "memory");
}
constexpr int I_FIN = (DM / 64) * (2 * DFF / 64), I_FOUT = (DFF / 64) * (DM / 64), I_INE = (DM / 64) * (EVEN_IN / 64), I_SQ = (DM / 64) * (DM / 64), I_INO = (DM / 64) * ((ODD_IN + 63) / 64);
constexpr int IT_FIN = 0, IT_FOUT = 4 * I_FIN, IT_INE = IT_FOUT + 4 * I_FOUT, IT_OUTE = IT_INE + I_INE, IT_OUTO = IT_OUTE + I_SQ, IT_INO = IT_OUTO + I_SQ;
DI void convert_item(const Params& p, LAS float* scr, int it, int lane) {
    unsigned char* ws = p.ws;
    int r = it;
    if (r < 4 * I_FIN) { const int w = r / I_FIN, l = w >> 1, which = w & 1;
        transpose_item((const float*)p.in[which ? I_WF2I : I_WF1I] + (size_t)l * DM * 2 * DFF, DM, 2 * DFF, (bf16*)(ws + WS_WFIN) + (size_t)w * 2 * DFF * DM, RowSwiglu(), scr, r % I_FIN, lane, (const float*)p.in[which ? I_NF2 : I_NF1] + l * DM); return; }
    r -= 4 * I_FIN;
    if (r < 4 * I_FOUT) { const int w = r / I_FOUT, l = w >> 1, which = w & 1;
        transpose_item((const float*)p.in[which ? I_WF2O : I_WF1O] + (size_t)l * DFF * DM, DFF, DM, (bf16*)(ws + WS_WFOUT) + (size_t)w * DM * DFF, RowId(), scr, r % I_FOUT, lane); return; }
    r -= 4 * I_FOUT;
    if (r < I_INE) { transpose_item((const float*)p.in[I_WINE], DM, EVEN_IN, (bf16*)(ws + WS_WINE), RowId(), scr, r, lane, (const float*)p.in[I_NM]); return; }
    r -= I_INE;
    if (r < I_SQ) { transpose_item((const float*)p.in[I_WOUTE], DM, DM, (bf16*)(ws + WS_WOUTE), RowId(), scr, r, lane); return; }
    r -= I_SQ;
    if (r < I_SQ) { transpose_item((const float*)p.in[I_WOUTO], DM, DM, (bf16*)(ws + WS_WOUTO), RowId(), scr, r, lane); return; }
    r -= I_SQ;
    transpose_item((const float*)p.in[I_WINO], DM, ODD_IN, (bf16*)(ws + WS_WINO), RowId(), scr, r, lane, (const float*)p.in[I_NM] + DM);
}
constexpr int DEF_N = I_FIN + I_FOUT + I_SQ;
DI int defer_item(int v) { return v < I_FIN ? IT_FIN + 3 * I_FIN + v : v < I_FIN + I_FOUT ? IT_FOUT + 3 * I_FOUT + (v - I_FIN) : IT_OUTO + (v - I_FIN - I_FOUT); }
DI bool is_deferred(int it) { return (it >= IT_FIN + 1 * I_FIN && it < IT_FIN + 4 * I_FIN) || (it >= IT_FOUT + 1 * I_FOUT && it < IT_FOUT + 4 * I_FOUT) || (it >= IT_OUTE); }
constexpr int DEF3_A = I_FIN + I_FOUT + I_SQ, DEF3_N = DEF3_A + I_FIN + I_FOUT + I_INO;
DI int defer3_item(int v) { if (v < DEF3_A) return v < I_FIN ? IT_FIN + 1 * I_FIN + v : v < I_FIN + I_FOUT ? IT_FOUT + 1 * I_FOUT + (v - I_FIN) : IT_OUTE + (v - I_FIN - I_FOUT);
    v -= DEF3_A; return v < I_FIN ? IT_FIN + 2 * I_FIN + v : v < I_FIN + I_FOUT ? IT_FOUT + 2 * I_FOUT + (v - I_FIN) : IT_INO + (v - I_FIN - I_FOUT); }
DI void phase_prologue(const Params& p, LAS unsigned char* lds, int gw, int NGW, int wave, int lane) {
    LAS float* scr = (LAS float*)(lds + wave * 16384);
    constexpr int NPRO = I_FIN + I_FOUT + I_INE, NIW = NPRO / 4;
    if (NGW > 2 * NIW) { if (gw < NIW) for (int v = gw; v < NPRO; v += NIW) convert_item(p, scr, v < I_FIN ? IT_FIN + v : v < I_FIN + I_FOUT ? IT_FOUT + (v - I_FIN) : IT_INE + (v - I_FIN - I_FOUT), lane); }
    else { constexpr int NITEMS = IT_INO + I_INO; for (int it = gw; it < NITEMS; it += NGW) if (!is_deferred(it)) convert_item(p, scr, it, lane); }
    { u32x4* z = (u32x4*)((bf16*)(p.ws + WS_WINO) + (size_t)ODD_IN * DM); const int n16 = (ODD_PAD - ODD_IN) * DM * 2 / 16;
      for (int i = gw * 64 + lane; i < n16; i += NGW * 64) z[i] = (u32x4){0u, 0u, 0u, 0u}; }
}
DI void phase_input_rows(const float* src_p, const float* src_s, bf16* xb, float* ssq, int gw, int NGW, int lane) {
    for (int m = gw; m < MT; m += 2 * NGW) {
        const int m1 = m + NGW < MT ? m + NGW : m;
        const float* r0 = m < MP ? src_p + (size_t)m * DM : src_s + (size_t)(m - MP) * DM;
        const float* r1 = m1 < MP ? src_p + (size_t)m1 * DM : src_s + (size_t)(m1 - MP) * DM;
        const f32x4* x0 = (const f32x4*)r0 + lane; const f32x4* x1 = (const f32x4*)r1 + lane; f32x4 v[4], w[4]; float s = 0.f, t = 0.f;
#pragma unroll
        for (int j = 0; j < 4; ++j) { v[j] = x0[64 * j]; w[j] = x1[64 * j]; }
#pragma unroll
        for (int j = 0; j < 4; ++j) { s += (v[j].x * v[j].x + v[j].y * v[j].y) + (v[j].z * v[j].z + v[j].w * v[j].w); t += (w[j].x * w[j].x + w[j].y * w[j].y) + (w[j].z * w[j].z + w[j].w * w[j].w); }
        s = wave_sum(s); t = wave_sum(t);
        u32x2* o0 = (u32x2*)(xb + (size_t)m * DM) + lane; u32x2* o1 = (u32x2*)(xb + (size_t)m1 * DM) + lane;
#pragma unroll
        for (int j = 0; j < 4; ++j) { u32x2 a; a.x = pk2(v[j].x, v[j].y); a.y = pk2(v[j].z, v[j].w); o0[64 * j] = a; }
        if (m1 != m) {
#pragma unroll
            for (int j = 0; j < 4; ++j) { u32x2 a; a.x = pk2(w[j].x, w[j].y); a.y = pk2(w[j].z, w[j].w); o1[64 * j] = a; } }
        if (lane == 0) { ((unsigned*)ssq)[m] = (unsigned)(s * 1024.f + 0.5f); if (m1 != m) ((unsigned*)ssq)[m1] = (unsigned)(t * 1024.f + 0.5f); }
    }
}
constexpr int GS_LD = 72;
template <int ROWS> struct GsRegs { u32x4 a[ROWS / 64], b; };
template <int ROWS> DI void gs_load(GsRegs<ROWS>& R, const bf16* ap, const bf16* bp, int K, int kt) {
#pragma unroll
    for (int rep = 0; rep < ROWS / 64; ++rep) R.a[rep] = *(const u32x4*)(ap + (size_t)(64 * rep) * K + kt * 64);
    R.b = *(const u32x4*)(bp + kt * 64);
}
template <int ROWS> DI void gs_store(const GsRegs<ROWS>& R, LAS unsigned char* buf, int soff) {
#pragma unroll
    for (int rep = 0; rep < ROWS / 64; ++rep) *(LAS u32x4*)(buf + soff + rep * (64 * GS_LD * 2)) = R.a[rep];
    *(LAS u32x4*)(buf + ROWS * GS_LD * 2 + soff) = R.b;
}
template <int ROWS> DI void gs_compute(f32x16& acc0, f32x16& acc1, const LAS unsigned char* ab, int wave, int r, int h2) {
    const LAS unsigned char* bb = ab + ROWS * GS_LD * 2;
#pragma unroll
    for (int s = 0; s < 4; ++s) {
        const bf16x8 a = *(const LAS bf16x8*)(ab + ((32 * wave + r) * GS_LD + 16 * s + 8 * h2) * 2);
        const bf16x8 b0 = *(const LAS bf16x8*)(bb + (r * GS_LD + 16 * s + 8 * h2) * 2), b1 = *(const LAS bf16x8*)(bb + ((32 + r) * GS_LD + 16 * s + 8 * h2) * 2);
        acc0 = MFMA32(a, b0, acc0); acc1 = MFMA32(a, b1, acc1);
    }
}
template <int ROWS, class Epi> DI void gemm_small_unit(LAS unsigned char* lds, const bf16* A, const bf16* Bt, int K, int m0, int n0, int n1, const Epi& E, int tid_, int wave) {
    constexpr int BUF = (ROWS + 64) * GS_LD * 2;
    int tid = tid_; asm volatile("" : "+v"(tid));
    const int lane = tid & 63, r = lane & 31, h2 = lane >> 5;
    const int arow = tid >> 3, ck = tid & 7;
    const bf16* ap = A + (size_t)(m0 + arow) * K + ck * 8;
    const bf16* bp = Bt + (size_t)(arow < 32 ? n0 + arow : n1 + arow - 32) * K + ck * 8;
    const int soff = (arow * GS_LD + ck * 8) * 2;
    f32x16 acc0, acc1;
#pragma unroll
    for (int i = 0; i < 16; ++i) { acc0[i] = 0.f; acc1[i] = 0.f; }
    GsRegs<ROWS> R0, R1, R2, R3;
    gs_load<ROWS>(R0, ap, bp, K, 0); gs_load<ROWS>(R1, ap, bp, K, 1); gs_load<ROWS>(R2, ap, bp, K, 2); gs_load<ROWS>(R3, ap, bp, K, 3);
    gs_store<ROWS>(R0, lds, soff);
    __syncthreads();
    const int nkt = K >> 6;
#define GS_STEP(RF, RN, t) do { gs_load<ROWS>(RF, ap, bp, K, ((t) + 4 < nkt) ? (t) + 4 : nkt - 1); \
        if (wave < ROWS / 32) gs_compute<ROWS>(acc0, acc1, lds + ((t) & 1) * BUF, wave, r, h2); \
        gs_store<ROWS>(RN, lds + (((t) + 1) & 1) * BUF, soff); \
        __syncthreads(); } while (0)
#pragma unroll 1
    for (int kt = 0; kt < nkt; kt += 4) { GS_STEP(R0, R1, kt); GS_STEP(R1, R2, kt + 1); GS_STEP(R2, R3, kt + 2); GS_STEP(R3, R0, kt + 3); }
#undef GS_STEP
    if (wave < ROWS / 32) E(acc0, acc1, m0 + 32 * wave, n0, n1, r, h2);
}
struct SEpiSwiglu { bf16* H; int colbase; const float* ssq;
    DI void operator()(const f32x16& a0, const f32x16& a1, int row0, int, int, int r, int h2) const {
#pragma unroll
        for (int i = 0; i < 16; ++i) { const int row = row0 + (i & 3) + 8 * (i >> 2) + 4 * h2; const float rs = pg8::row_rstd(ssq, row); H[(size_t)row * DFF + colbase + r] = f2bf(fsilu(a0[i] * rs) * (a1[i] * rs)); } } };
template <bool BASE_F32, bool OUT_F32> struct SEpiResT { const void* base; void* out; float* ssq; float alpha;
    DI void operator()(const f32x16& a0, const f32x16& a1, int row0, int n0, int n1, int r, int h2) const {
#pragma unroll
        for (int i = 0; i < 16; ++i) { const int row = row0 + (i & 3) + 8 * (i >> 2) + 4 * h2; const size_t ol = (size_t)(row - MP) * DM, og = (size_t)row * DM;
            const float b0 = BASE_F32 ? ((const float*)base)[ol + n0 + r] : bf2f(((const bf16*)base)[og + n0 + r]), b1 = BASE_F32 ? ((const float*)base)[ol + n1 + r] : bf2f(((const bf16*)base)[og + n1 + r]);
            const float v0 = b0 + alpha * a0[i], v1 = b1 + alpha * a1[i];
            if (OUT_F32) { ((float*)out)[ol + n0 + r] = v0; ((float*)out)[ol + n1 + r] = v1; } else { ((bf16*)out)[og + n0 + r] = f2bf(v0); ((bf16*)out)[og + n1 + r] = f2bf(v1); }
            if (ssq) { float s = v0 * v0 + v1 * v1;
#pragma unroll
                for (int of = 1; of < 32; of <<= 1) s += __shfl_xor(s, of);
                if (r == 0) pg8::ssq_add(ssq, row, s); } } } };
struct SEpiProj { bf16* O; int ldc; const float* ssq;
    DI void operator()(const f32x16& a0, const f32x16& a1, int row0, int n0, int n1, int r, int h2) const {
#pragma unroll
        for (int i = 0; i < 16; ++i) { const int row = row0 + (i & 3) + 8 * (i >> 2) + 4 * h2; const float rs = pg8::row_rstd(ssq, row); const size_t o = (size_t)row * ldc; O[o + n0 + r] = f2bf(a0[i] * rs); O[o + n1 + r] = f2bf(a1[i] * rs); } } };
DI void qkv_row(const Params& p, const bf16* PROJ, int m, int lane, float* kout, float* vout, u32x4& vraw) {
    bf16* QB = (bf16*)(p.ws + WS_QB); bf16* KB = (bf16*)(p.ws + WS_KB);
    const bf16* pr = PROJ + (size_t)m * EVEN_IN;
    const u32x4 q8 = *(const u32x4*)(pr + 8 * lane), k8 = *(const u32x4*)(pr + SBW + 8 * lane), v8 = *(const u32x4*)(pr + 2 * SBW + 8 * lane);
    float q[8], k[8], v[8];
#pragma unroll
    for (int j = 0; j < 4; ++j) { q[2 * j] = bflo(q8[j]); q[2 * j + 1] = bfhi(q8[j]); k[2 * j] = bflo(k8[j]); k[2 * j + 1] = bfhi(k8[j]); v[2 * j] = bflo(v8[j]); v[2 * j + 1] = bfhi(v8[j]); }
    float sq = 0.f, sk = 0.f;
#pragma unroll
    for (int j = 0; j < 8; ++j) { sq += q[j] * q[j]; sk += k[j] * k[j]; }
#pragma unroll
    for (int o = 1; o < 8; o <<= 1) { sq += __shfl_xor(sq, o); sk += __shfl_xor(sk, o); }
    const float rq = frsq(sq * (1.f / SBD) + EPS) * (0.125f * LOG2E), rk = frsq(sk * (1.f / SBD) + EPS);
    const float* qg = (const float*)p.in[I_QG] + 8 * (lane & 7); const float* kg = (const float*)p.in[I_KG] + 8 * (lane & 7);
    const f32x4 qg0 = *(const f32x4*)qg, qg1 = *(const f32x4*)(qg + 4), kg0 = *(const f32x4*)kg, kg1 = *(const f32x4*)(kg + 4);
    float qn[8], kn[8];
#pragma unroll
    for (int j = 0; j < 4; ++j) { qn[j] = q[j] * rq * qg0[j]; qn[4 + j] = q[4 + j] * rq * qg1[j]; kn[j] = k[j] * rk * kg0[j]; kn[4 + j] = k[4 + j] * rk * kg1[j]; }
    u32x4 qo, ko;
#pragma unroll
    for (int j = 0; j < 4; ++j) { qo[j] = pk2(qn[2 * j], qn[2 * j + 1]); ko[j] = pk2(kn[2 * j], kn[2 * j + 1]); }
    *(u32x4*)(QB + (size_t)m * SBW + 8 * lane) = qo; *(u32x4*)(KB + (size_t)m * SBW + 8 * lane) = ko;
    *(f32x4*)(kout + 8 * lane) = (f32x4){kn[0], kn[1], kn[2], kn[3]}; *(f32x4*)(kout + 8 * lane + 4) = (f32x4){kn[4], kn[5], kn[6], kn[7]};
    *(f32x4*)(vout + 8 * lane) = (f32x4){v[0], v[1], v[2], v[3]}; *(f32x4*)(vout + 8 * lane + 4) = (f32x4){v[4], v[5], v[6], v[7]};
    vraw = v8;
}
DI void lru_ab(float r_pre, float i_pre, float xc, float sp_lam8, float& a, float& b) {
    const float rr = fsigmoid(r_pre), ii = fsigmoid(i_pre);
    const float log_a = -sp_lam8 * rr;
    a = fexp2(log_a * LOG2E);
    b = __builtin_amdgcn_sqrtf(fnegexpm1(2.0f * log_a)) * (ii * xc);
}
DI void phase_even_a(const Params& p, LAS unsigned char* lds, int tid, int lane_, int wave, int G) {
    unsigned char* ws = p.ws;
    const bf16* PROJ = (const bf16*)(ws + WS_PROJ);
    bf16* VT = (bf16*)(ws + WS_VT); bf16* VS = (bf16*)(ws + WS_VS); bf16* AO = (bf16*)(ws + WS_AO);
    bf16* HL = (bf16*)(ws + WS_HL); bf16* PP = (bf16*)(ws + WS_PP); float* AGG = (float*)(ws + WS_AGG);
    constexpr int VLD = SBW + 8;
    LAS bf16* vt = (LAS bf16*)lds;
    LAS float* xc = (LAS float*)lds;
    const int ch0 = tid, lane0 = lane_;
    const float* cw = (const float*)p.in[I_LCW];
    const float cw0 = cw[ch0], cw1 = cw[LRW + ch0], cw2 = cw[2 * LRW + ch0], cw3 = cw[3 * LRW + ch0], cb = ((const float*)p.in[I_LCB])[ch0];
    const float b_a = ((const float*)p.in[I_LBA])[ch0], b_i = ((const float*)p.in[I_LBI])[ch0];
    const float sp_lam8 = 8.0f * fsoftplus(-((const float*)p.in[I_LAM])[ch0]);
    f32x2 wa[32], wi[32];
    { const float* pa = (const float*)p.in[I_LWA] + (size_t)wave * 4096 + lane0; const float* pi = (const float*)p.in[I_LWI] + (size_t)wave * 4096 + lane0;
#pragma unroll
      for (int c = 0; c < 32; ++c) { wa[c].x = pa[(2 * c) * 64]; wa[c].y = pa[(2 * c + 1) * 64]; wi[c].x = pi[(2 * c) * 64]; wi[c].y = pi[(2 * c + 1) * 64]; } }
    for (int unit = blockIdx.x; unit < NB_P * 64 + NB_S; unit += G) {
        const bool smp = unit >= NB_P * 64;
        if (!smp) {
            const int b = unit >> 6, c = unit & 63, t0 = c * 64, m0 = b * T_P + t0;
            int tidv = tid; asm volatile("" : "+v"(tidv)); const int lane = tidv & 63, ch = tidv;
#pragma unroll 2
            for (int i = 0; i < 8; ++i) { const int tl = wave * 8 + i, m = m0 + tl; u32x4 vraw;
                qkv_row(p, PROJ, m, lane, p.out + O_KP + (size_t)m * SBW, p.out + O_VP + (size_t)m * SBW, vraw);
                *(LAS u32x4*)(vt + tl * VLD + 8 * lane) = vraw; }
            __syncthreads();
            { const int col = tidv; bf16* dst = VT + ((size_t)(b * SBH) * SBD + col) * T_P + t0;
#pragma unroll
              for (int j = 0; j < 8; ++j) { unsigned w[4];
#pragma unroll
                  for (int i = 0; i < 4; ++i) w[i] = (unsigned)vt[(8 * j + 2 * i) * VLD + col] | ((unsigned)vt[(8 * j + 2 * i + 1) * VLD + col] << 16);
                  *(u32x4*)(dst + 8 * j) = (u32x4){w[0], w[1], w[2], w[3]}; } }
            __syncthreads();
            float x0 = 0.f, x1 = 0.f, x2 = 0.f;
            if (c > 0) { x0 = bf2f(PROJ[(size_t)(m0 - 3) * EVEN_IN + 3 * SBW + ch]); x1 = bf2f(PROJ[(size_t)(m0 - 2) * EVEN_IN + 3 * SBW + ch]); x2 = bf2f(PROJ[(size_t)(m0 - 1) * EVEN_IN + 3 * SBW + ch]); }
#pragma unroll 1
            for (int tb = 0; tb < 64; tb += 16) {
                bf16 xr[16];
#pragma unroll
                for (int t = 0; t < 16; ++t) xr[t] = PROJ[(size_t)(m0 + tb + t) * EVEN_IN + 3 * SBW + ch];
#pragma unroll
                for (int t = 0; t < 16; ++t) { const float x3 = bf2f(xr[t]); xc[(tb + t) * LRW + ch] = cb + cw0 * x0 + cw1 * x1 + cw2 * x2 + cw3 * x3; x0 = x1; x1 = x2; x2 = x3; } }
            if (c == 63) { float* o = p.out + O_LCP + (size_t)b * 3 * LRW + ch; o[0] = x0; o[LRW] = x1; o[2 * LRW] = x2; }
            __syncthreads();
            float h = 0.f, P = 1.f;
#pragma unroll 1
            for (int t = 0; t < 64; ++t) {
                const LAS f32x4* xr4 = (const LAS f32x4*)(xc + t * LRW + wave * 64);
                f32x2 ra = {b_a, 0.f}, rb = {0.f, 0.f}, ia = {b_i, 0.f}, ib = {0.f, 0.f};
#pragma unroll
                for (int c4 = 0; c4 < 16; ++c4) { const f32x4 x = xr4[c4];
                    const f32x2 xl = {x[0], x[1]}, xh = {x[2], x[3]};
                    ra = __builtin_elementwise_fma(xl, wa[2 * c4], ra); rb = __builtin_elementwise_fma(xh, wa[2 * c4 + 1], rb);
                    ia = __builtin_elementwise_fma(xl, wi[2 * c4], ia); ib = __builtin_elementwise_fma(xh, wi[2 * c4 + 1], ib);
                    if ((c4 & 3) == 3) asm volatile("" ::: "memory"); }
                float a, bb; lru_ab((ra.x + ra.y) + (rb.x + rb.y), (ia.x + ia.y) + (ib.x + ib.y), xc[t * LRW + ch], sp_lam8, a, bb);
                h = a * h + bb; P *= a;
                HL[(size_t)(m0 + t) * LRW + ch] = f2bf(h); PP[(size_t)(m0 + t) * LRW + ch] = f2bf(P);
            }
            AGG[((size_t)(b * 64 + c) * 2 + 0) * LRW + ch] = P; AGG[((size_t)(b * 64 + c) * 2 + 1) * LRW + ch] = h;
            __syncthreads();
        } else {
            const int s = unit - NB_P * 64, m0 = MP + 4 * s;
            int chs = tid; asm volatile("" : "+v"(chs)); const int lane = chs & 63;
            if (wave < 4) { const int m = m0 + wave; u32x4 vraw;
                qkv_row(p, PROJ, m, lane, p.out + O_KS + (size_t)(4 * s + wave) * SBW, p.out + O_VS + (size_t)(4 * s + wave) * SBW, vraw);
                *(u32x4*)(VS + (size_t)(4 * s + wave) * SBW + 8 * lane) = vraw; }
            const float* st = (const float*)p.in[I_SLC] + (size_t)s * 3 * LRW + chs;
            float xp[7]; xp[0] = st[0]; xp[1] = st[LRW]; xp[2] = st[2 * LRW];
#pragma unroll
            for (int t = 0; t < 4; ++t) xp[3 + t] = bf2f(PROJ[(size_t)(m0 + t) * EVEN_IN + 3 * SBW + chs]);
#pragma unroll
            for (int t = 0; t < 4; ++t) xc[t * LRW + chs] = cb + cw0 * xp[t] + cw1 * xp[t + 1] + cw2 * xp[t + 2] + cw3 * xp[t + 3];
            { float* o = p.out + O_LCS + (size_t)s * 3 * LRW + chs; o[0] = xp[4]; o[LRW] = xp[5]; o[2 * LRW] = xp[6]; }
            __syncthreads();
            float h = ((const float*)p.in[I_SLH])[(size_t)s * LRW + chs];
#pragma unroll 1
            for (int t = 0; t < 4; ++t) {
                const LAS f32x4* xr4 = (const LAS f32x4*)(xc + t * LRW + wave * 64);
                f32x2 ra = {b_a, 0.f}, rb = {0.f, 0.f}, ia = {b_i, 0.f}, ib = {0.f, 0.f};
#pragma unroll
                for (int c4 = 0; c4 < 16; ++c4) { const f32x4 x = xr4[c4];
                    const f32x2 xl = {x[0], x[1]}, xh = {x[2], x[3]};
                    ra = __builtin_elementwise_fma(xl, wa[2 * c4], ra); rb = __builtin_elementwise_fma(xh, wa[2 * c4 + 1], rb);
                    ia = __builtin_elementwise_fma(xl, wi[2 * c4], ia); ib = __builtin_elementwise_fma(xh, wi[2 * c4 + 1], ib);
                    if ((c4 & 3) == 3) asm volatile("" ::: "memory"); }
                float a, bb; lru_ab((ra.x + ra.y) + (rb.x + rb.y), (ia.x + ia.y) + (ib.x + ib.y), xc[t * LRW + chs], sp_lam8, a, bb);
                h = a * h + bb;
                const float xg = bf2f(PROJ[(size_t)(m0 + t) * EVEN_IN + 4 * SBW + chs]);
                AO[(size_t)(m0 + t) * DM + SBW + chs] = f2bf(h * fgelu_tanh(xg));
            }
            (p.out + O_LHS)[(size_t)s * LRW + chs] = h;
            __syncthreads();
        }
    }
}
DI unsigned queue_next(unsigned* head, volatile LAS unsigned* slot, int tid) {
    if (tid == 0) *slot = __hip_atomic_fetch_add(head, 1u, __ATOMIC_RELAXED, __HIP_MEMORY_SCOPE_AGENT);
    __syncthreads();
    const unsigned u = __builtin_amdgcn_readfirstlane(*slot);
    __syncthreads();
    return u;
}
template <int CTRL> DI float dppf(float x) { return __builtin_bit_cast(float, __builtin_amdgcn_mov_dpp(__builtin_bit_cast(int, x), CTRL, 0xf, 0xf, true)); }
struct SmpAcc { float carry; f32x4 acc[4]; };
struct SmpKV { f32x4 k[4], v[4]; };
DI void smp_key(SmpAcc& A, const f32x4 (&q)[4], const f32x4 K4, const f32x4 V4, float bias2, int c, bool masked) {
    const f32x2 Kl = __builtin_shufflevector(K4, K4, 0, 1), Kh = __builtin_shufflevector(K4, K4, 2, 3);
    f32x2 t0 = Kl * __builtin_shufflevector(q[0], q[0], 0, 1), t1 = Kl * __builtin_shufflevector(q[1], q[1], 0, 1), t2 = Kl * __builtin_shufflevector(q[2], q[2], 0, 1), t3 = Kl * __builtin_shufflevector(q[3], q[3], 0, 1);
    t0 = __builtin_elementwise_fma(Kh, __builtin_shufflevector(q[0], q[0], 2, 3), t0); t1 = __builtin_elementwise_fma(Kh, __builtin_shufflevector(q[1], q[1], 2, 3), t1);
    t2 = __builtin_elementwise_fma(Kh, __builtin_shufflevector(q[2], q[2], 2, 3), t2); t3 = __builtin_elementwise_fma(Kh, __builtin_shufflevector(q[3], q[3], 2, 3), t3);
    const float z0 = t0.x + t0.y, z1 = t1.x + t1.y, z2 = t2.x + t2.y, z3 = t3.x + t3.y;
    const bool b0 = c & 1, b1 = c & 2;
    const float y0 = (b0 ? z2 : z0) + dppf<0xB1>(b0 ? z0 : z2), y1 = (b0 ? z3 : z1) + dppf<0xB1>(b0 ? z1 : z3);
    float x = (b1 ? y1 : y0) + dppf<0x4E>(b1 ? y0 : y1);
    x += dppf<0x124>(x); x += dppf<0x128>(x);
    const float zz = fminf(x + bias2, 80.f), e = fexp2(zz); float kp = frcp(1.0f + e), sg = e * kp;
    if (masked) { kp = 1.f; sg = 0.f; }
    const float w = sg * A.carry;
    A.carry *= kp;
    const float w0 = dppf<0x00>(w), w1 = dppf<0xAA>(w), w2 = dppf<0x55>(w), w3 = dppf<0xFF>(w);
    A.acc[0] += V4 * w0; A.acc[1] += V4 * w1; A.acc[2] += V4 * w2; A.acc[3] += V4 * w3;
}
DI void smp_load(SmpKV& R, const float* ck, const float* cv, int phys, int pos0, int hg, int lane) {
    const size_t base = ((size_t)phys * PAGE + pos0) * SBW + hg * 256 + lane * 4;
#pragma unroll
    for (int u = 0; u < 4; ++u) { R.k[u] = __builtin_nontemporal_load((const f32x4*)(ck + base + (size_t)u * SBW)); R.v[u] = __builtin_nontemporal_load((const f32x4*)(cv + base + (size_t)u * SBW)); }
}
DI void attn_sample_unit(const Params& p, LAS unsigned char* lds, int lane_, int wave, int s, int half) {
    unsigned char* ws = p.ws;
    const bf16* QB = (const bf16*)(ws + WS_QB); const bf16* KB = (const bf16*)(ws + WS_KB); const bf16* VS = (const bf16*)(ws + WS_VS); bf16* AO = (bf16*)(ws + WS_AO);
    int lane = lane_; asm volatile("" : "+v"(lane));
    const int hg = wave & 1, seg = wave >> 1, hh = lane >> 4, c = lane & 15, h = 4 * hg + hh, qme = 2 * (c & 1) + ((c >> 1) & 1);
    const float bias2 = ((const float*)p.in[I_SBB])[h] * LOG2E;
    f32x4 q[4];
#pragma unroll
    for (int i = 0; i < 4; ++i) { const u32x2 w = *(const u32x2*)(QB + (size_t)(MP + 4 * s + i) * SBW + h * SBD + 4 * c); q[i] = (f32x4){bflo(w.x), bfhi(w.x), bflo(w.y), bfhi(w.y)}; }
    SmpAcc A; A.carry = 1.f;
#pragma unroll
    for (int i = 0; i < 4; ++i) A.acc[i] = (f32x4){0.f, 0.f, 0.f, 0.f};
    if (half && seg == 0) {
#pragma unroll
        for (int n = 3; n >= 0; --n) { const u32x2 kw = *(const u32x2*)(KB + (size_t)(MP + 4 * s + n) * SBW + h * SBD + 4 * c), vw = *(const u32x2*)(VS + (size_t)(4 * s + n) * SBW + h * SBD + 4 * c);
            smp_key(A, q, (f32x4){bflo(kw.x), bfhi(kw.x), bflo(kw.y), bfhi(kw.y)}, (f32x4){bflo(vw.x), bfhi(vw.x), bflo(vw.y), bfhi(vw.y)}, bias2, c, n >= qme); } }
    const float* ck = (const float*)p.in[I_CK]; const float* cv = (const float*)p.in[I_CV];
    typedef const __attribute__((address_space(4))) int* cint_p;
    cint_p pt = (cint_p)(unsigned long long)p.in[I_PT] + s * NPAGES + half * 8 + 6 - 2 * seg;
    SmpKV R0, R1, R2, R3;
#define SMP_LOAD(R, sidx) do { const int sn_ = (sidx) < 64 ? (sidx) : 63; const int ph_ = __builtin_amdgcn_readfirstlane(pt[1 - (sn_ >> 5)]); smp_load(R, ck, cv, ph_, 124 - 4 * (sn_ & 31), hg, lane); __builtin_amdgcn_sched_barrier(0); } while (0)
#define SMP_COMP(R) do { _Pragma("unroll") for (int u = 3; u >= 0; --u) smp_key(A, q, R.k[u], R.v[u], bias2, c, false); } while (0)
    SMP_LOAD(R0, 0); SMP_LOAD(R1, 1); SMP_LOAD(R2, 2);
#pragma unroll 1
    for (int st = 0; st < 64; st += 4) {
        SMP_LOAD(R3, st + 3); SMP_COMP(R0);
        SMP_LOAD(R0, st + 4); SMP_COMP(R1);
        SMP_LOAD(R1, st + 5); SMP_COMP(R2);
        SMP_LOAD(R2, st + 6); SMP_COMP(R3);
    }
#undef SMP_LOAD
#undef SMP_COMP
    const float P[4] = {dppf<0x00>(A.carry), dppf<0xAA>(A.carry), dppf<0x55>(A.carry), dppf<0xFF>(A.carry)};
    LAS float* xo = (LAS float*)lds;
    LAS float* xp = (LAS float*)(lds + 32768);
#pragma unroll
    for (int i = 0; i < 4; ++i) *(LAS f32x4*)(xo + ((wave * 4 + i) * 64 + lane) * 4) = A.acc[i];
    *(LAS f32x4*)(xp + (wave * 64 + lane) * 4) = (f32x4){P[0], P[1], P[2], P[3]};
    __syncthreads();
    if (seg == 0) {
        f32x4 o[4]; f32x4 pt_ = {1.f, 1.f, 1.f, 1.f};
#pragma unroll
        for (int i = 0; i < 4; ++i) o[i] = (f32x4){0.f, 0.f, 0.f, 0.f};
#pragma unroll
        for (int sg_ = 3; sg_ >= 0; --sg_) { const int wv = 2 * sg_ + hg; const f32x4 ps = *(const LAS f32x4*)(xp + (wv * 64 + lane) * 4);
#pragma unroll
            for (int i = 0; i < 4; ++i) o[i] = *(const LAS f32x4*)(xo + ((wv * 4 + i) * 64 + lane) * 4) + o[i] * ps[i];
            pt_ = pt_ * ps; }
        float* rec = (float*)(ws + WS_SPART) + (size_t)((s * 2 + hg) * 2 + half) * 1280;
#pragma unroll
        for (int i = 0; i < 4; ++i) *(f32x4*)(rec + (i * 64 + lane) * 4) = o[i];
        *(f32x4*)(rec + 1024 + lane * 4) = pt_;
        asm volatile("s_waitcnt vmcnt(0)" ::: "memory");
        __threadfence();
        asm volatile("s_waitcnt vmcnt(0)" ::: "memory");
        unsigned old = 0;
        if (lane == 0) old = __hip_atomic_fetch_add((unsigned*)(ws + WS_CTL) + CW_SMPCNT + s * 2 + hg, 1u, __ATOMIC_RELAXED, __HIP_MEMORY_SCOPE_AGENT);
        old = __builtin_amdgcn_readfirstlane(old);
        if (old == 1u) {
            __threadfence();
            asm volatile("s_waitcnt vmcnt(0)" ::: "memory");
            const float* orec = (const float*)(ws + WS_SPART) + (size_t)((s * 2 + hg) * 2 + (half ^ 1)) * 1280;
            const f32x4 Po = *(const f32x4*)(orec + 1024 + lane * 4);
#pragma unroll
            for (int i = 0; i < 4; ++i) { const f32x4 oo = *(const f32x4*)(orec + (i * 64 + lane) * 4);
                const f32x4 r = half ? o[i] + oo * pt_[i] : oo + o[i] * Po[i];
                u32x2 w; w.x = pk2(r[0], r[1]); w.y = pk2(r[2], r[3]); *(u32x2*)(AO + (size_t)(MP + 4 * s + i) * DM + h * SBD + 4 * c) = w; }
        }
    }
    __syncthreads();
}
DI void lru_fix_unit(const Params& p, int tid, int b, int c) {
    unsigned char* ws = p.ws;
    const bf16* PROJ = (const bf16*)(ws + WS_PROJ); const bf16* HL = (const bf16*)(ws + WS_HL); const bf16* PP = (const bf16*)(ws + WS_PP); const float* AGG = (const float*)(ws + WS_AGG); bf16* AO = (bf16*)(ws + WS_AO);
    int ch = tid; asm volatile("" : "+v"(ch));
    float carry = 0.f;
#pragma unroll 1
    for (int c0 = 0; c0 < c; c0 += 16) { float P[16], hh[16];
#pragma unroll
        for (int j = 0; j < 16; ++j) { const int cc = c0 + j < c ? c0 + j : c - 1; P[j] = AGG[((size_t)(b * 64 + cc) * 2 + 0) * LRW + ch]; hh[j] = AGG[((size_t)(b * 64 + cc) * 2 + 1) * LRW + ch]; }
#pragma unroll
        for (int j = 0; j < 16; ++j) if (c0 + j < c) carry = P[j] * carry + hh[j]; }
    const int m0 = b * T_P + c * 64; float hlast = 0.f;
#pragma unroll 1
    for (int t0 = 0; t0 < 64; t0 += 16) { bf16 hl[16], pp[16], xg[16];
#pragma unroll
        for (int j = 0; j < 16; ++j) { const size_t m = m0 + t0 + j; hl[j] = HL[m * LRW + ch]; pp[j] = PP[m * LRW + ch]; xg[j] = PROJ[m * EVEN_IN + 4 * SBW + ch]; }
#pragma unroll
        for (int j = 0; j < 16; ++j) { const size_t m = m0 + t0 + j; const float hv = bf2f(hl[j]) + bf2f(pp[j]) * carry; hlast = hv; AO[m * DM + SBW + ch] = f2bf(hv * fgelu_tanh(bf2f(xg[j]))); } }
    if (c == 63) (p.out + O_LHP)[(size_t)b * LRW + ch] = hlast;
}
DI void prompt_tile(const LAS unsigned char* kc, const LAS unsigned char* vc, const bf16x8 (&qf)[4], f32x16 (&accO)[2], float& carry, float bias2, int key0, int Q0, int r, int h2) {
    constexpr int KLD = 72, VLD = 68;
    if (key0 < Q0 + 31) {
        f32x16 sk[2];
#pragma unroll
        for (int kb = 0; kb < 2; ++kb) {
#pragma unroll
            for (int i = 0; i < 16; ++i) sk[kb][i] = bias2;
#pragma unroll
            for (int s = 0; s < 4; ++s) { const bf16x8 a = *(const LAS bf16x8*)(kc + (32 * kb + r) * (KLD * 2) + (16 * s + 8 * h2) * 2); sk[kb] = MFMA32(a, qf[s], sk[kb]); }
        }
        const bool need_mask = key0 + 63 >= Q0;
        f32x2 kp[2][8];
#pragma unroll
        for (int kb = 0; kb < 2; ++kb)
#pragma unroll
            for (int pq = 0; pq < 8; ++pq) {
                f32x2 e2; e2.x = fexp2(sk[kb][2 * pq]); e2.y = fexp2(sk[kb][2 * pq + 1]);
                const f32x2 d2 = e2 + 1.0f;
                f32x2 k2; k2.x = frcp(d2.x); k2.y = frcp(d2.y);
                kp[kb][pq] = k2;
            }
        if (need_mask) {
            asm volatile("" ::: "memory");
            const int lim = Q0 + r - key0 - 4 * h2;
#pragma unroll
            for (int kb = 0; kb < 2; ++kb)
#pragma unroll
                for (int pq = 0; pq < 8; ++pq) { const int ko = 32 * kb + ((2 * pq) & 3) + 8 * ((2 * pq) >> 2); if (ko >= lim) kp[kb][pq].x = 1.f; if (ko + 1 >= lim) kp[kb][pq].y = 1.f; }
        }
        float R[2][4], Rp[2][4];
#pragma unroll
        for (int kb = 0; kb < 2; ++kb)
#pragma unroll
            for (int q = 0; q < 4; ++q) { const f32x2 pr = kp[kb][2 * q] * kp[kb][2 * q + 1]; R[kb][q] = pr.x * pr.y; Rp[kb][q] = __shfl_xor(R[kb][q], 32); }
        float c = carry;
#pragma unroll
        for (int kb = 1; kb >= 0; --kb)
#pragma unroll
            for (int q = 3; q >= 0; --q) {
                const float E3 = c * (h2 ? 1.0f : Rp[kb][q]);
                c *= R[kb][q] * Rp[kb][q];
                const f32x2 ka = kp[kb][2 * q], kc = kp[kb][2 * q + 1];
                const float E2 = E3 * kc.y, E1 = E2 * kc.x, E0 = E1 * ka.y;
                const f32x2 w01 = (1.0f - ka) * (f32x2){E0, E1}, w23 = (1.0f - kc) * (f32x2){E2, E3};
                sk[kb][4 * q] = w01.x; sk[kb][4 * q + 1] = w01.y; sk[kb][4 * q + 2] = w23.x; sk[kb][4 * q + 3] = w23.y;
            }
        carry = c;
#pragma unroll
        for (int kb = 0; kb < 2; ++kb)
#pragma unroll
            for (int s = 0; s < 2; ++s) {
                u32x4 wp;
#pragma unroll
                for (int j = 0; j < 4; ++j) wp[j] = pk2(sk[kb][8 * s + 2 * j], sk[kb][8 * s + 2 * j + 1]);
                const bf16x8 wf = __builtin_bit_cast(bf16x8, wp);
#pragma unroll
                for (int db = 0; db < 2; ++db) {
                    const LAS unsigned char* va = vc + (32 * db + r) * (VLD * 2) + (32 * kb + 16 * s + 4 * h2) * 2;
                    const u32x2 lo = *(const LAS u32x2*)va, hi = *(const LAS u32x2*)(va + 16);
                    const bf16x8 vf = __builtin_bit_cast(bf16x8, (u32x4){lo.x, lo.y, hi.x, hi.y});
                    accO[db] = MFMA32(vf, wf, accO[db]);
                }
            }
    }
}
DI void sample_finish(const Params& p, LAS float* xo, LAS float* xp, const SmpAcc& A, int s, int half, int wave, int hg, int seg, int lane, int h, int c) {
    unsigned char* ws = p.ws; bf16* AO = (bf16*)(ws + WS_AO);
    const float P[4] = {dppf<0x00>(A.carry), dppf<0xAA>(A.carry), dppf<0x55>(A.carry), dppf<0xFF>(A.carry)};
#pragma unroll
    for (int i = 0; i < 4; ++i) *(LAS f32x4*)(xo + ((wave * 4 + i) * 64 + lane) * 4) = A.acc[i];
    *(LAS f32x4*)(xp + (wave * 64 + lane) * 4) = (f32x4){P[0], P[1], P[2], P[3]};
    __syncthreads();
    if (seg == 0) {
        f32x4 o[4]; f32x4 pt_ = {1.f, 1.f, 1.f, 1.f};
#pragma unroll
        for (int i = 0; i < 4; ++i) o[i] = (f32x4){0.f, 0.f, 0.f, 0.f};
#pragma unroll
        for (int sg_ = 3; sg_ >= 0; --sg_) { const int wv = 2 * sg_ + hg; const f32x4 ps = *(const LAS f32x4*)(xp + (wv * 64 + lane) * 4);
#pragma unroll
            for (int i = 0; i < 4; ++i) o[i] = *(const LAS f32x4*)(xo + ((wv * 4 + i) * 64 + lane) * 4) + o[i] * ps[i];
            pt_ = pt_ * ps; }
        float* rec = (float*)(ws + WS_SPART) + (size_t)((s * 2 + hg) * 2 + half) * 1280;
#pragma unroll
        for (int i = 0; i < 4; ++i) *(f32x4*)(rec + (i * 64 + lane) * 4) = o[i];
        *(f32x4*)(rec + 1024 + lane * 4) = pt_;
        asm volatile("s_waitcnt vmcnt(0)" ::: "memory");
        __threadfence();
        asm volatile("s_waitcnt vmcnt(0)" ::: "memory");
        unsigned old = 0;
        if (lane == 0) old = __hip_atomic_fetch_add((unsigned*)(ws + WS_CTL) + CW_SMPCNT + s * 2 + hg, 1u, __ATOMIC_RELAXED, __HIP_MEMORY_SCOPE_AGENT);
        old = __builtin_amdgcn_readfirstlane(old);
        if (old == 1u) {
            __threadfence();
            asm volatile("s_waitcnt vmcnt(0)" ::: "memory");
            const float* orec = (const float*)(ws + WS_SPART) + (size_t)((s * 2 + hg) * 2 + (half ^ 1)) * 1280;
            const f32x4 Po = *(const f32x4*)(orec + 1024 + lane * 4);
#pragma unroll
            for (int i = 0; i < 4; ++i) { const f32x4 oo = *(const f32x4*)(orec + (i * 64 + lane) * 4);
                const f32x4 rr = half ? o[i] + oo * pt_[i] : oo + o[i] * Po[i];
                u32x2 w; w.x = pk2(rr[0], rr[1]); w.y = pk2(rr[2], rr[3]); *(u32x2*)(AO + (size_t)(MP + 4 * s + i) * DM + h * SBD + 4 * c) = w; }
        }
    }
}
DI void phase_even_b(const Params& p, LAS unsigned char* lds, int tid_, int lane_, int wave, int G, int qsel = 0) {
    unsigned char* ws = p.ws;
    unsigned* headP = (unsigned*)(ws + WS_CTL) + CW_QUEUE + 64 * qsel; unsigned* headS = headP + 32;
    volatile LAS unsigned* slot = (volatile LAS unsigned*)(lds + LDSCTL_OFF + 128);
    const bf16* QB = (const bf16*)(ws + WS_QB); const bf16* KB = (const bf16*)(ws + WS_KB); const bf16* VT = (const bf16*)(ws + WS_VT); const bf16* VS = (const bf16*)(ws + WS_VS); bf16* AO = (bf16*)(ws + WS_AO);
    const float* ck = (const float*)p.in[I_CK]; const float* cv = (const float*)p.in[I_CV];
    typedef const __attribute__((address_space(4))) int* cint_p;
    constexpr unsigned N_ATT = NB_P * SBH * 16, N_FIX = NB_P * 64, N_PQ = N_ATT + N_FIX, N_SQ = 2 * NB_S;
    constexpr int KLD = 72, VLD = 68, KBUF = 64 * KLD * 2, VBUF = 64 * VLD * 2;
    LAS unsigned char* kl = lds; LAS unsigned char* vl = lds + 2 * KBUF;
    LAS float* xo = (LAS float*)(lds + 36864); LAS float* xp = (LAS float*)(lds + 36864 + 32768);
    int tid = tid_; asm volatile("" : "+v"(tid));
    const int lane = tid & 63, r = lane & 31, h2 = lane >> 5;
    bool pAct = false, pEmpty = (p.mode == 1); int pb = 0, ph = 0, Q0 = 0, kt = 0, cur = 0;
    bf16x8 qf[4]; f32x16 accO[2]; float pcarry = 1.f, pbias2 = 0.f; u32x4 kr0, vr0, kr1, vr1;
    const int srow = tid >> 3, sch = tid & 7, kdst = srow * (KLD * 2) + sch * 16, vdst = srow * (VLD * 2) + sch * 16;
    const bf16* ksrc = KB; const bf16* vsrc = VT;
    bool sAct = false, sEmpty = (p.mode == 2); int ss = 0, shalf = 0, st = 0;
    const int hg = wave & 1, seg = wave >> 1, hh = lane >> 4, c = lane & 15, sh = 4 * hg + hh, qme = 2 * (c & 1) + ((c >> 1) & 1);
    const float sbias2 = ((const float*)p.in[I_SBB])[sh] * LOG2E;
    LAS f32x4* sq = (LAS f32x4*)(lds + 36864 + 40960) + wave * 256 + lane;
    SmpAcc A; SmpKV R0, R1; cint_p spt = (cint_p)(unsigned long long)p.in[I_PT];
#pragma unroll
    for (int i = 0; i < 4; ++i) { qf[i] = (bf16x8){0, 0, 0, 0, 0, 0, 0, 0}; A.acc[i] = (f32x4){0.f, 0.f, 0.f, 0.f}; }
    A.carry = 1.f;
#pragma unroll
    for (int i = 0; i < 16; ++i) { accO[0][i] = 0.f; accO[1][i] = 0.f; }
    kr0 = (u32x4){0u, 0u, 0u, 0u}; vr0 = kr0; kr1 = kr0; vr1 = kr0;
#pragma unroll
    for (int u = 0; u < 4; ++u) { R0.k[u] = (f32x4){0.f, 0.f, 0.f, 0.f}; R0.v[u] = R0.k[u]; R1.k[u] = R0.k[u]; R1.v[u] = R0.k[u]; }
#define SMP_LOAD(R, sidx) do { const int sn_ = (sidx) < 64 ? (sidx) : 63; const int ph_ = __builtin_amdgcn_readfirstlane(spt[1 - (sn_ >> 5)]); smp_load(R, ck, cv, ph_, 124 - 4 * (sn_ & 31), hg, lane); __builtin_amdgcn_sched_barrier(0); } while (0)
#define EB_ITER(SA, SB, PKA, PVA, PKB, PVB) { \
    bool fresh = false; \
    if (!pAct && !pEmpty) { \
        for (;;) { const unsigned u = queue_next(headP, slot, tid); \
            if (u >= N_PQ) { pEmpty = true; break; } \
            if (u >= N_ATT) { lru_fix_unit(p, tid, (int)((u - N_ATT) >> 6), (int)((u - N_ATT) & 63)); continue; } \
            const int qb = 15 - (int)(u >> 5), bh = (int)(u & 31); pb = bh >> 3; ph = bh & 7; Q0 = qb * 256 + wave * 32; kt = 4 * qb + 3; cur = 0; pcarry = 1.f; \
            pbias2 = ((const float*)p.in[I_SBB])[ph] * LOG2E; \
            { const bf16* qp = QB + (size_t)(pb * T_P + Q0 + r) * SBW + ph * SBD + 8 * h2; _Pragma("unroll") for (int s_ = 0; s_ < 4; ++s_) qf[s_] = *(const bf16x8*)(qp + 16 * s_); } \
            _Pragma("unroll") for (int i = 0; i < 16; ++i) { accO[0][i] = 0.f; accO[1][i] = 0.f; } \
            ksrc = KB + (size_t)(pb * T_P + srow) * SBW + ph * SBD + sch * 8; vsrc = VT + ((size_t)(pb * SBH + ph) * SBD + srow) * T_P + sch * 8; \
            PKA = *(const u32x4*)(ksrc + (size_t)(64 * kt) * SBW); PVA = *(const u32x4*)(vsrc + 64 * kt); \
            { const int k1 = kt > 0 ? kt - 1 : 0; PKB = *(const u32x4*)(ksrc + (size_t)(64 * k1) * SBW); PVB = *(const u32x4*)(vsrc + 64 * k1); } \
            *(LAS u32x4*)(kl + kdst) = PKA; *(LAS u32x2*)(vl + vdst) = (u32x2){PVA.x, PVA.y}; *(LAS u32x2*)(vl + vdst + 8) = (u32x2){PVA.z, PVA.w}; \
            pAct = true; fresh = true; break; } } \
    if (!sAct && !sEmpty) { const unsigned u = queue_next(headS, slot, tid); \
        if (u >= N_SQ) sEmpty = true; \
        else { ss = (int)(u >> 1); shalf = (int)(u & 1); st = 0; sAct = true; A.carry = 1.f; \
            f32x4 q[4]; \
            _Pragma("unroll") for (int i = 0; i < 4; ++i) { A.acc[i] = (f32x4){0.f, 0.f, 0.f, 0.f}; const u32x2 w = *(const u32x2*)(QB + (size_t)(MP + 4 * ss + i) * SBW + sh * SBD + 4 * c); q[i] = (f32x4){bflo(w.x), bfhi(w.x), bflo(w.y), bfhi(w.y)}; sq[64 * i] = q[i]; } \
            spt = (cint_p)(unsigned long long)p.in[I_PT] + ss * NPAGES + shalf * 8 + 6 - 2 * seg; \
            SMP_LOAD(SA, 0); SMP_LOAD(SB, 1); \
            if (shalf && seg == 0) { _Pragma("unroll") for (int n = 3; n >= 0; --n) { const u32x2 kw = *(const u32x2*)(KB + (size_t)(MP + 4 * ss + n) * SBW + sh * SBD + 4 * c), vw = *(const u32x2*)(VS + (size_t)(4 * ss + n) * SBW + sh * SBD + 4 * c); \
                smp_key(A, q, (f32x4){bflo(kw.x), bfhi(kw.x), bflo(kw.y), bfhi(kw.y)}, (f32x4){bflo(vw.x), bfhi(vw.x), bflo(vw.y), bfhi(vw.y)}, sbias2, c, n >= qme); } } } } \
    if (!pAct && !sAct) break; \
    if (fresh) __syncthreads(); \
      \
    { const int k2 = kt > 1 ? kt - 2 : 0; PKA = *(const u32x4*)(ksrc + (size_t)(64 * k2) * SBW); PVA = *(const u32x4*)(vsrc + 64 * k2); __builtin_amdgcn_sched_barrier(0); } \
    if (pAct) { \
        prompt_tile(kl + cur * KBUF, vl + cur * VBUF, qf, accO, pcarry, pbias2, 64 * kt, Q0, r, h2); \
        if (kt > 0) { LAS unsigned char* kn = kl + (cur ^ 1) * KBUF; LAS unsigned char* vn = vl + (cur ^ 1) * VBUF; \
            *(LAS u32x4*)(kn + kdst) = PKB; *(LAS u32x2*)(vn + vdst) = (u32x2){PVB.x, PVB.y}; *(LAS u32x2*)(vn + vdst + 8) = (u32x2){PVB.z, PVB.w}; } } \
    if (sAct) { f32x4 q[4]; _Pragma("unroll") for (int i = 0; i < 4; ++i) q[i] = sq[64 * i]; \
        _Pragma("unroll") for (int u = 3; u >= 0; --u) smp_key(A, q, SA.k[u], SA.v[u], sbias2, c, false); } \
    SMP_LOAD(SA, st + 2); \
    __syncthreads(); \
    if (pAct) { cur ^= 1; if (--kt < 0) { pAct = false; \
            bf16* orow = AO + (size_t)(pb * T_P + Q0 + r) * DM + ph * SBD; \
            _Pragma("unroll") for (int db = 0; db < 2; ++db) _Pragma("unroll") for (int g = 0; g < 4; ++g) { u32x2 w; w.x = pk2(accO[db][4 * g], accO[db][4 * g + 1]); w.y = pk2(accO[db][4 * g + 2], accO[db][4 * g + 3]); \
                *(u32x2*)(orow + 32 * db + 8 * g + 4 * h2) = w; } } } \
    if (sAct && ++st == 64) { sAct = false; sample_finish(p, xo, xp, A, ss, shalf, wave, hg, seg, lane, sh, c); } }
    for (;;) { EB_ITER(R0, R1, kr0, vr0, kr1, vr1) EB_ITER(R1, R0, kr1, vr1, kr0, vr0) }
#undef EB_ITER
#undef SMP_LOAD
    if (p.mode == 0) { unsigned* headC = headP + 16; LAS float* scr = (LAS float*)(lds + wave * 16384);
      for (;;) { const unsigned bt = queue_next(headC, slot, tid); if (bt * 8 >= (unsigned)DEF3_N) break;
          const int v = (int)bt * 8 + wave; if (v < DEF3_N) convert_item(p, scr, defer3_item(v), lane); } }
}
constexpr int OA_QL = 0, OA_KL = 17408, OA_VL = 34816, OA_KBT = 52224, OA_VBT = 70656, OA_AL = 89088, OA_TL = 106496, OA_G = 115712, OA_BETA = 115968, OA_GRAW = 116224;
constexpr int QLD = 136, TLD = 72, ALD = 68;
constexpr int OA_RAW = OA_KBT, RAWLD = 384, OA_CW = 116480;
DI void oa_dma(const bf16* PROJ, const bf16* zeros, LAS unsigned char* rawb, int unit, int tid, int wave) {
    const int h = unit & 7, c = (unit >> 3) & 63, b = unit >> 9, m0 = b * T_P + c * 64;
#pragma unroll
    for (int rep = 0; rep < 7; ++rep) { const int id = tid + 512 * rep, row = id / 48, sg = id - row * 48, tn = sg >> 4, ck = sg & 15;
        const bool valid = id < 67 * 48 && !(c == 0 && row < 3);
        const bf16* src = valid ? PROJ + (size_t)(m0 - 3 + row) * ODD_PAD + tn * DNW + h * DND + ck * 8 : zeros + (tid & 63) * 8;
        __builtin_amdgcn_global_load_lds((const unsigned*)src, (LAS unsigned*)(rawb + (512 * rep + 64 * wave) * 16), 16, 0, 0); }
}
DI void oa_conv8(const LAS bf16* raw, const LAS float* cwl, int tl, int tn, int ch0, float (&y)[8]) {
    float acc[8];
#pragma unroll
    for (int j = 0; j < 8; ++j) acc[j] = 0.f;
#pragma unroll
    for (int i = 0; i < 4; ++i) {
        const u32x4 x = *(const LAS u32x4*)(raw + (tl + i) * RAWLD + tn * DND + ch0);
        const f32x4 w0 = *(const LAS f32x4*)(cwl + (tn * 4 + i) * DND + ch0), w1 = *(const LAS f32x4*)(cwl + (tn * 4 + i) * DND + ch0 + 4);
        acc[0] += w0[0] * bflo(x.x); acc[1] += w0[1] * bfhi(x.x); acc[2] += w0[2] * bflo(x.y); acc[3] += w0[3] * bfhi(x.y);
        acc[4] += w1[0] * bflo(x.z); acc[5] += w1[1] * bfhi(x.z); acc[6] += w1[2] * bflo(x.w); acc[7] += w1[3] * bfhi(x.w);
    }
#pragma unroll
    for (int j = 0; j < 8; ++j) y[j] = fsilu(acc[j]);
}
DI int perm16c(int k) { return (k & ~12) | ((k & 4) << 1) | ((k & 8) >> 1); }
DI void dn_conv8(const bf16* PROJ, const float* cw, int m, int t_in_seq, int chan, float (&y)[8]) {
    float acc[8];
#pragma unroll
    for (int j = 0; j < 8; ++j) acc[j] = 0.f;
#pragma unroll
    for (int i = 0; i < 4; ++i) {
        if (t_in_seq - 3 + i >= 0) {
            const u32x4 x = *(const u32x4*)(PROJ + (size_t)(m - 3 + i) * ODD_PAD + chan);
            const f32x4 w0 = *(const f32x4*)(cw + i * 3 * DNW + chan), w1 = *(const f32x4*)(cw + i * 3 * DNW + chan + 4);
            acc[0] += w0[0] * bflo(x.x); acc[1] += w0[1] * bfhi(x.x); acc[2] += w0[2] * bflo(x.y); acc[3] += w0[3] * bfhi(x.y);
            acc[4] += w1[0] * bflo(x.z); acc[5] += w1[1] * bfhi(x.z); acc[6] += w1[2] * bflo(x.w); acc[7] += w1[3] * bfhi(x.w);
        }
    }
#pragma unroll
    for (int j = 0; j < 8; ++j) y[j] = fsilu(acc[j]);
}
constexpr int OB2_QL = 0, OB2_KL = 17408, OB2_AL = 34816, OB2_KGT = 52224, OB2_KBT = 70656, OB2_VBT = 89088, OB2_TL = 107520  , OB2_CW = 124928, OB2_GB = 132096  , OB2_LOG = 140288;
DI void phase_odd_a(const Params& p, LAS unsigned char* lds, int tid, int lane_, int wave, int G) {
    unsigned char* ws = p.ws;
    const bf16* PROJ = (const bf16*)(ws + WS_PROJ);
    bf16* UV = (bf16*)(ws + WS_UV); bf16* WK = (bf16*)(ws + WS_WK); bf16* QG = (bf16*)(ws + WS_QG); bf16* KGT = (bf16*)(ws + WS_KGT); bf16* PM = (bf16*)(ws + WS_PM); float* GL = (float*)(ws + WS_GL);
    const float* cw = (const float*)p.in[I_DCW];
    LAS bf16* Ql = (LAS bf16*)(lds + OB2_QL); LAS bf16* Kl = (LAS bf16*)(lds + OB2_KL); LAS float* Al = (LAS float*)(lds + OB2_AL);
    LAS bf16* KgTl = (LAS bf16*)(lds + OB2_KGT); LAS bf16* KbT = (LAS bf16*)(lds + OB2_KBT); LAS bf16* VbT = (LAS bf16*)(lds + OB2_VBT); LAS bf16* Tl = (LAS bf16*)(lds + OB2_TL);
    LAS float* Gw = (LAS float*)(lds + OB2_GB) + wave * 256;
    LAS bf16* Vl = (LAS bf16*)(lds + OB2_TL);
    LAS float* cwl = (LAS float*)(lds + OB2_CW); LAS unsigned* lograw = (LAS unsigned*)(lds + OB2_LOG);
    LAS bf16* raw = (LAS bf16*)(lds + OB2_QL);
    LAS bf16* TT = (LAS bf16*)(lds + OB2_LOG + 512);
    int curh = -1;
    const bf16* zeros = (const bf16*)(ws + WS_WINO) + (size_t)ODD_IN * DM;
    const float negA_all = 0.f; (void)negA_all;
    for (int unit = (int)blockIdx.x - G; unit < NB_P * 64 * DNH; unit += G) {
        int tidv = tid; asm volatile("" : "+v"(tidv));
        const int lane = tidv & 63, r = lane & 31, h2 = lane >> 5, tl = tidv >> 3, part = tidv & 7;
        const bool real = unit >= 0, more = unit + G < NB_P * 64 * DNH;
        const int h = unit & 7, c = (unit >> 3) & 63, b = unit >> 9;
        if (real) {
            const int t0 = c * 64, m0 = b * T_P + t0, m = m0 + tl;
            if (h != curh) { curh = h;
#pragma unroll
                for (int rep = 0; rep < 3; ++rep) { const int id = tidv + 512 * rep, tn = id >> 9, i = (id >> 7) & 3, d = id & 127; cwl[id] = cw[i * 3 * DNW + tn * DNW + h * DND + d]; }
                __syncthreads(); }
            { const float bl = bf2f((bf16)lograw[2 * lane]), al = bf2f((bf16)lograw[2 * lane + 1]);
              float x = -__expf(((const float*)p.in[I_DAL])[h]) * fsoftplus(al + ((const float*)p.in[I_DDT])[h]);
#pragma unroll
              for (int o = 1; o < 64; o <<= 1) { const float y = __shfl_up(x, o); if (lane >= o) x += y; }
              const float be = fsigmoid(bl), glast = __shfl(x, 63);
              Gw[lane] = x; Gw[64 + lane] = be; Gw[128 + lane] = be * __expf(x); Gw[192 + lane] = __expf(glast - x); }
            float qv[16], kv[16], vv[16];
            { float y[8];
              oa_conv8(raw, cwl, tl, 0, part * 16, y);
#pragma unroll
              for (int j = 0; j < 8; ++j) qv[j] = y[j];
              oa_conv8(raw, cwl, tl, 0, part * 16 + 8, y);
#pragma unroll
              for (int j = 0; j < 8; ++j) qv[8 + j] = y[j];
              oa_conv8(raw, cwl, tl, 1, part * 16, y);
#pragma unroll
              for (int j = 0; j < 8; ++j) kv[j] = y[j];
              oa_conv8(raw, cwl, tl, 1, part * 16 + 8, y);
#pragma unroll
              for (int j = 0; j < 8; ++j) kv[8 + j] = y[j];
              oa_conv8(raw, cwl, tl, 2, part * 16, y);
#pragma unroll
              for (int j = 0; j < 8; ++j) vv[j] = y[j];
              oa_conv8(raw, cwl, tl, 2, part * 16 + 8, y);
#pragma unroll
              for (int j = 0; j < 8; ++j) vv[8 + j] = y[j]; }
            float sq = 0.f, sk = 0.f;
#pragma unroll
            for (int j = 0; j < 16; ++j) { sq += qv[j] * qv[j]; sk += kv[j] * kv[j]; }
#pragma unroll
            for (int o = 1; o < 8; o <<= 1) { sq += __shfl_xor(sq, o); sk += __shfl_xor(sk, o); }
            const float rq = frsq(sq + EPS) * 0.08838834764831845f, rk = frsq(sk + EPS);
#pragma unroll
            for (int j = 0; j < 16; ++j) { qv[j] *= rq; kv[j] *= rk; }
            if (c == 63 && tl >= 61) {
                float* o = p.out + O_DCP + (size_t)(b * 3 + (tl - 61)) * 3 * DNW;
#pragma unroll
                for (int tn = 0; tn < 3; ++tn)
#pragma unroll
                    for (int j = 0; j < 16; ++j) { const int chan = tn * DNW + h * DND + part * 16 + j; o[chan] = bf2f(PROJ[(size_t)m * ODD_PAD + chan]); }
            }
            const float Gt = Gw[tl], Glast = Gw[63], bt = Gw[64 + tl];
            __syncthreads();
            { u32x4 w0, w1;
#pragma unroll
              for (int j = 0; j < 4; ++j) { w0[j] = pk2(qv[2 * j], qv[2 * j + 1]); w1[j] = pk2(qv[8 + 2 * j], qv[8 + 2 * j + 1]); }
              *(LAS u32x4*)(Ql + tl * QLD + part * 16) = w0; *(LAS u32x4*)(Ql + tl * QLD + part * 16 + 8) = w1;
#pragma unroll
              for (int j = 0; j < 4; ++j) { w0[j] = pk2(kv[2 * j], kv[2 * j + 1]); w1[j] = pk2(kv[8 + 2 * j], kv[8 + 2 * j + 1]); }
              *(LAS u32x4*)(Kl + tl * QLD + part * 16) = w0; *(LAS u32x4*)(Kl + tl * QLD + part * 16 + 8) = w1;
#pragma unroll
              for (int j = 0; j < 4; ++j) { w0[j] = pk2(vv[2 * j], vv[2 * j + 1]); w1[j] = pk2(vv[8 + 2 * j], vv[8 + 2 * j + 1]); }
              *(LAS u32x4*)(Vl + tl * QLD + part * 16) = w0; *(LAS u32x4*)(Vl + tl * QLD + part * 16 + 8) = w1; }
            { const float eg = __expf(Gt);
              u32x4 w0, w1;
              w0[0] = pk2(qv[0] * eg, qv[1] * eg); w0[1] = pk2(qv[2] * eg, qv[3] * eg); w0[2] = pk2(qv[8] * eg, qv[9] * eg); w0[3] = pk2(qv[10] * eg, qv[11] * eg);
              w1[0] = pk2(qv[4] * eg, qv[5] * eg); w1[1] = pk2(qv[6] * eg, qv[7] * eg); w1[2] = pk2(qv[12] * eg, qv[13] * eg); w1[3] = pk2(qv[14] * eg, qv[15] * eg);
              bf16* qg = QG + (size_t)unit * 8192 + tl * DND + part * 16; *(u32x4*)qg = w0; *(u32x4*)(qg + 8) = w1; }
            if (tidv == 0) GL[unit] = __expf(Glast);
            __syncthreads();
            { const int d = tidv & 127, q16 = tidv >> 7;
              float kq[16], vq[16];
#pragma unroll
              for (int i = 0; i < 16; ++i) { kq[i] = bf2f(Kl[(16 * q16 + i) * QLD + d]); vq[i] = bf2f(Vl[(16 * q16 + i) * QLD + d]); }
              float skk[16], sbt[16], sek[16];
#pragma unroll
              for (int i4 = 0; i4 < 4; ++i4) { const f32x4 a = *(const LAS f32x4*)(Gw + 128 + 16 * q16 + 4 * i4), bq = *(const LAS f32x4*)(Gw + 64 + 16 * q16 + 4 * i4), e4 = *(const LAS f32x4*)(Gw + 192 + 16 * q16 + 4 * i4);
#pragma unroll
                  for (int j = 0; j < 4; ++j) { skk[4 * i4 + j] = a[j]; sbt[4 * i4 + j] = bq[j]; sek[4 * i4 + j] = e4[j]; } }
              u32x4 w0, w1;
#pragma unroll
              for (int j = 0; j < 4; ++j) { w0[j] = pk2(kq[2 * j] * skk[2 * j], kq[2 * j + 1] * skk[2 * j + 1]); w1[j] = pk2(kq[8 + 2 * j] * skk[8 + 2 * j], kq[9 + 2 * j] * skk[9 + 2 * j]); }
              *(LAS u32x4*)(KbT + d * TLD + 16 * q16) = w0; *(LAS u32x4*)(KbT + d * TLD + 16 * q16 + 8) = w1;
#pragma unroll
              for (int j = 0; j < 4; ++j) { w0[j] = pk2(vq[2 * j] * sbt[2 * j], vq[2 * j + 1] * sbt[2 * j + 1]); w1[j] = pk2(vq[8 + 2 * j] * sbt[8 + 2 * j], vq[9 + 2 * j] * sbt[9 + 2 * j]); }
              *(LAS u32x4*)(VbT + d * TLD + 16 * q16) = w0; *(LAS u32x4*)(VbT + d * TLD + 16 * q16 + 8) = w1;
              w0[0] = pk2(kq[0] * sek[0], kq[1] * sek[1]); w0[1] = pk2(kq[2] * sek[2], kq[3] * sek[3]); w0[2] = pk2(kq[8] * sek[8], kq[9] * sek[9]); w0[3] = pk2(kq[10] * sek[10], kq[11] * sek[11]);
              w1[0] = pk2(kq[4] * sek[4], kq[5] * sek[5]); w1[1] = pk2(kq[6] * sek[6], kq[7] * sek[7]); w1[2] = pk2(kq[12] * sek[12], kq[13] * sek[13]); w1[3] = pk2(kq[14] * sek[14], kq[15] * sek[15]);
              *(LAS u32x4*)(KgTl + d * TLD + 16 * q16) = w0; *(LAS u32x4*)(KgTl + d * TLD + 16 * q16 + 8) = w1; }
            { const int ti = (wave >> 1) & 1, tj = wave & 1; const bool isP = wave >= 4;
              const LAS bf16* Asrc = isP ? Ql : Kl;
              f32x16 acc;
#pragma unroll
              for (int i = 0; i < 16; ++i) acc[i] = 0.f;
#pragma unroll
              for (int s = 0; s < 8; ++s) { const bf16x8 a = *(const LAS bf16x8*)(Asrc + (32 * ti + r) * QLD + 16 * s + 8 * h2), bb = *(const LAS bf16x8*)(Kl + (32 * tj + r) * QLD + 16 * s + 8 * h2); acc = MFMA32(a, bb, acc); }
              const int j = 32 * tj + r; const float Gj = Gw[j];
#pragma unroll
              for (int i = 0; i < 16; ++i) { const int row = 32 * ti + (i & 3) + 8 * (i >> 2) + 4 * h2; const float Gi = Gw[row];
                  if (isP) { const float v = row >= j ? acc[i] * __expf(Gi - Gj) : 0.f; PM[(size_t)unit * 4096 + row * 64 + perm16c(j)] = f2bf(v); }
                  else { const float v = row > j ? acc[i] * __expf(Gi - Gj) * Gw[64 + row] : 0.f; Al[row * ALD + j] = v; } } }
            __syncthreads();
            if (wave < 2) {
                const int j = lane & 31, kh = lane >> 5, o = 32 * wave;
                f32x2 R[8];
#pragma unroll
                for (int m = 0; m < 8; ++m) R[m] = (f32x2){0.f, 0.f};
                const LAS float* abase = Al + o * ALD + o + 2 * kh;
#pragma unroll
                for (int i = 0; i < 32; ++i) {
                    f32x2 acc = {0.f, 0.f};
#pragma unroll
                    for (int m = 0; m < (i + 3) / 4; ++m) acc = __builtin_elementwise_fma(*(const LAS f32x2*)(abase + i * ALD + 4 * m), R[m], acc);
                    const float part = acc.x + acc.y;
                    const auto sw = __builtin_amdgcn_permlane32_swap(__float_as_uint(part), __float_as_uint(part), false, false);
                    const float t = ((j == i) ? 1.f : 0.f) - (__uint_as_float(sw[0]) + __uint_as_float(sw[1]));
                    if (kh == ((i >> 1) & 1)) { if (i & 1) R[i >> 2].y = t; else R[i >> 2].x = t; }
                    if (kh == 0) Tl[(o + i) * TLD + o + j] = f2bf(t);
                }
                if (wave == 0) {
#pragma unroll
                    for (int m = 0; m < 8; ++m) *(LAS unsigned*)(TT + j * 40 + 4 * m + 2 * kh) = pk2(R[m].x, R[m].y); }
            } else if (wave == 2) {
                const u32x4 z = {0u, 0u, 0u, 0u};
                *(LAS u32x4*)(Tl + (lane >> 1) * TLD + 32 + (lane & 1) * 16) = z; *(LAS u32x4*)(Tl + (lane >> 1) * TLD + 32 + (lane & 1) * 16 + 8) = z;
            } else {
#pragma unroll
                for (int rep = 0; rep < 4; ++rep) { const int id = (tidv - 192) + 320 * rep;
                    if (id < 1024) { const int row = id >> 3, chk = id & 7; *(u32x4*)(KGT + (size_t)unit * 8192 + row * 64 + chk * 8) = *(const LAS u32x4*)(KgTl + row * TLD + chk * 8); } }
            }
            __syncthreads();
            if (wave == 0) {
                f32x16 X;
#pragma unroll
                for (int i = 0; i < 16; ++i) X[i] = 0.f;
#pragma unroll
                for (int s2 = 0; s2 < 2; ++s2) { const LAS float* ap = Al + (32 + r) * ALD + 16 * s2 + 8 * h2; const f32x4 a0 = *(const LAS f32x4*)ap, a1 = *(const LAS f32x4*)(ap + 4);
                    u32x4 aw; aw[0] = pk2(a0[0], a0[1]); aw[1] = pk2(a0[2], a0[3]); aw[2] = pk2(a1[0], a1[1]); aw[3] = pk2(a1[2], a1[3]);
                    const bf16x8 bfr = *(const LAS bf16x8*)(TT + r * 40 + 16 * s2 + 8 * h2);
                    X = MFMA32(__builtin_bit_cast(bf16x8, aw), bfr, X); }
                f32x16 Y;
#pragma unroll
                for (int i = 0; i < 16; ++i) Y[i] = 0.f;
#pragma unroll
                for (int s2 = 0; s2 < 2; ++s2) { u32x4 xw;
#pragma unroll
                    for (int q = 0; q < 4; ++q) xw[q] = pk2(X[8 * s2 + 2 * q], X[8 * s2 + 2 * q + 1]);
                    const LAS bf16* tp = Tl + (32 + r) * TLD + 32 + 16 * s2 + 4 * h2; const u32x2 lo = *(const LAS u32x2*)tp, hi = *(const LAS u32x2*)(tp + 8);
                    Y = MFMA32(__builtin_bit_cast(bf16x8, (u32x4){lo.x, lo.y, hi.x, hi.y}), __builtin_bit_cast(bf16x8, xw), Y); }
#pragma unroll
                for (int i = 0; i < 16; ++i) Tl[(32 + (i & 3) + 8 * (i >> 2) + 4 * h2) * TLD + r] = f2bf(-Y[i]);
            }
            __syncthreads();
        }
        if (more) {
            oa_dma(PROJ, zeros, lds + OB2_QL, unit + G, tidv, wave);
            if (part == 0) { const int un = unit + G; const bf16* pr = PROJ + (size_t)((un >> 9) * T_P + ((un >> 3) & 63) * 64 + tl) * ODD_PAD + 4 * DNW + (un & 7); lograw[2 * tl] = pr[0]; lograw[2 * tl + 1] = pr[DNH]; } }
        if (real) {
#pragma unroll
            for (int rep = 0; rep < 2; ++rep) {
                const int id = wave + 8 * rep, which = id >> 3, ti = (id >> 2) & 1, tj = id & 3;
                const LAS bf16* Bsrc = which ? KbT : VbT;
                f32x16 acc;
#pragma unroll
                for (int i = 0; i < 16; ++i) acc[i] = 0.f;
#pragma unroll
                for (int s = 0; s < 4; ++s) { const bf16x8 a = *(const LAS bf16x8*)(Tl + (32 * ti + r) * TLD + 16 * s + 8 * h2), bb = *(const LAS bf16x8*)(Bsrc + (32 * tj + r) * TLD + 16 * s + 8 * h2); acc = MFMA32(a, bb, acc); }
                if (which) { bf16* dst = WK + (size_t)unit * 8192; const int colp = perm16c(32 * tj + r);
#pragma unroll
                    for (int i = 0; i < 16; ++i) { const int row = 32 * ti + (i & 3) + 8 * (i >> 2) + 4 * h2; dst[row * DND + colp] = f2bf(acc[i]); } }
                else { u32x4 w0, w1;
#pragma unroll
                    for (int j = 0; j < 4; ++j) { w0[j] = pk2(acc[2 * j], acc[2 * j + 1]); w1[j] = pk2(acc[8 + 2 * j], acc[8 + 2 * j + 1]); }
                    bf16* dst = UV + (size_t)unit * 8192 + (size_t)(((tj * 2 + ti) * 64) + lane) * 16; *(u32x4*)dst = w0; *(u32x4*)(dst + 8) = w1; }
            }
        }
        asm volatile("s_waitcnt vmcnt(0)" ::: "memory");
        __syncthreads();
    }
}
constexpr int OB_WK = 0, OB_QG = 17408, OB_KGT = 34816, OB_PM = 53248, OB_BUF = 62464;
DI bf16x8 pack8(const f32x16& x, int s) {
    u32x4 w;
#pragma unroll
    for (int j = 0; j < 4; ++j) w[j] = pk2(x[8 * s + 2 * j], x[8 * s + 2 * j + 1]);
    return __builtin_bit_cast(bf16x8, w);
}
#define CH_BARRIER() do { asm volatile("s_waitcnt lgkmcnt(0)" ::: "memory"); __builtin_amdgcn_s_barrier(); asm volatile("" ::: "memory"); } while (0)
struct ChainRegs { u32x4 wk[4], qg[4], kg[4], pm[2]; };
DI void chain_load(ChainRegs& R, const bf16* WK, const bf16* QG, const bf16* KGT, const bf16* PM, size_t u, int lt) {
#pragma unroll
    for (int rep = 0; rep < 4; ++rep) { const int id = lt + 256 * rep;
        R.wk[rep] = *(const u32x4*)(WK + u * 8192 + id * 8); R.qg[rep] = *(const u32x4*)(QG + u * 8192 + id * 8); R.kg[rep] = *(const u32x4*)(KGT + u * 8192 + id * 8); }
#pragma unroll
    for (int rep = 0; rep < 2; ++rep) R.pm[rep] = *(const u32x4*)(PM + u * 4096 + (lt + 256 * rep) * 8);
}
DI void chain_store(const ChainRegs& R, LAS unsigned char* buf, int lt) {
#pragma unroll
    for (int rep = 0; rep < 4; ++rep) { const int id = lt + 256 * rep;
        *(LAS u32x4*)(buf + OB_WK + ((id >> 4) * QLD + (id & 15) * 8) * 2) = R.wk[rep]; *(LAS u32x4*)(buf + OB_QG + ((id >> 4) * QLD + (id & 15) * 8) * 2) = R.qg[rep];
        *(LAS u32x4*)(buf + OB_KGT + ((id >> 3) * TLD + (id & 7) * 8) * 2) = R.kg[rep]; }
#pragma unroll
    for (int rep = 0; rep < 2; ++rep) { const int id = lt + 256 * rep; *(LAS u32x4*)(buf + OB_PM + ((id >> 3) * TLD + (id & 7) * 8) * 2) = R.pm[rep]; }
}
DI void chain_step(f32x16 (&Sacc)[4], u32x4 (&uv)[4], const LAS unsigned char* buf, float gl, const bf16* uv_next, bf16* oraw, int r, int h2) {
    const LAS bf16* WKl = (const LAS bf16*)(buf + OB_WK) + r * QLD + 8 * h2; const LAS bf16* QGl = (const LAS bf16*)(buf + OB_QG) + r * QLD + 8 * h2;
    const LAS bf16* KGTl = (const LAS bf16*)(buf + OB_KGT) + r * TLD + 8 * h2; const LAS bf16* PMl = (const LAS bf16*)(buf + OB_PM) + r * TLD + 8 * h2;
#define FR(base, ld, rowblk, kk) (*(const LAS bf16x8*)((base) + (32 * (rowblk)) * (ld) + 16 * (kk)))
    f32x16 U[2], accO[2];
#pragma unroll
    for (int ti = 0; ti < 2; ++ti)
#pragma unroll
        for (int i = 0; i < 16; ++i) { U[ti][i] = 0.f; accO[ti][i] = 0.f; }
    bf16x8 fw[2][2], fq[2][2];
    fw[0][0] = FR(WKl, QLD, 0, 0); fw[0][1] = FR(WKl, QLD, 1, 0); fq[0][0] = FR(QGl, QLD, 0, 0); fq[0][1] = FR(QGl, QLD, 1, 0);
#pragma unroll
    for (int kk = 0; kk < 8; ++kk) { const int cb = kk & 1, nb = cb ^ 1;
        if (kk < 7) { fw[nb][0] = FR(WKl, QLD, 0, kk + 1); fw[nb][1] = FR(WKl, QLD, 1, kk + 1); fq[nb][0] = FR(QGl, QLD, 0, kk + 1); fq[nb][1] = FR(QGl, QLD, 1, kk + 1); }
        const bf16x8 sf = pack8(Sacc[kk >> 1], kk & 1);
        __builtin_amdgcn_sched_barrier(0);
        U[0] = MFMA32(fw[cb][0], sf, U[0]); U[1] = MFMA32(fw[cb][1], sf, U[1]); accO[0] = MFMA32(fq[cb][0], sf, accO[0]); accO[1] = MFMA32(fq[cb][1], sf, accO[1]);
        __builtin_amdgcn_sched_barrier(0); }
    bf16x8 fk[2][4];
#pragma unroll
    for (int d = 0; d < 2; ++d)
#pragma unroll
        for (int k2 = 0; k2 < 4; ++k2) fk[d][k2] = FR(KGTl, TLD, d, k2);
    __builtin_amdgcn_sched_barrier(0);
#pragma unroll
    for (int ti = 0; ti < 2; ++ti)
#pragma unroll
        for (int j = 0; j < 8; ++j) { const unsigned w = uv[2 * ti + (j >> 2)][j & 3]; U[ti][2 * j] = bflo(w) - U[ti][2 * j]; U[ti][2 * j + 1] = bfhi(w) - U[ti][2 * j + 1]; }
    if (uv_next) {
#pragma unroll
        for (int q = 0; q < 4; ++q) uv[q] = *(const u32x4*)(uv_next + (size_t)((q >> 1) * 64) * 16 + (q & 1) * 8); }
    bf16x8 Uf[4];
#pragma unroll
    for (int k2 = 0; k2 < 4; ++k2) Uf[k2] = pack8(U[k2 >> 1], k2 & 1);
    bf16x8 fp[4];
#pragma unroll
    for (int k2 = 0; k2 < 4; ++k2) fp[k2] = FR(PMl, TLD, 0, k2);
    __builtin_amdgcn_sched_barrier(0);
#pragma unroll
    for (int d = 0; d < 2; ++d) {
#pragma unroll
        for (int i = 0; i < 16; ++i) Sacc[d][i] *= gl;
#pragma unroll
        for (int k2 = 0; k2 < 4; ++k2) Sacc[d] = MFMA32(fk[d][k2], Uf[k2], Sacc[d]); }
#pragma unroll
    for (int d = 0; d < 2; ++d)
#pragma unroll
        for (int k2 = 0; k2 < 4; ++k2) fk[d][k2] = FR(KGTl, TLD, 2 + d, k2);
    __builtin_amdgcn_sched_barrier(0);
#pragma unroll
    for (int k2 = 0; k2 < 4; ++k2) accO[0] = MFMA32(fp[k2], Uf[k2], accO[0]);
#pragma unroll
    for (int k2 = 0; k2 < 4; ++k2) fp[k2] = FR(PMl, TLD, 1, k2);
    __builtin_amdgcn_sched_barrier(0);
#pragma unroll
    for (int d = 0; d < 2; ++d) {
#pragma unroll
        for (int i = 0; i < 16; ++i) Sacc[2 + d][i] *= gl;
#pragma unroll
        for (int k2 = 0; k2 < 4; ++k2) Sacc[2 + d] = MFMA32(fk[d][k2], Uf[k2], Sacc[2 + d]); }
#pragma unroll
    for (int k2 = 0; k2 < 4; ++k2) accO[1] = MFMA32(fp[k2], Uf[k2], accO[1]);
#pragma unroll
    for (int ti = 0; ti < 2; ++ti) { u32x4 w0, w1;
#pragma unroll
        for (int j = 0; j < 4; ++j) { w0[j] = pk2(accO[ti][2 * j], accO[ti][2 * j + 1]); w1[j] = pk2(accO[ti][8 + 2 * j], accO[ti][8 + 2 * j + 1]); }
        *(u32x4*)(oraw + (size_t)(ti * 64) * 16) = w0; *(u32x4*)(oraw + (size_t)(ti * 64) * 16 + 8) = w1; }
#undef FR
}
DI void dn_chain_unit(const Params& p, LAS unsigned char* lds, int tid_, int wave, int b, int h, int half) {
    unsigned char* ws = p.ws;
    const bf16* UV = (const bf16*)(ws + WS_UV); const bf16* WK = (const bf16*)(ws + WS_WK); const bf16* QG = (const bf16*)(ws + WS_QG); const bf16* KGT = (const bf16*)(ws + WS_KGT); const bf16* PM = (const bf16*)(ws + WS_PM);
    const float* GL = (const float*)(ws + WS_GL); bf16* OR = (bf16*)(ws + WS_OR);
    int tid = tid_; asm volatile("" : "+v"(tid));
    const size_t ub = (size_t)(b * 64) * 8 + h;
    if (wave >= 4) {
        const int lt = tid - 256;
        ChainRegs R0, R1, R2;
#define CH_CHUNK(i) (ub + 8 * ((i) < 64 ? (i) : 63))
#define CH_LSTEP(n_, RL, RS) do { chain_load(RL, WK, QG, KGT, PM, CH_CHUNK((n_) + 3), lt); chain_store(RS, lds + (((n_) + 1) & 1) * OB_BUF, lt); CH_BARRIER(); } while (0)
        chain_load(R0, WK, QG, KGT, PM, CH_CHUNK(0), lt); chain_load(R1, WK, QG, KGT, PM, CH_CHUNK(1), lt); chain_load(R2, WK, QG, KGT, PM, CH_CHUNK(2), lt);
        chain_store(R0, lds, lt);
        CH_BARRIER();
#pragma unroll 1
        for (int n = 0; n < 63; n += 3) { CH_LSTEP(n, R0, R1); CH_LSTEP(n + 1, R1, R2); CH_LSTEP(n + 2, R2, R0); }
        CH_LSTEP(63, R0, R1);
#undef CH_LSTEP
#undef CH_CHUNK
    } else if (wave >= 2) {
        for (int n = 0; n < 65; ++n) CH_BARRIER();
    } else {
        const int lane = tid & 63, r = lane & 31, h2 = lane >> 5, w = 2 * half + wave;
        f32x16 Sacc[4];
#pragma unroll
        for (int d = 0; d < 4; ++d)
#pragma unroll
            for (int i = 0; i < 16; ++i) Sacc[d][i] = 0.f;
        const size_t lofs = (size_t)((w * 2) * 64 + lane) * 16;
        u32x4 uv[4];
#pragma unroll
        for (int q = 0; q < 4; ++q) uv[q] = *(const u32x4*)(UV + ub * 8192 + lofs + (size_t)((q >> 1) * 64) * 16 + (q & 1) * 8);
        float gl = GL[ub];
        CH_BARRIER();
#pragma unroll 1
        for (int n = 0; n < 64; n += 2) {
            const float gl1 = GL[ub + 8 * (n + 1)];
            chain_step(Sacc, uv, lds, gl, UV + (ub + 8 * (n + 1)) * 8192 + lofs, OR + (ub + 8 * n) * 8192 + lofs, r, h2);
            CH_BARRIER();
            gl = (n + 2 < 64) ? GL[ub + 8 * (n + 2)] : 0.f;
            chain_step(Sacc, uv, lds + OB_BUF, gl1, (n + 2 < 64) ? UV + (ub + 8 * (n + 2)) * 8192 + lofs : (const bf16*)nullptr, OR + (ub + 8 * (n + 1)) * 8192 + lofs, r, h2);
            CH_BARRIER();
        }
        float* so = p.out + O_DSP + (size_t)((b * DNH + h) * DND) * DND;
#pragma unroll
        for (int d = 0; d < 4; ++d)
#pragma unroll
            for (int i = 0; i < 16; ++i) so[(size_t)(32 * d + (i & 3) + 8 * (i >> 2) + 4 * h2) * DND + 32 * w + r] = Sacc[d][i];
    }
    __syncthreads();
}
DI void dn_sample_unit(const Params& p, LAS unsigned char* lds, int tid_, int wave, int s, int h) {
    unsigned char* ws = p.ws;
    const bf16* PROJ = (const bf16*)(ws + WS_PROJ); bf16* AO = (bf16*)(ws + WS_AO);
    LAS float* qkvl = (LAS float*)lds;
    LAS float* red = (LAS float*)(lds + 6144);
    LAS float* red2 = (LAS float*)(lds + 8192);
    LAS float* ol = (LAS float*)(lds + 10240);
    int tid = tid_; asm volatile("" : "+v"(tid));
    const int lane = tid & 63;
    const float* cw = (const float*)p.in[I_DCW];
    if (tid < 384) {
        const int chan = (tid >> 7) * DNW + h * DND + (tid & 127);
        float xp[7];
#pragma unroll
        for (int i = 0; i < 3; ++i) xp[i] = ((const float*)p.in[I_SDC])[(size_t)(s * 3 + i) * 3 * DNW + chan];
#pragma unroll
        for (int t = 0; t < 4; ++t) xp[3 + t] = bf2f(PROJ[(size_t)(MP + 4 * s + t) * ODD_PAD + chan]);
        const float w0 = cw[chan], w1 = cw[3 * DNW + chan], w2 = cw[2 * 3 * DNW + chan], w3 = cw[3 * 3 * DNW + chan];
#pragma unroll
        for (int t = 0; t < 4; ++t) qkvl[t * 384 + tid] = fsilu(w0 * xp[t] + w1 * xp[t + 1] + w2 * xp[t + 2] + w3 * xp[t + 3]);
#pragma unroll
        for (int i = 0; i < 3; ++i) (p.out + O_DCS)[(size_t)(s * 3 + i) * 3 * DNW + chan] = xp[4 + i];
    }
    __syncthreads();
    { const int t = wave >> 1, tn = wave & 1; LAS float* v = qkvl + t * 384 + tn * 128;
      const float a = v[lane], bq = v[lane + 64]; const float sc = frsq(wave_sum(a * a + bq * bq) + EPS) * (tn == 0 ? 0.08838834764831845f : 1.0f);
      v[lane] = a * sc; v[lane + 64] = bq * sc; }
    __syncthreads();
    const int e = tid & 127, qd = tid >> 7;
    float S[32];
    const float* s0 = (const float*)p.in[I_SDS] + ((size_t)(s * DNH + h) * DND + 32 * qd) * DND + e;
#pragma unroll
    for (int j = 0; j < 32; ++j) S[j] = s0[(size_t)j * DND];
    const float negA = -__expf(((const float*)p.in[I_DAL])[h]), dtb = ((const float*)p.in[I_DDT])[h];
#pragma unroll 1
    for (int t = 0; t < 4; ++t) {
        const size_t m = MP + 4 * s + t;
        const float beta = fsigmoid(bf2f(PROJ[m * ODD_PAD + 4 * DNW + h])), dec = __expf(negA * fsoftplus(bf2f(PROJ[m * ODD_PAD + 4 * DNW + DNH + h]) + dtb));
        const LAS float* qt = qkvl + t * 384 + 32 * qd; const LAS float* kt = qt + 128;
        float part = 0.f;
#pragma unroll
        for (int j = 0; j < 32; ++j) { S[j] *= dec; part += kt[j] * S[j]; }
        red[qd * 128 + e] = part;
        __syncthreads();
        const float kS = (red[e] + red[128 + e]) + (red[256 + e] + red[384 + e]);
        const float u = beta * (qkvl[t * 384 + 256 + e] - kS);
        float part2 = 0.f;
#pragma unroll
        for (int j = 0; j < 32; ++j) { S[j] += kt[j] * u; part2 += qt[j] * S[j]; }
        red2[qd * 128 + e] = part2;
        __syncthreads();
        if (qd == 0) ol[t * 128 + e] = (red2[e] + red2[128 + e]) + (red2[256 + e] + red2[384 + e]);
    }
    __syncthreads();
    if (wave < 4) { const int t = wave; const float a = ol[t * 128 + lane], bq = ol[t * 128 + lane + 64];
        const float rn = frsq(wave_sum(a * a + bq * bq) * (1.f / DND) + EPS);
        const size_t m = MP + 4 * s + t; const float* og = (const float*)p.in[I_DOG];
        const float z0 = bf2f(PROJ[m * ODD_PAD + 3 * DNW + h * DND + lane]), z1 = bf2f(PROJ[m * ODD_PAD + 3 * DNW + h * DND + lane + 64]);
        AO[m * DM + h * DND + lane] = f2bf(a * rn * og[lane] * fsilu(z0)); AO[m * DM + h * DND + lane + 64] = f2bf(bq * rn * og[lane + 64] * fsilu(z1)); }
    float* so = p.out + O_DSS + ((size_t)(s * DNH + h) * DND + 32 * qd) * DND + e;
#pragma unroll
    for (int j = 0; j < 32; ++j) so[(size_t)j * DND] = S[j];
    __syncthreads();
}
DI void phase_odd_b(const Params& p, LAS unsigned char* lds, int tid, int lane, int wave, int G, int qsel = 1) {
    unsigned* head = (unsigned*)(p.ws + WS_CTL) + CW_QUEUE + 64 * qsel;
    volatile LAS unsigned* slot = (volatile LAS unsigned*)(lds + LDSCTL_OFF + 128);
    constexpr unsigned N_CH = 2 * NB_P * DNH, N_SMP = NB_S * DNH, N_ALL = N_CH + N_SMP;
    for (;;) {
        unsigned u = queue_next(head, slot, tid);
        if (u >= N_ALL) break;
        const int mode = p.mode;
        if (u < N_CH) { if (mode != 2) dn_chain_unit(p, lds, tid, wave, (int)(u >> 4), (int)((u >> 1) & 7), (int)(u & 1)); continue; }
        u -= N_CH;
        if (mode != 1) dn_sample_unit(p, lds, tid, wave, (int)(u >> 3), (int)(u & 7));
    }
    { unsigned* headC = head + 32; LAS float* scr = (LAS float*)(lds + wave * 16384);
      for (;;) { const unsigned bt = queue_next(headC, slot, tid); if (bt * 8 >= (unsigned)DEF_N) break;
          const int v = (int)bt * 8 + wave; if (v < DEF_N) convert_item(p, scr, defer_item(v), lane & 63); } }
}

DI void phase_odd_c(const Params& p, LAS unsigned char* lds, int tid_, int wave, int G) {
    unsigned char* ws = p.ws;
    const bf16* PROJ = (const bf16*)(ws + WS_PROJ); const bf16* OR = (const bf16*)(ws + WS_OR); bf16* AO = (bf16*)(ws + WS_AO);
    LAS bf16* Ot = (LAS bf16*)lds;
    int tid = tid_; asm volatile("" : "+v"(tid));
    const int tl = tid >> 3, part = tid & 7;
    const float* og = (const float*)p.in[I_DOG] + part * 16;
    const f32x4 g0 = *(const f32x4*)og, g1 = *(const f32x4*)(og + 4), g2 = *(const f32x4*)(og + 8), g3 = *(const f32x4*)(og + 12);
    const float gg[16] = {g0[0], g0[1], g0[2], g0[3], g1[0], g1[1], g1[2], g1[3], g2[0], g2[1], g2[2], g2[3], g3[0], g3[1], g3[2], g3[3]};
    constexpr int NU = NB_P * 64 * DNH;
    u32x4 orn[2], zn[2];
    { const int u0 = (int)blockIdx.x < NU ? (int)blockIdx.x : 0; const int h = u0 & 7, c = (u0 >> 3) & 63, b = u0 >> 9; const size_t m = (size_t)(b * T_P + c * 64 + tl);
#pragma unroll
      for (int rep = 0; rep < 2; ++rep) orn[rep] = *(const u32x4*)(OR + (size_t)u0 * 8192 + (size_t)(tid + 512 * rep) * 8);
      zn[0] = *(const u32x4*)(PROJ + m * ODD_PAD + 3 * DNW + h * DND + part * 16); zn[1] = *(const u32x4*)(PROJ + m * ODD_PAD + 3 * DNW + h * DND + part * 16 + 8); }
    for (int unit = blockIdx.x; unit < NU; unit += G) {
        const int h = unit & 7, c = (unit >> 3) & 63, b = unit >> 9, m0 = b * T_P + c * 64;
        const u32x4 z0 = zn[0], z1 = zn[1];
#pragma unroll
        for (int rep = 0; rep < 2; ++rep) { const int q = tid + 512 * rep;
            const int half = q & 1, lane = (q >> 1) & 63, ti = (q >> 7) & 1, w = q >> 8, r = lane & 31, h2 = lane >> 5;
            const u32x4 v = orn[rep];
#pragma unroll
            for (int j = 0; j < 8; ++j) { const int i = 8 * half + j, tok = 32 * ti + (i & 3) + 8 * (i >> 2) + 4 * h2;
                Ot[tok * QLD + 32 * w + r] = (bf16)((j & 1) ? (v[j >> 1] >> 16) : (v[j >> 1] & 0xffffu)); } }
        { const int un = unit + G < NU ? unit + G : unit; const int hn = un & 7, cn = (un >> 3) & 63, bn = un >> 9; const size_t mn = (size_t)(bn * T_P + cn * 64 + tl);
#pragma unroll
          for (int rep = 0; rep < 2; ++rep) orn[rep] = *(const u32x4*)(OR + (size_t)un * 8192 + (size_t)(tid + 512 * rep) * 8);
          zn[0] = *(const u32x4*)(PROJ + mn * ODD_PAD + 3 * DNW + hn * DND + part * 16); zn[1] = *(const u32x4*)(PROJ + mn * ODD_PAD + 3 * DNW + hn * DND + part * 16 + 8); }
        const size_t m = m0 + tl;
        __syncthreads();
        const u32x4 o0 = *(const LAS u32x4*)(Ot + tl * QLD + part * 16), o1 = *(const LAS u32x4*)(Ot + tl * QLD + part * 16 + 8);
        float o[16], z[16];
#pragma unroll
        for (int j = 0; j < 4; ++j) { o[2 * j] = bflo(o0[j]); o[2 * j + 1] = bfhi(o0[j]); o[8 + 2 * j] = bflo(o1[j]); o[8 + 2 * j + 1] = bfhi(o1[j]);
            z[2 * j] = bflo(z0[j]); z[2 * j + 1] = bfhi(z0[j]); z[8 + 2 * j] = bflo(z1[j]); z[8 + 2 * j + 1] = bfhi(z1[j]); }
        float ss = 0.f;
#pragma unroll
        for (int j = 0; j < 16; ++j) ss += o[j] * o[j];
#pragma unroll
        for (int of = 1; of < 8; of <<= 1) ss += __shfl_xor(ss, of);
        const float rn = frsq(ss * (1.f / DND) + EPS);
        u32x4 w0, w1;
#pragma unroll
        for (int j = 0; j < 4; ++j) { w0[j] = pk2(o[2 * j] * rn * gg[2 * j] * fsilu(z[2 * j]), o[2 * j + 1] * rn * gg[2 * j + 1] * fsilu(z[2 * j + 1]));
            w1[j] = pk2(o[8 + 2 * j] * rn * gg[8 + 2 * j] * fsilu(z[8 + 2 * j]), o[8 + 2 * j + 1] * rn * gg[8 + 2 * j + 1] * fsilu(z[8 + 2 * j + 1])); }
        bf16* dst = AO + m * DM + h * DND + part * 16; *(u32x4*)dst = w0; *(u32x4*)(dst + 8) = w1;
        __syncthreads();
    }
}
DI void small_swiglu(LAS unsigned char* lds, const bf16* XB, const bf16* Wt, bf16* HB, const float* ssq, int tid, int wave, int G) {
    for (int su = G - 1 - (int)blockIdx.x; su < 4 * (DFF / 32); su += G) { const int rt = su & 3, j = su >> 2, n0 = ((32 * j) >> 7) * 256 + ((32 * j) & 127);
        gemm_small_unit<128>(lds, XB, Wt, DM, MP + 128 * rt, n0, n0 + 128, SEpiSwiglu{HB, 32 * j, ssq}, tid, wave); }
}
template <bool BASE_F32, bool OUT_F32> DI void small_res(LAS unsigned char* lds, const bf16* A, const bf16* Wt, int K, const void* base, void* out, float alpha, float* ssq, int tid, int wave, int G) {
    for (int su = G - 1 - (int)blockIdx.x; su < 8 * (DM / 64); su += G) { const int rt = su & 7, j = su >> 3;
        gemm_small_unit<64>(lds, A, Wt, K, MP + 64 * rt, 64 * j, 64 * j + 32, SEpiResT<BASE_F32, OUT_F32>{base, out, ssq, alpha}, tid, wave); }
}
DI void small_proj_e(LAS unsigned char* lds, const bf16* XB, const bf16* Wt, bf16* PROJ, const float* ssq, int tid, int wave, int G) {
    if ((int)blockIdx.x < G / 2) return;
    for (int su = G - 1 - (int)blockIdx.x; su < 4 * (EVEN_IN / 64); su += G / 2) { const int rt = su & 3, j = su >> 2;
        gemm_small_unit<128>(lds, XB, Wt, DM, MP + 128 * rt, 64 * j, 64 * j + 32, SEpiProj{PROJ, EVEN_IN, ssq}, tid, wave); }
}
DI void small_proj(LAS unsigned char* lds, const bf16* XB, const bf16* Wt, bf16* PROJ, int ldc, int ngrp, int with_logits, const float* ssq, int tid, int wave, int G) {
    const int nsmp = 2 * ngrp, nall = nsmp + (with_logits ? MP / 256 : 0);
    for (int su = G - 1 - (int)blockIdx.x; su < nall; su += G) {
        int m0, j; if (su < nsmp) { m0 = MP + 256 * (su & 1); j = su >> 1; } else { m0 = 256 * (su - nsmp); j = ngrp - 1; }
        gemm_small_unit<256>(lds, XB, Wt, DM, m0, 64 * j, 64 * j + 32, SEpiProj{PROJ, ldc, ssq}, tid, wave); }
}
#ifndef PROBE_MASK
#define PROBE_MASK 0
#endif
#ifndef PROBE_MODE
#define PROBE_MODE 0
#endif
#define IN(k) (lo <= (k) && (k) < hi)
#define SEAM(k) do { if (IN(k) && IN((k) + 1)) xcd_barrier(bar); } while (0)
template <int l> DI void run_layer(const Params& p, LAS unsigned char* lds, const XcdBarrier& bar, int lo, int hi, int tid, int lane, int wave, int G, int gw, int NGW) {
    unsigned char* ws = p.ws;
    float* X = (float*)(ws + WS_X); bf16* XB = (bf16*)(ws + WS_XN); bf16* HB = (bf16*)(ws + WS_H); bf16* PROJ = (bf16*)(ws + WS_PROJ); bf16* AO = (bf16*)(ws + WS_AO);
    float* Xs = X + (size_t)MP * DM;
    float* SSQ = (float*)(ws + WS_CTL) + CW_SSQ;
    const float* xp = (const float*)p.in[I_XP]; const float* xs = (const float*)p.in[I_XS];
    const int pb = PH_L0 + l * PH_PER_LAYER;
    if (IN(pb + LP_FIN1)) {
        const bf16* Wt = (const bf16*)(ws + WS_WFIN) + (size_t)(l * 2) * 2 * DFF * DM; const float* sq = SSQ + (size_t)(3 * l + 0) * MT;
        pg8::Gemm g{XB, Wt, MP, 2 * DFF, DM}; pg8::StaticOrder S; S.init(MP, 2 * DFF, G, (int)blockIdx.x);
        pg8::EpiSwiglu E{HB, DFF, sq};
        pg8::gemm_phase<pg8::EpiSwiglu, pg8::StaticOrder, PG8_ALIGN, PG8_SP2>(lds, g, S, E);
        small_swiglu(lds, XB, Wt, HB, sq, tid, wave, G);
    }
    SEAM(pb + LP_FIN1);
    if (IN(pb + LP_FOUT1)) {
        const bf16* Wt = (const bf16*)(ws + WS_WFOUT) + (size_t)(l * 2) * DM * DFF; float* sq = SSQ + (size_t)(3 * l + 1) * MT;
        pg8::Gemm g{HB, Wt, MP, DM, DFF}; pg8::StaticOrder S; S.init(MP, DM, G, (int)blockIdx.x);
        if (l == 0) { pg8::EpiResT<true, false> E{xp, XB, sq, 0.5f}; pg8::gemm_phase<pg8::EpiResT<true, false>, pg8::StaticOrder, PG8_ALIGN, PG8_SP2>(lds, g, S, E);
            small_res<true, false>(lds, HB, Wt, DFF, xs, XB, 0.5f, sq, tid, wave, G); }
        else { pg8::EpiResT<false, false> E{XB, XB, sq, 0.5f}; pg8::gemm_phase<pg8::EpiResT<false, false>, pg8::StaticOrder, PG8_ALIGN, PG8_SP2>(lds, g, S, E);
            small_res<false, false>(lds, HB, Wt, DFF, XB, XB, 0.5f, sq, tid, wave, G); }
    }
    SEAM(pb + LP_FOUT1);
    if (IN(pb + LP_PROJ)) {
        const float* sq = SSQ + (size_t)(3 * l + 1) * MT;
        if (l == 0) {
            pg8::Gemm g{XB, (const bf16*)(ws + WS_WINE), MP, EVEN_IN, DM}; pg8::StaticOrder S; S.init(MP, EVEN_IN, G, (int)blockIdx.x);
            pg8::EpiProj E{PROJ, EVEN_IN, sq};
            pg8::gemm_phase<pg8::EpiProj, pg8::StaticOrder, PG8_ALIGN, PG8_SP2>(lds, g, S, E);
            small_proj_e(lds, XB, (const bf16*)(ws + WS_WINE), PROJ, sq, tid, wave, G);
        } else {
            pg8::Gemm g{XB, (const bf16*)(ws + WS_WINO), MP, 4 * DNW, DM}; pg8::StaticOrder S; S.init(MP, 4 * DNW, G, (int)blockIdx.x);
            pg8::EpiProj E{PROJ, ODD_PAD, sq};
            pg8::gemm_phase<pg8::EpiProj, pg8::StaticOrder, PG8_ALIGN, PG8_SP2>(lds, g, S, E);
            small_proj(lds, XB, (const bf16*)(ws + WS_WINO), PROJ, ODD_PAD, 4 * DNW / 64 + 1, 1, sq, tid, wave, G);
        }
    }
    SEAM(pb + LP_PROJ);
    if (IN(pb + LP_MIXA)) { if (l == 0) phase_even_a(p, lds, tid, lane, wave, G); else phase_odd_a(p, lds, tid, lane, wave, G); }
    SEAM(pb + LP_MIXA);
    if (IN(pb + LP_MIXB)) { if (l == 0) phase_even_b(p, lds, tid, lane, wave, G); else phase_odd_b(p, lds, tid, lane, wave, G); }
    SEAM(pb + LP_MIXB);
    if (l == 1) { if (IN(pb + LP_MIXC)) phase_odd_c(p, lds, tid, wave, G); SEAM(pb + LP_MIXC); }
    if (IN(pb + LP_OUT)) {
        const bf16* Wt = (const bf16*)(ws + (l == 0 ? WS_WOUTE : WS_WOUTO)); float* sq = SSQ + (size_t)(3 * l + 2) * MT;
        pg8::Gemm g{AO, Wt, MP, DM, DM}; pg8::StaticOrder S; S.init(MP, DM, G, (int)blockIdx.x);
        pg8::EpiResT<false, false> E{XB, XB, sq, 1.0f};
        pg8::gemm_phase<pg8::EpiResT<false, false>, pg8::StaticOrder, PG8_ALIGN, PG8_SP2>(lds, g, S, E);
        small_res<false, false>(lds, AO, Wt, DM, XB, XB, 1.0f, sq, tid, wave, G);
    }
    SEAM(pb + LP_OUT);
    if (IN(pb + LP_FIN2)) {
        const bf16* Wt = (const bf16*)(ws + WS_WFIN) + (size_t)(l * 2 + 1) * 2 * DFF * DM; const float* sq = SSQ + (size_t)(3 * l + 2) * MT;
        pg8::Gemm g{XB, Wt, MP, 2 * DFF, DM}; pg8::StaticOrder S; S.init(MP, 2 * DFF, G, (int)blockIdx.x);
        pg8::EpiSwiglu E{HB, DFF, sq};
        pg8::gemm_phase<pg8::EpiSwiglu, pg8::StaticOrder, PG8_ALIGN, PG8_SP2>(lds, g, S, E);
        small_swiglu(lds, XB, Wt, HB, sq, tid, wave, G);
    }
    SEAM(pb + LP_FIN2);
    if (IN(pb + LP_FOUT2)) {
        const bf16* Wt = (const bf16*)(ws + WS_WFOUT) + (size_t)(l * 2 + 1) * DM * DFF; float* sq = l == 0 ? SSQ + (size_t)3 * MT : (float*)nullptr;
        pg8::Gemm g{HB, Wt, MP, DM, DFF}; pg8::StaticOrder S; S.init(MP, DM, G, (int)blockIdx.x);
        if (l == 0) { pg8::EpiResT<false, false> E{XB, XB, sq, 0.5f}; pg8::gemm_phase<pg8::EpiResT<false, false>, pg8::StaticOrder, PG8_ALIGN, PG8_SP2>(lds, g, S, E);
            small_res<false, false>(lds, HB, Wt, DFF, XB, XB, 0.5f, sq, tid, wave, G); }
        else { pg8::EpiResT<false, true> E{XB, p.out + O_YP, sq, 0.5f}; pg8::gemm_phase<pg8::EpiResT<false, true>, pg8::StaticOrder, PG8_ALIGN, PG8_SP2>(lds, g, S, E);
            small_res<false, true>(lds, HB, Wt, DFF, XB, p.out + O_YS, 0.5f, sq, tid, wave, G); }
    }
    SEAM(pb + LP_FOUT2);
}
__global__ void __launch_bounds__(NTHR, 2) mega(Params p) {
    extern __shared__ __attribute__((aligned(16))) unsigned char lds_raw[];
    LAS unsigned char* lds = (LAS unsigned char*)lds_raw;
    const int tid = threadIdx.x, lane = tid & 63, wave = __builtin_amdgcn_readfirstlane(tid >> 6);
    const int G = gridDim.x, gw = blockIdx.x * NWAVES + wave, NGW = G * NWAVES;
    unsigned char* ws = p.ws;
    unsigned* ctl = (unsigned*)(ws + WS_CTL);
    for (int u = tid; u < (LDS_BYTES - LDSCTL_OFF) / 4; u += NTHR) ((LAS unsigned*)(lds + LDSCTL_OFF))[u] = 0u;
    __syncthreads();
    const int lo = p.ph_lo, hi = p.ph_hi;
    XcdBarrier bar; bar.bar = ctl + CW_BAR; bar.x = 0; bar.st = nullptr;
    if (hi - lo > 1) bar = xcd_barrier_post(ctl + CW_BAR, (volatile LAS unsigned*)(lds + LDSCTL_OFF + 64));

    float* X = (float*)(ws + WS_X); bf16* XN = (bf16*)(ws + WS_XN); bf16* HB = (bf16*)(ws + WS_H); bf16* PROJ = (bf16*)(ws + WS_PROJ); bf16* AO = (bf16*)(ws + WS_AO);
    const float* xp = (const float*)p.in[I_XP]; const float* xs = (const float*)p.in[I_XS];

    if (IN(PH_PRO)) { phase_prologue(p, lds, gw, NGW, wave, lane); { constexpr int NIW = (I_FIN + I_FOUT + I_INE) / 4;
          if (NGW > 2 * NIW) { if (gw >= NIW) phase_input_rows(xp, xs, XN, (float*)(ws + WS_CTL) + CW_SSQ, gw - NIW, NGW - NIW, lane); }
          else phase_input_rows(xp, xs, XN, (float*)(ws + WS_CTL) + CW_SSQ, gw, NGW, lane); } }
    SEAM(PH_PRO);

    run_layer<0>(p, lds, bar, lo, hi, tid, lane, wave, G, gw, NGW);
    run_layer<1>(p, lds, bar, lo, hi, tid, lane, wave, G, gw, NGW);
#undef IN
#undef SEAM
}

#ifndef MK_ONE_LAUNCH
#define MK_ONE_LAUNCH 1
#endif
extern "C" void kernel_launch(void* const* d_in, const int* in_sizes, int n_in, void* d_out, int out_size, void* d_ws, size_t ws_size, hipStream_t stream) {
    static int grid = 0;
    if (grid == 0) {
        if (n_in != N_IN || (size_t)out_size != O_END || ws_size < WS_END) { fprintf(stderr, "kernel_launch: unexpected problem: n_in %d out %d ws %zu\n", n_in, out_size, ws_size); grid = -1; return; }
        int dev = 0, cus = 0;
        if (hipGetDevice(&dev) != hipSuccess || hipDeviceGetAttribute(&cus, hipDeviceAttributeMultiprocessorCount, dev) != hipSuccess) { grid = -1; return; }
        if (hipFuncSetAttribute((const void*)mega, hipFuncAttributeMaxDynamicSharedMemorySize, LDS_BYTES) != hipSuccess) { fprintf(stderr, "kernel_launch: hipFuncSetAttribute failed\n"); grid = -1; return; }
        int per_cu = 0;
        if (hipOccupancyMaxActiveBlocksPerMultiprocessor(&per_cu, (const void*)mega, NTHR, LDS_BYTES) != hipSuccess || per_cu < 1) fprintf(stderr, "kernel_launch: occupancy query says %d\n", per_cu);
        (void)hipGetLastError();
        grid = cus;
    }
    if (grid < 0) return;
    if (hipMemsetAsync((char*)d_ws + WS_CTL, 0, CTL_ZERO_BYTES, stream) != hipSuccess) return;
    Params p{};
    for (int i = 0; i < N_IN; ++i) p.in[i] = d_in[i];
    p.out = (float*)d_out; p.ws = (unsigned char*)d_ws;
#if PROBE_MASK
    { int lo = 0;
      for (int ph = 0; ph < NPH; ++ph) if ((PROBE_MASK >> ph) & 1) {
          p.ph_lo = lo; p.ph_hi = ph + 1; hipLaunchKernelGGL(mega, dim3(grid), dim3(NTHR), LDS_BYTES, stream, p);
          (void)hipMemsetAsync((char*)d_ws + WS_CTL, 0, CW_SSQ * 4, stream);
          p.ph_lo = ph; p.ph_hi = ph + 1; p.mode = PROBE_MODE; hipLaunchKernelGGL(mega, dim3(grid), dim3(NTHR), LDS_BYTES, stream, p); p.mode = 0;
          (void)hipMemsetAsync((char*)d_ws + WS_CTL, 0, CW_SSQ * 4, stream);
          lo = ph + 1; }
      if (lo < NPH) { p.ph_lo = lo; p.ph_hi = NPH; hipLaunchKernelGGL(mega, dim3(grid), dim3(NTHR), LDS_BYTES, stream, p); } }
#elif MK_ONE_LAUNCH
    p.ph_lo = 0; p.ph_hi = NPH;
    hipLaunchKernelGGL(mega, dim3(grid), dim3(NTHR), LDS_BYTES, stream, p);
#else
    for (int ph = 0; ph < NPH; ++ph) { p.ph_lo = ph; p.ph_hi = ph + 1; hipLaunchKernelGGL(mega, dim3(grid), dim3(NTHR), LDS_BYTES, stream, p); }
#endif
}
```
